# Optimizing an MI355X kernel written in HIP

```python
import jax
import jax.numpy as jnp
from jax import lax
import numpy as np


D_MODEL = 1024
BATCH = 1
SEQ = 16384
DEPTH = 1

ATTN_HEADS = 8
ATTN_HEAD_DIM = 64
ATTN_WIDTH = ATTN_HEADS * ATTN_HEAD_DIM
MOBA_BLOCK = 256
MOBA_TOP_K = 3
Q_BLOCK = 128
MLSTM_HEADS = 4
MLSTM_HEAD_DIM = 128
MLSTM_WIDTH = MLSTM_HEADS * MLSTM_HEAD_DIM
MLSTM_CHUNK = 128
CONV_WIDTH = 4
FFN_HIDDEN = -(-8 * D_MODEL // (3 * 256)) * 256
NORM_EPS = 1e-6
IN_SPLITS = (ATTN_WIDTH, ATTN_WIDTH, ATTN_WIDTH,
             MLSTM_WIDTH, MLSTM_WIDTH, MLSTM_WIDTH, MLSTM_WIDTH,
             MLSTM_HEADS, MLSTM_HEADS, D_MODEL, D_MODEL)
IN_WIDTH = sum(IN_SPLITS)

kernel_name = 'hybrid_moba_mlstm_swiglu'


def rms_norm(x, g):
    xf = x.astype(jnp.float32)
    y = xf * lax.rsqrt(jnp.mean(xf * xf, axis=-1, keepdims=True) + NORM_EPS)
    return (y * g.astype(jnp.float32)).astype(x.dtype)


def to_heads(t, n_heads):
    b, s, w = t.shape
    return t.reshape(b, s, n_heads, w // n_heads).transpose(0, 2, 1, 3)


def from_heads(t):
    b, h, s, d = t.shape
    return t.transpose(0, 2, 1, 3).reshape(b, s, h * d)


def causal_depthwise_conv(x, w):
    width = w.shape[0]
    s = x.shape[1]
    xp = jnp.pad(x, ((0, 0), (width - 1, 0), (0, 0)))
    y = xp[:, 0:s] * w[0]
    for j in range(1, width):
        y = y + xp[:, j:j + s] * w[j]
    return y


def moba_attention(q, k, v, slopes):
    b, h, s, d = q.shape
    n_blk = -(-s // MOBA_BLOCK)
    s_pad = n_blk * MOBA_BLOCK
    pad = ((0, 0), (0, 0), (0, s_pad - s), (0, 0))
    k_pad = jnp.pad(k, pad)
    v_pad = jnp.pad(v, pad)
    k_blk = k_pad.reshape(b, h, n_blk, MOBA_BLOCK, d)
    v_blk = v_pad.reshape(b, h, n_blk, MOBA_BLOCK, d)
    k_mean = jnp.mean(k_blk.astype(jnp.float32), axis=3)
    top_k = min(MOBA_TOP_K, n_blk)
    n_sel = top_k * MOBA_BLOCK
    n_q = s // Q_BLOCK
    q_chunks = jnp.moveaxis(q.reshape(b, h, n_q, Q_BLOCK, d), 2, 0)
    b_ix = jnp.arange(b)[:, None, None, None]
    h_ix = jnp.arange(h)[None, :, None, None]
    blk_ids = jnp.arange(n_blk)
    key_off = jnp.arange(MOBA_BLOCK)
    scale = d ** -0.5
    slope = slopes[None, :, None, None]

    def one_block(args):
        q_i, q_blk = args
        t = q_blk * Q_BLOCK + jnp.arange(Q_BLOCK)
        own = (q_blk * Q_BLOCK) // MOBA_BLOCK
        qf = q_i.astype(jnp.float32)
        gate = jnp.einsum('bhqd,bhnd->bhqn', qf, k_mean)
        gate = jnp.where(blk_ids < own, gate, -jnp.inf)
        _, idx = lax.top_k(gate, top_k)
        k_sel = k_blk[b_ix, h_ix, idx].reshape(b, h, Q_BLOCK, n_sel, d)
        v_sel = v_blk[b_ix, h_ix, idx].reshape(b, h, Q_BLOCK, n_sel, d)
        pos_sel = (idx[..., None] * MOBA_BLOCK + key_off).reshape(b, h, Q_BLOCK, n_sel)
        valid_sel = jnp.repeat(jnp.arange(top_k) < own, MOBA_BLOCK)
        s_sel = jnp.einsum('bhqd,bhqkd->bhqk', qf, k_sel.astype(jnp.float32)) * scale
        s_sel = s_sel - slope * (t[:, None] - pos_sel)
        s_sel = jnp.where(valid_sel, s_sel, -jnp.inf)
        k_own = lax.dynamic_slice_in_dim(k_pad, own * MOBA_BLOCK, MOBA_BLOCK, axis=2)
        v_own = lax.dynamic_slice_in_dim(v_pad, own * MOBA_BLOCK, MOBA_BLOCK, axis=2)
        pos_own = own * MOBA_BLOCK + key_off
        s_own = jnp.einsum('bhqd,bhkd->bhqk', qf, k_own.astype(jnp.float32)) * scale
        s_own = s_own - slope * (t[:, None] - pos_own[None, :])
        s_own = jnp.where(pos_own[None, :] <= t[:, None], s_own, -jnp.inf)
        p = jax.nn.softmax(jnp.concatenate([s_sel, s_own], axis=-1), axis=-1)
        o = (jnp.einsum('bhqk,bhqkd->bhqd', p[..., :n_sel], v_sel.astype(jnp.float32))
             + jnp.einsum('bhqk,bhkd->bhqd', p[..., n_sel:], v_own.astype(jnp.float32)))
        return o.astype(q.dtype)

    out = lax.map(one_block, (q_chunks, jnp.arange(n_q)))
    return jnp.moveaxis(out, 0, 2).reshape(b, h, s, d)


def mlstm_chunkwise(q, k, v, log_i, log_f):
    b, h, s, d = q.shape
    L = MLSTM_CHUNK
    nc = s // L

    def chunks(t):
        return jnp.moveaxis(t.reshape((b, h, nc, L) + t.shape[3:]), 2, 0)

    qf = q.astype(jnp.float32)
    kf = k.astype(jnp.float32) * (d ** -0.5)
    vf = v.astype(jnp.float32)
    bcum = jnp.moveaxis(jnp.cumsum(log_f.reshape(b, h, nc, L), axis=-1), 2, 0)
    causal = jnp.tril(jnp.ones((L, L), dtype=bool))

    def step(carry, xs):
        C, n, m = carry
        qc, kc, vc, ic, bc = xs
        dmat = bc[..., :, None] - bc[..., None, :] + ic[..., None, :]
        dmat = jnp.where(causal, dmat, -jnp.inf)
        inter = bc + m[..., None]
        m_t = jnp.maximum(inter, jnp.max(dmat, axis=-1))
        w_intra = jnp.exp(dmat - m_t[..., None])
        w_inter = jnp.exp(inter - m_t)
        sc = jnp.einsum('bhtd,bhsd->bhts', qc, kc) * w_intra
        num = (w_inter[..., None] * jnp.einsum('bhtd,bhde->bhte', qc, C)
               + jnp.einsum('bhts,bhse->bhte', sc, vc))
        den = w_inter * jnp.einsum('bhtd,bhd->bht', qc, n) + jnp.sum(sc, axis=-1)
        h_out = num / jnp.maximum(jnp.abs(den), jnp.exp(-m_t))[..., None]
        b_last = bc[..., -1]
        g = b_last[..., None] - bc + ic
        m_new = jnp.maximum(b_last + m, jnp.max(g, axis=-1))
        w_s = jnp.exp(g - m_new[..., None])
        decay = jnp.exp(b_last + m - m_new)
        C = decay[..., None, None] * C + jnp.einsum('bhs,bhsd,bhse->bhde', w_s, kc, vc)
        n = decay[..., None] * n + jnp.einsum('bhs,bhsd->bhd', w_s, kc)
        return (C, n, m_new), h_out

    init = (jnp.zeros((b, h, d, d), jnp.float32),
            jnp.zeros((b, h, d), jnp.float32),
            jnp.zeros((b, h), jnp.float32))
    _, hs = lax.scan(step, init, (chunks(qf), chunks(kf), chunks(vf), chunks(log_i), bcum))
    return jnp.moveaxis(hs, 0, 2).reshape(b, h, s, d)


def head_layer_norm(h, g):
    mu = jnp.mean(h, axis=-1, keepdims=True)
    var = jnp.mean(jnp.square(h - mu), axis=-1, keepdims=True)
    nh, dh = h.shape[1], h.shape[3]
    return (h - mu) * lax.rsqrt(var + NORM_EPS) * g.astype(jnp.float32).reshape(nh, dh)[None, :, None, :]


def setup_inputs(seed: int = 0) -> dict:
    key = jax.random.key(seed)
    ks = jax.random.split(key, 16)
    f32 = jnp.float32
    nrm = lambda k, shp: jax.random.normal(k, shp, f32)
    return {
        'x': nrm(ks[0], (BATCH, SEQ, D_MODEL)),
        'mix_norm_g': 1.0 + 0.02 * nrm(ks[1], (DEPTH, D_MODEL)),
        'w_in': nrm(ks[2], (DEPTH, D_MODEL, IN_WIDTH)) * D_MODEL ** -0.5,
        'conv_qk': nrm(ks[3], (DEPTH, CONV_WIDTH, 2 * MLSTM_WIDTH)) * CONV_WIDTH ** -0.5,
        'b_igate': 0.1 * nrm(ks[4], (DEPTH, MLSTM_HEADS)),
        'b_fgate': jnp.linspace(3.0, 6.0, MLSTM_HEADS, dtype=f32)[None, :] + 0.1 * nrm(ks[5], (DEPTH, MLSTM_HEADS)),
        'mlstm_norm_g': 1.0 + 0.02 * nrm(ks[6], (DEPTH, MLSTM_WIDTH)),
        'w_out_attn': nrm(ks[7], (DEPTH, ATTN_WIDTH, D_MODEL)) * ATTN_WIDTH ** -0.5,
        'w_out_mlstm': nrm(ks[8], (DEPTH, MLSTM_WIDTH, D_MODEL)) * MLSTM_WIDTH ** -0.5,
        'w_o': nrm(ks[9], (DEPTH, D_MODEL, D_MODEL)) * D_MODEL ** -0.5,
        'ffn_norm_g': 1.0 + 0.02 * nrm(ks[10], (DEPTH, D_MODEL)),
        'w_ffn_gate': nrm(ks[11], (DEPTH, D_MODEL, FFN_HIDDEN)) * D_MODEL ** -0.5,
        'w_ffn_up': nrm(ks[12], (DEPTH, D_MODEL, FFN_HIDDEN)) * D_MODEL ** -0.5,
        'w_ffn_down': nrm(ks[13], (DEPTH, FFN_HIDDEN, D_MODEL)) * FFN_HIDDEN ** -0.5,
        'final_norm_g': 1.0 + 0.02 * nrm(ks[14], (D_MODEL,)),
    }


def reference(x, mix_norm_g, w_in, conv_qk, b_igate, b_fgate, mlstm_norm_g,
              w_out_attn, w_out_mlstm, w_o, ffn_norm_g, w_ffn_gate, w_ffn_up,
              w_ffn_down, final_norm_g):
    f32 = jnp.float32
    slopes = jnp.exp2(-8.0 * jnp.arange(1, ATTN_HEADS + 1, dtype=f32) / ATTN_HEADS)
    split_points = np.cumsum(IN_SPLITS)[:-1].tolist()
    for layer in range(DEPTH):
        h = rms_norm(x, mix_norm_g[layer])
        proj = h @ w_in[layer]
        (q_a, k_a, v_a, q_m, k_m, v_m, o_m, i_m, f_m, g_a, g_m) = jnp.split(proj, split_points, axis=-1)
        y_a = from_heads(moba_attention(to_heads(q_a, ATTN_HEADS), to_heads(k_a, ATTN_HEADS),
                                        to_heads(v_a, ATTN_HEADS), slopes))
        qk_m = jax.nn.silu(causal_depthwise_conv(jnp.concatenate([q_m, k_m], axis=-1), conv_qk[layer]))
        q_m, k_m = jnp.split(qk_m, 2, axis=-1)
        log_i = (i_m.astype(f32) + b_igate[layer].astype(f32)).transpose(0, 2, 1)
        log_f = jax.nn.log_sigmoid(f_m.astype(f32) + b_fgate[layer].astype(f32)).transpose(0, 2, 1)
        h_m = mlstm_chunkwise(to_heads(q_m, MLSTM_HEADS), to_heads(k_m, MLSTM_HEADS),
                              to_heads(v_m, MLSTM_HEADS), log_i, log_f)
        h_m = h_m * jax.nn.sigmoid(to_heads(o_m, MLSTM_HEADS).astype(f32))
        y_m = from_heads(head_layer_norm(h_m, mlstm_norm_g[layer])).astype(x.dtype)
        merged = (jax.nn.sigmoid(g_a) * (y_a @ w_out_attn[layer])
                  + jax.nn.sigmoid(g_m) * (y_m @ w_out_mlstm[layer]))
        x = x + merged @ w_o[layer]
        h = rms_norm(x, ffn_norm_g[layer])
        x = x + (jax.nn.silu(h @ w_ffn_gate[layer]) * (h @ w_ffn_up[layer])) @ w_ffn_down[layer]
    return rms_norm(x, final_norm_g)
```

```cpp
#include <hip/hip_runtime.h>
#include <cstdio>
#include <cstdint>
namespace pg8 {
#define PG8_LAS __attribute__((address_space(3)))
typedef unsigned short bf16_t;
typedef short bf16x8 __attribute__((ext_vector_type(8)));
typedef float f32x4 __attribute__((ext_vector_type(4)));
typedef unsigned u32x4 __attribute__((ext_vector_type(4)));
constexpr int BM = 256, BK = 64, HALF = 128, HTB = HALF * BK * 2  , STAGE_BYTES = 8 * HTB, NXCD = 8, WGM = 8;

__host__ __device__ __forceinline__ int lds_byte(int r, int c) { const int st = (r >> 4) * 2 + (c >> 5), rr = r & 15, cc = c & 31, ob = rr * 64 + cc * 2; return st * 1024 + (ob ^ (((ob >> 9) & 1) << 5)); }
__host__ __device__ __forceinline__ void stage_rc(int b, int& R, int& C) { const int st = b / 1024, sb = b % 1024, swz = sb ^ (((sb >> 9) & 1) << 5); R = (st >> 1) * 16 + swz / 64; C = (st & 1) * 32 + (swz % 64) / 2; }
__host__ __device__ __forceinline__ int perm32(int rho) { const int n = rho >> 4, i = rho & 15; return 8 * (i >> 2) + 4 * n + (i & 3); }

struct Unit { int pm, pn; };
struct Gemm { const bf16_t* A; const bf16_t* Bt; int M, N, K; };

struct StaticOrder {
    int nM, nN, nwg, G, c;
    __host__ __device__ void init(int M, int N, int G_, int c_) { nM = M / BM; nN = N / BM; nwg = nM * nN; G = G_; c = c_; }
    __host__ __device__ bool next(int i, Unit& u) const {
        const long L = (long)i * G + c; if (L >= nwg) return false;
        int wgid = (int)L; { const int q = nwg / NXCD, r = nwg % NXCD, xcd = wgid % NXCD, off = wgid / NXCD; wgid = (xcd < r ? xcd * (q + 1) : r * (q + 1) + (xcd - r) * q) + off; }
        const int nig = WGM * nN, gid = wgid / nig, fm = gid * WGM, gsz = (nM - fm) < WGM ? (nM - fm) : WGM;
        u.pm = fm + ((wgid % nig) % gsz); u.pn = (wgid % nig) / gsz; return true;
    }
    __device__ __forceinline__ void a_ready(const Unit&) const {}
    __device__ __forceinline__ void done(const Unit&) const {}
};

__device__ __forceinline__ unsigned cvt_pk_bf16(float lo, float hi) { unsigned r; asm volatile("v_cvt_pk_bf16_f32 %0, %1, %2" : "=v"(r) : "v"(lo), "v"(hi)); return r; }
typedef float f32x2 __attribute__((ext_vector_type(2)));
template <class Epi, class Sched, bool ALIGN_EPI = false, bool SP2 = false>
__device__ __forceinline__ void gemm_phase(PG8_LAS unsigned char* lds, const Gemm g, const Sched& S, const Epi& E) {
    const int tid = threadIdx.x, wid = __builtin_amdgcn_readfirstlane(tid >> 6), lane = tid & 63, wr = wid >> 2, wc = wid & 3, fr = lane & 15, fq = lane >> 4;
    const int K = g.K, nt = K / BK;
    unsigned voffA[2], voffB[2];
#pragma unroll
    for (int i = 0; i < 2; ++i) { int R, C; stage_rc(tid * 16 + i * 8192, R, C); const int Rb = Epi::PERM ? ((R & ~31) + perm32(R & 31)) : R;
        voffA[i] = (unsigned)(R * K + C) * 2u; voffB[i] = (unsigned)(Rb * K + C) * 2u; }
    const size_t kstep = (size_t)(BK * 2);
    const size_t hstep = (size_t)HALF * K * 2;
    const size_t tstep = 2 * hstep;
    const unsigned ldsw = (unsigned)wid * 1024u;
    const int aoff = lds_byte(wr * 64 + fr, fq * 8), boff = lds_byte(wc * 32 + fr, fq * 8);
#define PG8_SA(b, h) (((b) * 2 + (h)) * HTB)
#define PG8_SB(b, h) ((4 + (b) * 2 + (h)) * HTB)
#define PG8_STAGE(bufoff, gbase, voff) do { _Pragma("unroll") for (int _i = 0; _i < 2; ++_i) \
        __builtin_amdgcn_global_load_lds((const unsigned*)((const char*)(gbase) + (voff)[_i]), (PG8_LAS unsigned*)(lds + (bufoff) + ldsw + _i * 8192), 16, 0, 0); } while (0)
#define PG8_LDA(dst, b, h) do { _Pragma("unroll") for (int m = 0; m < 4; ++m) _Pragma("unroll") for (int k = 0; k < 2; ++k) dst[m][k] = *(const PG8_LAS bf16x8*)(lds + PG8_SA(b, h) + aoff + m * 2048 + k * 1024); } while (0)
#define PG8_LDB(dst, b, h) do { _Pragma("unroll") for (int n = 0; n < 2; ++n) _Pragma("unroll") for (int k = 0; k < 2; ++k) dst[n][k] = *(const PG8_LAS bf16x8*)(lds + PG8_SB(b, h) + boff + n * 2048 + k * 1024); } while (0)
#define PG8_MMA(ai, bj, At, Bt) do { __builtin_amdgcn_s_setprio(1); _Pragma("unroll") for (int m = 0; m < 4; ++m) _Pragma("unroll") for (int n = 0; n < 2; ++n) _Pragma("unroll") for (int k = 0; k < 2; ++k) \
        acc[ai][bj][m][n] = __builtin_amdgcn_mfma_f32_16x16x32_bf16(Bt[n][k], At[m][k], acc[ai][bj][m][n], 0, 0, 0); __builtin_amdgcn_s_setprio(0); } while (0)
#define PG8_WAIT_V(n) asm volatile("s_waitcnt vmcnt(" #n ")" ::: "memory")
#define PG8_WAIT_L(n) asm volatile("s_waitcnt lgkmcnt(" #n ")" ::: "memory")
#define PG8_BAR __builtin_amdgcn_s_barrier()
#define PG8_SCHED __builtin_amdgcn_sched_barrier(0)
    Unit cur, nxt; int ui = 0;
    if (!S.next(0, cur)) return;
    f32x4 acc[2][2][4][2];
#pragma unroll
    for (int a = 0; a < 2; ++a)
#pragma unroll
        for (int b = 0; b < 2; ++b)
#pragma unroll
            for (int m = 0; m < 4; ++m)
#pragma unroll
                for (int n = 0; n < 2; ++n) acc[a][b][m][n] = (f32x4){0.f, 0.f, 0.f, 0.f};
    bf16x8 At[4][2], B0[2][2], B1[2][2];
    const char* cA = (const char*)g.A + (size_t)cur.pm * tstep; const char* cB = (const char*)g.Bt + (size_t)cur.pn * tstep;
    S.a_ready(cur);
    if constexpr (SP2) {
        PG8_STAGE(PG8_SB(0, 0), cB, voffB); PG8_STAGE(PG8_SB(0, 1), cB + hstep, voffB); PG8_STAGE(PG8_SA(0, 0), cA, voffA); PG8_STAGE(PG8_SA(0, 1), cA + hstep, voffA);
        if (wr == 1) PG8_BAR;
        PG8_WAIT_V(2); PG8_BAR;
        PG8_STAGE(PG8_SB(1, 0), cB + kstep, voffB); PG8_STAGE(PG8_SA(1, 0), cA + kstep, voffA); PG8_STAGE(PG8_SB(1, 1), cB + hstep + kstep, voffB);
        PG8_WAIT_V(6); PG8_BAR;
    } else {
        PG8_STAGE(PG8_SB(0, 0), cB, voffB); PG8_STAGE(PG8_SA(0, 0), cA, voffA); PG8_STAGE(PG8_SB(0, 1), cB + hstep, voffB); PG8_STAGE(PG8_SA(0, 1), cA + hstep, voffA);
        if (wr == 1) PG8_BAR;
        PG8_WAIT_V(4); PG8_BAR;
        PG8_STAGE(PG8_SB(1, 0), cB + kstep, voffB); PG8_STAGE(PG8_SA(1, 0), cA + kstep, voffA); PG8_STAGE(PG8_SB(1, 1), cB + hstep + kstep, voffB);
        PG8_WAIT_V(6); PG8_BAR;
    }
    for (;;) {
        const bool has_next = S.next(ui + 1, nxt);
        const char* nA = has_next ? (const char*)g.A + (size_t)nxt.pm * tstep : cA; const char* nB = has_next ? (const char*)g.Bt + (size_t)nxt.pn * tstep : cB;
        for (int t = 0; t < nt; t += 2) {
            const bool last = (t == nt - 2);
            const char* a1 = cA + (size_t)(t + 1) * kstep;
            const char* a2 = last ? nA : cA + (size_t)(t + 2) * kstep; const char* b2 = last ? nB : cB + (size_t)(t + 2) * kstep;
            const char* a3 = a2 + kstep; const char* b3 = b2 + kstep;
            if (last && has_next) S.a_ready(nxt);
            if constexpr (SP2) {
            PG8_LDB(B0, 0, 0); PG8_LDB(B1, 0, 1); PG8_SCHED; PG8_LDA(At, 0, 0); PG8_STAGE(PG8_SA(1, 1), a1 + hstep, voffA);
            PG8_WAIT_V(8); PG8_WAIT_L(0); PG8_BAR; PG8_MMA(0, 0, At, B0); PG8_MMA(0, 1, At, B1); PG8_BAR; PG8_SCHED;
            PG8_LDA(At, 0, 1); PG8_STAGE(PG8_SB(0, 0), b2, voffB); PG8_STAGE(PG8_SB(0, 1), b2 + hstep, voffB); PG8_STAGE(PG8_SA(0, 0), a2, voffA);
            PG8_WAIT_V(8); PG8_WAIT_L(0); PG8_BAR; PG8_MMA(1, 0, At, B0); PG8_MMA(1, 1, At, B1); PG8_BAR; PG8_SCHED;
            PG8_LDB(B0, 1, 0); PG8_LDB(B1, 1, 1); PG8_SCHED; PG8_LDA(At, 1, 0); PG8_STAGE(PG8_SA(0, 1), a2 + hstep, voffA);
            PG8_WAIT_V(8); PG8_WAIT_L(0); PG8_BAR; PG8_MMA(0, 0, At, B0); PG8_MMA(0, 1, At, B1); PG8_BAR; PG8_SCHED;
            PG8_LDA(At, 1, 1); PG8_STAGE(PG8_SB(1, 0), b3, voffB); PG8_STAGE(PG8_SB(1, 1), b3 + hstep, voffB); PG8_STAGE(PG8_SA(1, 0), a3, voffA);
            PG8_WAIT_V(8); PG8_WAIT_L(0); PG8_BAR; PG8_MMA(1, 0, At, B0); PG8_MMA(1, 1, At, B1); PG8_BAR; PG8_SCHED;
            } else {
            PG8_LDB(B0, 0, 0); PG8_SCHED; PG8_LDA(At, 0, 0); PG8_STAGE(PG8_SA(1, 1), a1 + hstep, voffA);
            PG8_WAIT_L(8); PG8_BAR; PG8_WAIT_L(0); PG8_MMA(0, 0, At, B0); PG8_BAR; PG8_SCHED;
            PG8_LDB(B1, 0, 1); PG8_STAGE(PG8_SB(0, 0), b2, voffB);
            PG8_BAR; PG8_WAIT_L(0); PG8_MMA(0, 1, At, B1); PG8_BAR;
            PG8_LDA(At, 0, 1); PG8_STAGE(PG8_SA(0, 0), a2, voffA);
            PG8_BAR; PG8_WAIT_L(0); PG8_MMA(1, 0, At, B0); PG8_BAR; PG8_SCHED;
            PG8_STAGE(PG8_SB(0, 1), b2 + hstep, voffB);
            PG8_WAIT_V(6); PG8_BAR; PG8_MMA(1, 1, At, B1); PG8_BAR;
            PG8_LDB(B0, 1, 0); PG8_SCHED; PG8_LDA(At, 1, 0); PG8_STAGE(PG8_SA(0, 1), a2 + hstep, voffA);
            PG8_WAIT_L(8); PG8_BAR; PG8_WAIT_L(0); PG8_MMA(0, 0, At, B0); PG8_BAR; PG8_SCHED;
            PG8_LDB(B1, 1, 1); PG8_STAGE(PG8_SB(1, 0), b3, voffB);
            PG8_BAR; PG8_WAIT_L(0); PG8_MMA(0, 1, At, B1); PG8_BAR;
            PG8_LDA(At, 1, 1); PG8_STAGE(PG8_SA(1, 0), a3, voffA);
            PG8_BAR; PG8_WAIT_L(0); PG8_MMA(1, 0, At, B0); PG8_BAR; PG8_SCHED;
            PG8_STAGE(PG8_SB(1, 1), b3 + hstep, voffB);
            PG8_WAIT_V(6); PG8_BAR; PG8_MMA(1, 1, At, B1); PG8_BAR;
            }
        }
        if constexpr (ALIGN_EPI) { if (wr == 0) PG8_BAR; }
        if constexpr (!Epi::AFTER_DRAIN) { E(acc, cur, wr, wc, fr, fq); S.done(cur); }
        if (!has_next) break;
#pragma unroll
        for (int a = 0; a < 2; ++a)
#pragma unroll
            for (int b = 0; b < 2; ++b)
#pragma unroll
                for (int m = 0; m < 4; ++m)
#pragma unroll
                    for (int n = 0; n < 2; ++n) acc[a][b][m][n] = (f32x4){0.f, 0.f, 0.f, 0.f};
        cur = nxt; cA = nA; cB = nB; ++ui;
        if constexpr (ALIGN_EPI) { if (wr == 1) PG8_BAR; }
    }
    PG8_WAIT_V(0);
    if constexpr (!ALIGN_EPI) { if (wr == 0) PG8_BAR; }
    PG8_BAR;
    if constexpr (Epi::AFTER_DRAIN) { E.fused(acc, cur, wr, wc, fr, fq, lds, wid, lane); S.done(cur); }
#undef PG8_SA
#undef PG8_SB
#undef PG8_STAGE
#undef PG8_LDA
#undef PG8_LDB
#undef PG8_MMA
#undef PG8_WAIT_V
#undef PG8_WAIT_L
#undef PG8_BAR
#undef PG8_SCHED
}
}

#ifndef PG8_SP2
#define PG8_SP2 true
#endif
#ifndef PG8_ALIGN
#define PG8_ALIGN true
#endif
namespace pg8 {
__device__ __forceinline__ float sigmoidf_fast(float x) { return __builtin_amdgcn_rcpf(1.0f + __builtin_amdgcn_exp2f(-1.4426950408889634f * x)); }
__device__ __forceinline__ float bflo(unsigned w) { return __uint_as_float(w << 16); }
__device__ __forceinline__ float bfhi(unsigned w) { return __uint_as_float(w & 0xffff0000u); }

struct EpiIn {
    static constexpr bool PERM = true, AFTER_DRAIN = false;
    bf16_t* seg; bf16_t* gates; float qscale; int Mrows;
    __device__ __forceinline__ void operator()(const f32x4 (&acc)[2][2][4][2], const Unit& u, int wr, int wc, int fr, int fq) const {
        const int pn = u.pn; bf16_t* base; int ldc, colt, mode;
        if (pn < 14) { const int s = pn >> 1; base = seg + (size_t)s * Mrows * 512; ldc = 512; colt = (pn & 1) * 256; mode = (s == 0) ? 1 : 0; }
        else { const int g = (pn - 14) >> 2; base = gates + (size_t)g * Mrows * 1024; ldc = 1024; colt = ((pn - 14) & 3) * 256; mode = 2; }
        const int row0 = u.pm * BM + wr * 64 + fr, col0 = colt + wc * 32 + 8 * fq;
#pragma unroll
        for (int ai = 0; ai < 2; ++ai)
#pragma unroll
            for (int m = 0; m < 4; ++m) { bf16_t* rowp = base + (size_t)(row0 + ai * HALF + m * 16) * ldc + col0;
#pragma unroll
                for (int bj = 0; bj < 2; ++bj) { f32x4 v0 = acc[ai][bj][m][0], v1 = acc[ai][bj][m][1];
                    if (mode == 1) { v0 = v0 * qscale; v1 = v1 * qscale; }
                    else if (mode == 2) {
#pragma unroll
                        for (int e = 0; e < 4; ++e) { v0[e] = sigmoidf_fast(v0[e]); v1[e] = sigmoidf_fast(v1[e]); } }
                    u32x4 w; w.x = cvt_pk_bf16(v0[0], v0[1]); w.y = cvt_pk_bf16(v0[2], v0[3]); w.z = cvt_pk_bf16(v1[0], v1[1]); w.w = cvt_pk_bf16(v1[2], v1[3]);
                    *(u32x4*)(rowp + bj * HALF) = w; } }
    }
};
template <int MODE> struct EpiGate {
    static constexpr bool PERM = true, AFTER_DRAIN = false;
    const bf16_t* G; const bf16_t* P; bf16_t* O;
    __device__ __forceinline__ void operator()(const f32x4 (&acc)[2][2][4][2], const Unit& u, int wr, int wc, int fr, int fq) const {
        const int row0 = u.pm * BM + wr * 64 + fr, col0 = u.pn * BM + wc * 32 + 8 * fq;
#pragma unroll
        for (int ai = 0; ai < 2; ++ai)
#pragma unroll
            for (int m = 0; m < 4; ++m) { const size_t off = (size_t)(row0 + ai * HALF + m * 16) * 1024 + col0;
#pragma unroll
                for (int bj = 0; bj < 2; ++bj) { const f32x4 v0 = acc[ai][bj][m][0], v1 = acc[ai][bj][m][1];
                    const u32x4 g = *(const u32x4*)(G + off + bj * HALF);
                    float r[8] = { bflo(g.x) * v0[0], bfhi(g.x) * v0[1], bflo(g.y) * v0[2], bfhi(g.y) * v0[3], bflo(g.z) * v1[0], bfhi(g.z) * v1[1], bflo(g.w) * v1[2], bfhi(g.w) * v1[3] };
                    if (MODE == 1) { const u32x4 p = *(const u32x4*)(P + off + bj * HALF);
                        r[0] += bflo(p.x); r[1] += bfhi(p.x); r[2] += bflo(p.y); r[3] += bfhi(p.y); r[4] += bflo(p.z); r[5] += bfhi(p.z); r[6] += bflo(p.w); r[7] += bfhi(p.w); }
                    u32x4 w; w.x = cvt_pk_bf16(r[0], r[1]); w.y = cvt_pk_bf16(r[2], r[3]); w.z = cvt_pk_bf16(r[4], r[5]); w.w = cvt_pk_bf16(r[6], r[7]);
                    *(u32x4*)(O + off + bj * HALF) = w; } }
    }
};
template <bool WITH_BF> struct EpiRes {
    static constexpr bool PERM = false, AFTER_DRAIN = false;
    const float* base; float* out; bf16_t* xb; float* ssq;
    __device__ __forceinline__ void operator()(const f32x4 (&acc)[2][2][4][2], const Unit& u, int wr, int wc, int fr, int fq) const {
        typedef unsigned u32x2v __attribute__((ext_vector_type(2)));
        const int row0 = u.pm * BM + wr * 64 + fr, col0 = u.pn * BM + wc * 32 + 4 * fq;
#pragma unroll
        for (int ai = 0; ai < 2; ++ai)
#pragma unroll
            for (int m = 0; m < 4; ++m) { const int row = row0 + ai * HALF + m * 16; const size_t off = (size_t)row * 1024 + col0; float ss = 0.f;
#pragma unroll
                for (int bj = 0; bj < 2; ++bj)
#pragma unroll
                    for (int n = 0; n < 2; ++n) { const size_t o2 = off + bj * HALF + n * 16; const f32x4 o = *(const f32x4*)(base + o2) + acc[ai][bj][m][n];
                        *(f32x4*)(out + o2) = o; ss += (o[0] * o[0] + o[1] * o[1]) + (o[2] * o[2] + o[3] * o[3]);
                        if (WITH_BF) { u32x2v w; w.x = cvt_pk_bf16(o[0], o[1]); w.y = cvt_pk_bf16(o[2], o[3]); *(u32x2v*)(xb + o2) = w; } }
                ss += __shfl_xor(ss, 16); ss += __shfl_xor(ss, 32);
                if (fq == 0) ssq[(size_t)row * 16 + u.pn * 4 + wc] = ss; }
    }
};
struct EpiSwiGLU {
    static constexpr bool PERM = true, AFTER_DRAIN = false;
    const float* ssq; bf16_t* Hd; int ldh; float eps;
    __device__ __forceinline__ void operator()(const f32x4 (&acc)[2][2][4][2], const Unit& u, int wr, int wc, int fr, int fq) const {
        const int row0 = u.pm * BM + wr * 64 + fr, col0 = u.pn * HALF + wc * 32 + 8 * fq;
#pragma unroll
        for (int ai = 0; ai < 2; ++ai)
#pragma unroll
            for (int m = 0; m < 4; ++m) { const int row = row0 + ai * HALF + m * 16; const f32x4* sp = (const f32x4*)(ssq + (size_t)row * 16);
                const f32x4 s0 = sp[0], s1 = sp[1], s2 = sp[2], s3 = sp[3];
                const float tot = ((s0[0] + s0[1]) + (s0[2] + s0[3])) + ((s1[0] + s1[1]) + (s1[2] + s1[3])) + ((s2[0] + s2[1]) + (s2[2] + s2[3])) + ((s3[0] + s3[1]) + (s3[2] + s3[3]));
                const float rs = 1.0f / sqrtf(tot * (1.0f / 1024.0f) + eps);
                float r[8];
#pragma unroll
                for (int n = 0; n < 2; ++n)
#pragma unroll
                    for (int e = 0; e < 4; ++e) { const float g = acc[ai][0][m][n][e] * rs, up = acc[ai][1][m][n][e] * rs; r[n * 4 + e] = g * sigmoidf_fast(g) * up; }
                u32x4 w; w.x = cvt_pk_bf16(r[0], r[1]); w.y = cvt_pk_bf16(r[2], r[3]); w.z = cvt_pk_bf16(r[4], r[5]); w.w = cvt_pk_bf16(r[6], r[7]);
                *(u32x4*)(Hd + (size_t)row * ldh + col0) = w; }
    }
};
}
#define GAS __attribute__((address_space(1)))
#define LAS __attribute__((address_space(3)))
typedef unsigned short bf16;
typedef unsigned v4u __attribute__((ext_vector_type(4)));
typedef float f32x4 __attribute__((ext_vector_type(4)));
typedef short bf16x8 __attribute__((ext_vector_type(8)));
typedef GAS unsigned gu32;
typedef GAS unsigned long long gu64;
#define RLX_AGENT __ATOMIC_RELAXED, __HIP_MEMORY_SCOPE_AGENT
#define LDS_WAIT() asm volatile("s_waitcnt lgkmcnt(0)" ::: "memory")
#define VM_WAIT() asm volatile("s_waitcnt vmcnt(0)" ::: "memory")
__device__ __forceinline__ unsigned long long rt() { return __builtin_amdgcn_s_memrealtime(); }
__device__ __forceinline__ unsigned f2bf(float f) { unsigned u = __builtin_bit_cast(unsigned, f); return (u + 0x7fffu + ((u >> 16) & 1u)) >> 16; }
__device__ __forceinline__ unsigned pk2(float lo, float hi) { return f2bf(lo) | (f2bf(hi) << 16); }

#define XB_TMO      128
#define XB_XCNT(j)  (256  + 64 * (j))
#define XB_XSUB(j)  (1280 + 64 * (j))
#define XB_XGEN(j)  (2304 + 64 * (j))
#define XB_TOP      3328
#define XB_TOPGEN   3392
#define XCD_BAR_WORDS 3456
#define XB_SPIN_CAP (1u << 18)

__device__ __forceinline__ unsigned xb_ld(unsigned* p)              { return __hip_atomic_load(p, __ATOMIC_RELAXED, __HIP_MEMORY_SCOPE_AGENT); }
__device__ __forceinline__ unsigned xb_add(unsigned* p, unsigned v) { return __hip_atomic_fetch_add(p, v, __ATOMIC_RELAXED, __HIP_MEMORY_SCOPE_AGENT); }
__device__ __forceinline__ unsigned xb_xcc_id() { return (unsigned)__builtin_amdgcn_s_getreg((3 << 11) | 20) & 0xFu; }
#define XB_SPIN(cond, bar) do { unsigned _sp = 0; while (cond) { __builtin_amdgcn_s_sleep(1); \
    if ((++_sp & 255u) == 0u) { if (xb_ld(&(bar)[XB_TMO])) break; if (_sp > XB_SPIN_CAP) { atomicAdd(&(bar)[XB_TMO], 1u); break; } } } } while (0)

struct XcdBarrier {
    unsigned* bar; unsigned x;
    volatile LAS unsigned* st;
};

__device__ __forceinline__ XcdBarrier xcd_barrier_post(unsigned* bar, volatile LAS unsigned* st) {
    XcdBarrier b; b.bar = bar; b.x = xb_xcc_id(); b.st = st;
    if (threadIdx.x == 0) (void)xb_add(&bar[XB_XCNT(b.x)], 1u);
    return b;
}
__device__ __forceinline__ void xcd_barrier_complete(unsigned* bar, unsigned x, unsigned& nloc, unsigned& nx) {
    const unsigned G = gridDim.x * gridDim.y * gridDim.z;
    unsigned sum, cnt, mine, sp = 0u;
    for (;;) {
        sum = 0u; cnt = 0u; mine = 0u;
#pragma unroll
        for (unsigned j = 0; j < 16; ++j) { const unsigned c = xb_ld(&bar[XB_XCNT(j)]); sum += c; cnt += (c > 0u) ? 1u : 0u; mine = (j == x) ? c : mine; }
        if (sum == G) break;
        __builtin_amdgcn_s_sleep(1);
        if ((++sp & 255u) == 0u) { if (xb_ld(&bar[XB_TMO])) break; if (sp > XB_SPIN_CAP) { atomicAdd(&bar[XB_TMO], 1u); break; } }
    }
    nloc = mine > 0u ? mine : 1u; nx = cnt > 0u ? cnt : 1u;
}

__device__ __forceinline__ void xcd_barrier(const XcdBarrier& b) {
    asm volatile("s_waitcnt vmcnt(0)" ::: "memory");
    __syncthreads();
    if (threadIdx.x == 0) {
        unsigned* bar = b.bar;
        __builtin_amdgcn_s_waitcnt(0);
        unsigned nloc = b.st[0], nx = b.st[1];
        if (nloc == 0u) { xcd_barrier_complete(bar, b.x, nloc, nx); b.st[0] = nloc; b.st[1] = nx; }
        const unsigned old = xb_add(&bar[XB_XSUB(b.x)], 1u);
        const unsigned gen = old / nloc;
        if (old + 1u == (gen + 1u) * nloc) {
            __builtin_amdgcn_fence(__ATOMIC_RELEASE, "agent");
            asm volatile("s_waitcnt vmcnt(0)" ::: "memory");
            const unsigned og = xb_add(&bar[XB_TOP], 1u);
            const unsigned tg = og / nx;
            if (og + 1u == (tg + 1u) * nx) xb_add(&bar[XB_TOPGEN], 1u);
            else XB_SPIN(xb_ld(&bar[XB_TOPGEN]) == tg, bar);
            __builtin_amdgcn_fence(__ATOMIC_ACQUIRE, "agent");
            xb_add(&bar[XB_XGEN(b.x)], 1u);
            asm volatile("s_waitcnt vmcnt(0)" ::: "memory");
        } else {
            XB_SPIN(xb_ld(&bar[XB_XGEN(b.x)]) == gen, bar);
            __builtin_amdgcn_fence(__ATOMIC_ACQUIRE, "agent");
            asm volatile("s_waitcnt vmcnt(0)" ::: "memory");
        }
    }
    __syncthreads();
}
constexpr int NWAVES = 8;
constexpr int N_PHASES = 12;
#ifndef MK_N_LAUNCHES
#define MK_N_LAUNCHES 12
#endif
constexpr int N_LAUNCHES = MK_N_LAUNCHES;

constexpr int M = 16384, D = 1024, NIN = 5632, FF = 2816, INW = 5640;
constexpr int AH = 8, AD = 64, AW = 512, MH = 4, MD = 128, MW = 512, NBLK = 64, NCH = 128, CL = 128;
constexpr float EPS = 1e-6f;
constexpr float LOG2E = 1.4426950408889634f;
constexpr float C2 = 0.125f * LOG2E;

constexpr size_t MiB = 1u << 20;
constexpr size_t WS_CTL = 0, CTL_ZERO_BYTES = 1 * MiB;
constexpr size_t WS_WIN = 1 * MiB;
constexpr size_t WS_WGU = 12 * MiB;
constexpr size_t WS_WD = 23 * MiB;
constexpr size_t WS_WO = 29 * MiB;
constexpr size_t WS_WA = 31 * MiB;
constexpr size_t WS_WM = 32 * MiB;
constexpr size_t WS_MISC = 33 * MiB;
constexpr size_t MS_LOGI = WS_MISC;
constexpr size_t MS_LOGF = MS_LOGI + 256 * 1024;
constexpr size_t MS_BCUM = MS_LOGF + 256 * 1024;
constexpr size_t MS_KMEAN = MS_BCUM + 256 * 1024;
constexpr size_t MS_SEL = MS_KMEAN + 128 * 1024;
constexpr size_t MS_CHS = MS_SEL + 512 * 1024;
constexpr size_t MS_NST = MS_CHS + 64 * 1024;
constexpr size_t MS_SSQ1 = MS_NST + 256 * 1024;
constexpr size_t MS_SSQ2 = MS_SSQ1 + 1024 * 1024;
static_assert(MS_SSQ2 + 1024 * 1024 <= 40 * MiB, "misc");
constexpr size_t WS_A = 40 * MiB;
constexpr size_t WS_B = 72 * MiB;
constexpr size_t WS_C = 120 * MiB;
constexpr size_t WS_D = 184 * MiB;
constexpr size_t WS_HID = 72 * MiB;
constexpr size_t WS_END = 256 * MiB;
static_assert(WS_HID + (size_t)M * FF * 2 <= WS_D, "hidden overlay");

constexpr int CW_TMO = 0, CW_CODE = 1, CW_BAR = 4096;

constexpr int RING_OFF = 0, RING_BYTES = 131072;
constexpr int LDS_BYTES = 147456;
constexpr int LDSCTL_OFF = LDS_BYTES - 512, MISC_OFF = LDSCTL_OFF + 320;


__device__ __forceinline__ float bf2f(unsigned short v) { return __uint_as_float((unsigned)v << 16); }
__device__ __forceinline__ float blo(unsigned w) { return __uint_as_float(w << 16); }
__device__ __forceinline__ float bhi(unsigned w) { return __uint_as_float(w & 0xffff0000u); }
__device__ __forceinline__ float wave_sum(float v) {
#pragma unroll
    for (int o = 1; o < 64; o <<= 1) v += __shfl_xor(v, o);
    return v;
}
__device__ __forceinline__ float wave_max(float v) {
#pragma unroll
    for (int o = 1; o < 64; o <<= 1) v = fmaxf(v, __shfl_xor(v, o));
    return v;
}
__device__ __forceinline__ float sigm(float x) { return 1.0f / (1.0f + __expf(-x)); }

struct Frame {
    LAS unsigned char* lds;
    volatile LAS unsigned* MISC;
    gu32* ctl;
    int tid, lane, wave, vcu, G;
    const float *x, *mix_g, *w_in, *conv_qk, *b_ig, *b_fg, *mnorm_g, *w_oa, *w_om, *w_o, *ffn_g, *w_fg, *w_fu, *w_fd, *fin_g;
    float* out; unsigned char* ws;
};
#define WSP(T, off) ((T*)(F.ws + (off)))

__device__ __forceinline__ void tr_item(const float* W, int ldw, int k0, int n_src0, bf16* WT, int ldt, int dst_row0, const float* kscale, LAS float* scr, int lane) {
#pragma unroll 8
    for (int i = 0; i < 32; ++i) { const int kk = 2 * i + (lane >> 5); float v = W[(size_t)(k0 + kk) * ldw + n_src0 + (lane & 31)]; if (kscale) v *= kscale[k0 + kk]; scr[kk * 33 + (lane & 31)] = v; }
    LDS_WAIT(); asm volatile("" ::: "memory");
    const int c = lane & 7;
#pragma unroll
    for (int j = 0; j < 4; ++j) { const int n = (lane >> 3) + 8 * j; const LAS float* s = scr + (8 * c) * 33 + n;
        v4u o; o.x = pk2(s[0 * 33], s[1 * 33]); o.y = pk2(s[2 * 33], s[3 * 33]); o.z = pk2(s[4 * 33], s[5 * 33]); o.w = pk2(s[6 * 33], s[7 * 33]);
        *(GAS v4u*)(WT + (size_t)(dst_row0 + n) * ldt + k0 + 8 * c) = o; }
    LDS_WAIT(); asm volatile("" ::: "memory");
}
__device__ __forceinline__ float log_sigmoid(float z) { return fminf(z, 0.f) - log1pf(__expf(-fabsf(z))); }

__device__ __forceinline__ void p0_prologue(Frame& F) {
    const int gw = F.vcu * NWAVES + F.wave, NGW = F.G * NWAVES, lane = F.lane;
    LAS float* gt = (LAS float*)(F.lds + RING_OFF);
    for (int i = F.tid; i < 8192; i += NWAVES * 64) { const int k = i >> 3, c = i & 7; gt[c * 1024 + k] = F.w_in[(size_t)k * INW + 3584 + c]; }
    __syncthreads();
    LAS float* scr = (LAS float*)(F.lds + RING_OFF + 32768 + F.wave * 8704);
    constexpr int I_IN = 16 * 176, I_GU = 16 * 88, I_D = 44 * 32, I_O = 16 * 32, I_A = 8 * 32;
    constexpr int NITEMS = I_IN + 2 * I_GU + I_D + I_O + 2 * I_A;
    bf16* Win = WSP(bf16, WS_WIN); bf16* Wgu = WSP(bf16, WS_WGU); bf16* Wd = WSP(bf16, WS_WD); bf16* Wo = WSP(bf16, WS_WO); bf16* Wa = WSP(bf16, WS_WA); bf16* Wm = WSP(bf16, WS_WM);
    for (int it = gw; it < NITEMS; it += NGW) {
        int r = it;
        if (r < I_IN) { const int kb = r / 176, nb = r % 176; const int ns = nb < 112 ? 32 * nb : 3592 + 32 * (nb - 112), nd = nb < 112 ? 32 * nb : 3584 + 32 * (nb - 112);
            tr_item(F.w_in, INW, 64 * kb, ns, Win, D, nd, nullptr, scr, lane); continue; } r -= I_IN;
        if (r < I_GU) { const int kb = r / 88, nb = r % 88; tr_item(F.w_fg, FF, 64 * kb, 32 * nb, Wgu, D, 256 * (nb >> 2) + 32 * (nb & 3), F.ffn_g, scr, lane); continue; } r -= I_GU;
        if (r < I_GU) { const int kb = r / 88, nb = r % 88; tr_item(F.w_fu, FF, 64 * kb, 32 * nb, Wgu, D, 256 * (nb >> 2) + 128 + 32 * (nb & 3), F.ffn_g, scr, lane); continue; } r -= I_GU;
        if (r < I_D) { const int kb = r / 32, nb = r % 32; tr_item(F.w_fd, D, 64 * kb, 32 * nb, Wd, FF, 32 * nb, nullptr, scr, lane); continue; } r -= I_D;
        if (r < I_O) { const int kb = r / 32, nb = r % 32; tr_item(F.w_o, D, 64 * kb, 32 * nb, Wo, D, 32 * nb, nullptr, scr, lane); continue; } r -= I_O;
        if (r < I_A) { const int kb = r / 32, nb = r % 32; tr_item(F.w_oa, D, 64 * kb, 32 * nb, Wa, AW, 32 * nb, nullptr, scr, lane); continue; } r -= I_A;
        { const int kb = r / 32, nb = r % 32; tr_item(F.w_om, D, 64 * kb, 32 * nb, Wm, MW, 32 * nb, nullptr, scr, lane); }
    }
    bf16* Hn = WSP(bf16, WS_A); float* logi = WSP(float, MS_LOGI); float* logf = WSP(float, MS_LOGF);
    f32x4 gv[4];
#pragma unroll
    for (int j = 0; j < 4; ++j) gv[j] = ((const GAS f32x4*)F.mix_g)[lane + 64 * j];
    for (int m = gw; m < M; m += NGW) {
        const GAS f32x4* xr = (const GAS f32x4*)(F.x + (size_t)m * D) + lane;
        f32x4 v[4]; float s = 0.f;
#pragma unroll
        for (int j = 0; j < 4; ++j) { v[j] = xr[64 * j]; s += (v[j].x * v[j].x + v[j].y * v[j].y) + (v[j].z * v[j].z + v[j].w * v[j].w); }
        const float rstd = 1.0f / sqrtf(wave_sum(s) * (1.f / D) + EPS);
#pragma unroll
        for (int j = 0; j < 4; ++j) v[j] = v[j] * rstd * gv[j];
        GAS unsigned long long* o8 = (GAS unsigned long long*)(Hn + (size_t)m * D) + lane;
#pragma unroll
        for (int j = 0; j < 4; ++j) o8[64 * j] = (unsigned long long)pk2(v[j].x, v[j].y) | ((unsigned long long)pk2(v[j].z, v[j].w) << 32);
        float ga[8];
#pragma unroll
        for (int c = 0; c < 8; ++c) { float a = 0.f;
#pragma unroll
            for (int j = 0; j < 4; ++j) { const f32x4 w = *(const LAS f32x4*)(gt + c * 1024 + 4 * lane + 256 * j); a += (v[j].x * w.x + v[j].y * w.y) + (v[j].z * w.z + v[j].w * w.w); }
            ga[c] = wave_sum(a); }
#pragma unroll
        for (int c = 0; c < 4; ++c) { if (lane == c) logi[(size_t)m * 4 + c] = ga[c] + F.b_ig[c]; if (lane == 4 + c) logf[(size_t)m * 4 + c] = log_sigmoid(ga[4 + c] + F.b_fg[c]); }
    }
}

__device__ __forceinline__ float wave_incl_scan(float v, int lane) {
#pragma unroll
    for (int o = 1; o < 64; o <<= 1) { const float t = __shfl_up(v, o); if (lane >= o) v += t; }
    return v;
}
__device__ __forceinline__ void p2_prep(Frame& F) {
    const int gw = F.vcu * NWAVES + F.wave, NGW = F.G * NWAVES, lane = F.lane;
    const bf16* ka = WSP(bf16, WS_B) + (size_t)M * 512;
    float* kmean = WSP(float, MS_KMEAN);
    for (int it = gw; it < AH * NBLK; it += NGW) { const int h = it >> 6, j = it & 63; float s = 0.f;
        for (int r = 0; r < 256; ++r) s += bf2f(ka[(size_t)(j * 256 + r) * 512 + h * 64 + lane]);
        kmean[(size_t)it * 64 + lane] = s * (1.0f / 256.0f); }
    const float* logi = WSP(float, MS_LOGI); const float* logf = WSP(float, MS_LOGF); float* bcum = WSP(float, MS_BCUM); float* chs = WSP(float, MS_CHS);
    for (int it = gw; it < MH * NCH; it += NGW) { const int h = it >> 7, c = it & 127, t0 = c * CL;
        float v0 = logf[(size_t)(t0 + lane) * 4 + h], v1 = logf[(size_t)(t0 + 64 + lane) * 4 + h];
        v0 = wave_incl_scan(v0, lane); const float tot0 = __shfl(v0, 63); v1 = wave_incl_scan(v1, lane) + tot0; const float bl = __shfl(v1, 63);
        bcum[(size_t)h * M + t0 + lane] = v0; bcum[(size_t)h * M + t0 + 64 + lane] = v1;
        const float g0 = bl - v0 + logi[(size_t)(t0 + lane) * 4 + h], g1 = bl - v1 + logi[(size_t)(t0 + 64 + lane) * 4 + h];
        const float gm = wave_max(fmaxf(g0, g1));
        if (lane == 0) { chs[0 * 512 + it] = bl; chs[1 * 512 + it] = gm; } }
    const bf16* qm = WSP(bf16, WS_C); const bf16* km = WSP(bf16, WS_C) + (size_t)M * 512;
    bf16* qc = (bf16*)F.out; bf16* kc = (bf16*)F.out + (size_t)M * 512;
    const int gt = F.vcu * (NWAVES * 64) + F.tid, NGT = F.G * NWAVES * 64;
    for (int it = gt; it < M * 128; it += NGT) { const int t = it >> 7, cg = it & 127; const bool isk = cg >= 64; const int c0 = (cg & 63) * 8;
        const bf16* src = isk ? km : qm; float acc[8];
#pragma unroll
        for (int e = 0; e < 8; ++e) acc[e] = 0.f;
#pragma unroll
        for (int j = 0; j < 4; ++j) { const int tt = t - 3 + j; if (tt >= 0) { const v4u w = *(const GAS v4u*)(src + (size_t)tt * 512 + c0); const float* cw = F.conv_qk + (size_t)j * 1024 + cg * 8;
                acc[0] += blo(w.x) * cw[0]; acc[1] += bhi(w.x) * cw[1]; acc[2] += blo(w.y) * cw[2]; acc[3] += bhi(w.y) * cw[3]; acc[4] += blo(w.z) * cw[4]; acc[5] += bhi(w.z) * cw[5]; acc[6] += blo(w.w) * cw[6]; acc[7] += bhi(w.w) * cw[7]; } }
        const float sc = isk ? 0.08838834764831845f : 1.0f;
#pragma unroll
        for (int e = 0; e < 8; ++e) acc[e] = acc[e] * sigm(acc[e]) * sc;
        v4u o; o.x = pk2(acc[0], acc[1]); o.y = pk2(acc[2], acc[3]); o.z = pk2(acc[4], acc[5]); o.w = pk2(acc[6], acc[7]);
        *(GAS v4u*)((isk ? kc : qc) + (size_t)t * 512 + c0) = o; }
}

__device__ __forceinline__ void p3_gate_cloc(Frame& F) {
    const int lane = F.lane, tid = F.tid;
    {
        const bf16* qa = WSP(bf16, WS_B); const float* kmean = WSP(float, MS_KMEAN); unsigned* sel = WSP(unsigned, MS_SEL);
        LAS float* kl = (LAS float*)(F.lds + RING_OFF);
        for (int qg = F.vcu; qg < M / 64; qg += F.G) {
            const int b = (qg * 64) >> 8;
            __syncthreads();
            for (int i = tid; i < 8 * 64 * 16; i += NWAVES * 64) { const int h = i >> 10, rem = i & 1023; if ((rem >> 4) < b) *(LAS f32x4*)(kl + h * 4096 + rem * 4) = *(const GAS f32x4*)(kmean + h * 4096 + rem * 4); }
            __syncthreads();
            const int h = F.wave, q = qg * 64 + lane;
            float qf[64];
            { const GAS v4u* qp = (const GAS v4u*)(qa + (size_t)q * 512 + h * 64);
#pragma unroll
              for (int i = 0; i < 8; ++i) { const v4u w = qp[i]; qf[8 * i + 0] = blo(w.x); qf[8 * i + 1] = bhi(w.x); qf[8 * i + 2] = blo(w.y); qf[8 * i + 3] = bhi(w.y); qf[8 * i + 4] = blo(w.z); qf[8 * i + 5] = bhi(w.z); qf[8 * i + 6] = blo(w.w); qf[8 * i + 7] = bhi(w.w); } }
            float v0 = -INFINITY, v1 = -INFINITY, v2 = -INFINITY; int j0 = 0, j1 = 0, j2 = 0;
            for (int j = 0; j < b; ++j) { const LAS f32x4* kp = (const LAS f32x4*)(kl + h * 4096 + j * 64); float s = 0.f;
#pragma unroll
                for (int i = 0; i < 16; ++i) { const f32x4 k4 = kp[i]; s += (qf[4 * i] * k4.x + qf[4 * i + 1] * k4.y) + (qf[4 * i + 2] * k4.z + qf[4 * i + 3] * k4.w); }
                if (s > v2) { if (s > v1) { v2 = v1; j2 = j1; if (s > v0) { v1 = v0; j1 = j0; v0 = s; j0 = j; } else { v1 = s; j1 = j; } } else { v2 = s; j2 = j; } } }
            const int n = b < 3 ? b : 3;
            sel[(size_t)q * 8 + h] = (unsigned)j0 | ((unsigned)j1 << 8) | ((unsigned)j2 << 16) | ((unsigned)n << 24);
        }
        __syncthreads();
    }
    {
        const bf16* kc = (const bf16*)F.out + (size_t)M * 512; const bf16* vm = WSP(bf16, WS_C) + (size_t)2 * M * 512;
        const float* logi = WSP(float, MS_LOGI); const float* bcum = WSP(float, MS_BCUM); float* chs = WSP(float, MS_CHS);
        float* Cl = WSP(float, WS_A); float* nst = WSP(float, MS_NST);
        LAS bf16* KW = (LAS bf16*)(F.lds + RING_OFF); LAS bf16* VV = (LAS bf16*)(F.lds + RING_OFF + 32768); LAS float* sh = (LAS float*)(F.lds + RING_OFF + 65536);
        for (int it = F.vcu; it < MH * NCH; it += F.G) { const int h = it >> 7, c = it & 127, t0 = c * CL;
            __syncthreads();
            if (tid == 0) { float m = 0.f, mp = 0.f; for (int cc = 0; cc <= c; ++cc) { mp = m; m = fmaxf(chs[0 * 512 + h * 128 + cc] + m, chs[1 * 512 + h * 128 + cc]); }
                sh[0] = mp; sh[1] = m; const float bl = chs[0 * 512 + it]; chs[2 * 512 + it] = mp; chs[3 * 512 + it] = m; chs[4 * 512 + it] = __expf(bl + mp - m); }
            __syncthreads();
            if (tid < 128) { const float bl = chs[0 * 512 + it]; sh[8 + tid] = __expf(bl - bcum[(size_t)h * M + t0 + tid] + logi[(size_t)(t0 + tid) * 4 + h] - sh[1]); }
            __syncthreads();
#pragma unroll
            for (int i = 0; i < 4; ++i) { const int idx = tid + 512 * i, r = idx >> 4, ci = idx & 15; const float w = sh[8 + r];
                const v4u kk = *(const GAS v4u*)(kc + (size_t)(t0 + r) * 512 + h * 128 + ci * 8); v4u o;
                o.x = pk2(blo(kk.x) * w, bhi(kk.x) * w); o.y = pk2(blo(kk.y) * w, bhi(kk.y) * w); o.z = pk2(blo(kk.z) * w, bhi(kk.z) * w); o.w = pk2(blo(kk.w) * w, bhi(kk.w) * w);
                *(LAS v4u*)(KW + r * 128 + ci * 8) = o;
                *(LAS v4u*)(VV + r * 128 + ci * 8) = *(const GAS v4u*)(vm + (size_t)(t0 + r) * 512 + h * 128 + ci * 8); }
            __syncthreads();
            const int dk = tid >> 2, e0 = (tid & 3) * 32; float acc[32]; float ns = 0.f;
#pragma unroll
            for (int e = 0; e < 32; ++e) acc[e] = 0.f;
            for (int s = 0; s < 128; ++s) { const float a = bf2f(KW[s * 128 + dk]); ns += a;
#pragma unroll
                for (int i = 0; i < 4; ++i) { const v4u w = *(const LAS v4u*)(VV + s * 128 + e0 + 8 * i);
                    acc[8 * i + 0] += a * blo(w.x); acc[8 * i + 1] += a * bhi(w.x); acc[8 * i + 2] += a * blo(w.y); acc[8 * i + 3] += a * bhi(w.y); acc[8 * i + 4] += a * blo(w.z); acc[8 * i + 5] += a * bhi(w.z); acc[8 * i + 6] += a * blo(w.w); acc[8 * i + 7] += a * bhi(w.w); } }
            float* dst = Cl + ((size_t)it * 128 + dk) * 128 + e0;
#pragma unroll
            for (int i = 0; i < 8; ++i) *(GAS f32x4*)(dst + 4 * i) = (f32x4){acc[4 * i], acc[4 * i + 1], acc[4 * i + 2], acc[4 * i + 3]};
            if ((tid & 3) == 0) nst[(size_t)it * 128 + dk] = ns;
        }
        __syncthreads();
    }
}

__device__ __forceinline__ void p4_attn_scan(Frame& F) {
    const int lane = F.lane, tid = F.tid;
    {
        float* Cl = WSP(float, WS_A); float* nst = WSP(float, MS_NST); const float* chs = WSP(float, MS_CHS);
        const int gt = F.vcu * (NWAVES * 64) + tid, NGT = F.G * NWAVES * 64;
        for (int idx = gt; idx < MH * 16384 + MH * 128; idx += NGT) {
            if (idx < MH * 16384) { const int h = idx >> 14, el = idx & 16383; float a = 0.f;
                for (int c = 0; c < NCH; ++c) { float* p = Cl + ((size_t)(h * 128 + c) << 14) + el; a = chs[4 * 512 + h * 128 + c] * a + *p; *p = a; } }
            else { const int i2 = idx - MH * 16384, h = i2 >> 7, el = i2 & 127; float a = 0.f;
                for (int c = 0; c < NCH; ++c) { float* p = nst + (size_t)(h * 128 + c) * 128 + el; a = chs[4 * 512 + h * 128 + c] * a + *p; *p = a; } }
        }
    }
    {
        const bf16* qa = WSP(bf16, WS_B); const bf16* ka = qa + (size_t)M * 512; const bf16* va = ka + (size_t)M * 512; const unsigned* sel = WSP(unsigned, MS_SEL);
        bf16* ya = (bf16*)F.out + (size_t)2 * M * 512;
        LAS float* pbuf = (LAS float*)(F.lds + RING_OFF) + F.wave * 1024;
        const int gw = F.vcu * NWAVES + F.wave, NGW = F.G * NWAVES;
        for (int it = gw; it < M * AH; it += NGW) { const int q = it >> 3, h = it & 7, b = q >> 8;
            const unsigned sl = sel[it]; const int n = (int)(sl >> 24);
            float qf[64];
            { const GAS v4u* qp = (const GAS v4u*)(qa + (size_t)q * 512 + h * 64);
#pragma unroll
              for (int i = 0; i < 8; ++i) { const v4u w = qp[i]; qf[8 * i + 0] = blo(w.x); qf[8 * i + 1] = bhi(w.x); qf[8 * i + 2] = blo(w.y); qf[8 * i + 3] = bhi(w.y); qf[8 * i + 4] = blo(w.z); qf[8 * i + 5] = bhi(w.z); qf[8 * i + 6] = blo(w.w); qf[8 * i + 7] = bhi(w.w); } }
            const float ch = exp2f(-(float)(h + 1)) * LOG2E;
            float s[16]; float mx = -INFINITY;
#pragma unroll
            for (int g = 0; g < 4; ++g) { const bool own = (g == 3); const bool act = own || (g < n); const int blk = own ? b : (int)((sl >> (8 * g)) & 0xffu);
#pragma unroll
                for (int r = 0; r < 4; ++r) { const int key = blk * 256 + r * 64 + lane; float d = -INFINITY;
                    if (act && (!own || key <= q)) { const GAS v4u* kp = (const GAS v4u*)(ka + (size_t)key * 512 + h * 64); float a = 0.f;
#pragma unroll
                        for (int i = 0; i < 8; ++i) { const v4u w = kp[i]; a += (qf[8 * i] * blo(w.x) + qf[8 * i + 1] * bhi(w.x)) + (qf[8 * i + 2] * blo(w.y) + qf[8 * i + 3] * bhi(w.y)) + (qf[8 * i + 4] * blo(w.z) + qf[8 * i + 5] * bhi(w.z)) + (qf[8 * i + 6] * blo(w.w) + qf[8 * i + 7] * bhi(w.w)); }
                        d = a + ch * (float)(key - q); }
                    s[g * 4 + r] = d; mx = fmaxf(mx, d); } }
            mx = wave_max(mx); float l = 0.f;
#pragma unroll
            for (int i = 0; i < 16; ++i) { const float p = exp2f(s[i] - mx); l += p; pbuf[i * 64 + lane] = p; }
            l = wave_sum(l);
            asm volatile("s_waitcnt lgkmcnt(0)" ::: "memory");
            float o = 0.f;
#pragma unroll
            for (int g = 0; g < 4; ++g) { const bool own = (g == 3); const bool act = own || (g < n); const int blk = own ? b : (int)((sl >> (8 * g)) & 0xffu);
                if (act) { const bf16* vp = va + (size_t)(blk * 256) * 512 + h * 64 + lane;
#pragma unroll 8
                    for (int i = 0; i < 256; ++i) o += pbuf[g * 256 + i] * bf2f(vp[(size_t)i * 512]); } }
            asm volatile("s_waitcnt lgkmcnt(0)" ::: "memory");
            ya[(size_t)q * 512 + h * 64 + lane] = (bf16)f2bf(o / l);
        }
    }
}

__device__ __forceinline__ void p5_mlstm_out(Frame& F) {
    const int tid = F.tid;
    const bf16* qc = (const bf16*)F.out; const bf16* kc = qc + (size_t)M * 512; const bf16* vm = WSP(bf16, WS_C) + (size_t)2 * M * 512; const bf16* om = WSP(bf16, WS_C) + (size_t)3 * M * 512;
    const float* logi = WSP(float, MS_LOGI); const float* bcum = WSP(float, MS_BCUM); const float* chs = WSP(float, MS_CHS);
    const float* Cst = WSP(float, WS_A); const float* nst = WSP(float, MS_NST);
    bf16* ym = (bf16*)F.out + (size_t)3 * M * 512;
    LAS bf16* Q = (LAS bf16*)(F.lds + RING_OFF); LAS bf16* K = (LAS bf16*)(F.lds + RING_OFF + 32768); LAS bf16* V = (LAS bf16*)(F.lds + RING_OFF + 65536); LAS bf16* SC = (LAS bf16*)(F.lds + RING_OFF + 98304); LAS bf16* Cb = K;
    LAS float* sh = (LAS float*)(F.lds + RING_OFF + 131072);
    for (int it = F.vcu; it < MH * NCH; it += F.G) { const int h = it >> 7, c = it & 127, t0 = c * CL;
        __syncthreads();
#pragma unroll
        for (int i = 0; i < 4; ++i) { const int idx = tid + 512 * i, r = idx >> 4, ci = idx & 15; const size_t go = (size_t)(t0 + r) * 512 + h * 128 + ci * 8;
            *(LAS v4u*)(Q + r * 128 + ci * 8) = *(const GAS v4u*)(qc + go); *(LAS v4u*)(K + r * 128 + ci * 8) = *(const GAS v4u*)(kc + go); *(LAS v4u*)(V + r * 128 + ci * 8) = *(const GAS v4u*)(vm + go);
 }
        if (tid < 128) { const float bt = bcum[(size_t)h * M + t0 + tid]; sh[tid] = bt; sh[128 + tid] = logi[(size_t)(t0 + tid) * 4 + h] - bt; sh[256 + tid] = (c > 0) ? nst[(size_t)(it - 1) * 128 + tid] : 0.f; }
        __syncthreads();
        const float mprev = chs[2 * 512 + it];
        const int t = tid >> 2, part = tid & 3, s0 = part * 32;
        const float bt = sh[t];
        float lm = -INFINITY;
        for (int j = 0; j < 32; ++j) if (s0 + j <= t) lm = fmaxf(lm, sh[128 + s0 + j]);
        lm = fmaxf(lm, __shfl_xor(lm, 1)); lm = fmaxf(lm, __shfl_xor(lm, 2));
        const float inter = bt + mprev, mt = fmaxf(inter, bt + lm), winter = __expf(inter - mt);
        float rsum = 0.f;
        {
            unsigned qp[64];
#pragma unroll
            for (int i = 0; i < 16; ++i) { const v4u w = *(const LAS v4u*)(Q + t * 128 + 8 * i); qp[4 * i] = w.x; qp[4 * i + 1] = w.y; qp[4 * i + 2] = w.z; qp[4 * i + 3] = w.w; }
#pragma unroll 1
            for (int j = 0; j < 32; ++j) { float a = 0.f; const LAS bf16* kr = K + (s0 + j) * 128;
#pragma unroll
                for (int i = 0; i < 16; ++i) { const v4u w = *(const LAS v4u*)(kr + 8 * i);
                    a += (blo(qp[4 * i]) * blo(w.x) + bhi(qp[4 * i]) * bhi(w.x)) + (blo(qp[4 * i + 1]) * blo(w.y) + bhi(qp[4 * i + 1]) * bhi(w.y)) + (blo(qp[4 * i + 2]) * blo(w.z) + bhi(qp[4 * i + 2]) * bhi(w.z)) + (blo(qp[4 * i + 3]) * blo(w.w) + bhi(qp[4 * i + 3]) * bhi(w.w)); }
                const float w = (s0 + j <= t) ? __expf(bt + sh[128 + s0 + j] - mt) : 0.f; a *= w; rsum += a;
                SC[t * 128 + s0 + j] = (bf16)f2bf(a); }
        }
        rsum += __shfl_xor(rsum, 1); rsum += __shfl_xor(rsum, 2);
        __syncthreads();
#pragma unroll
        for (int i = 0; i < 4; ++i) { const int idx = tid + 512 * i, r = idx >> 4, ci = idx & 15;
            v4u o = (v4u){0u, 0u, 0u, 0u};
            if (c > 0) { const float* cp = Cst + ((size_t)(it - 1) * 128 + r) * 128 + ci * 8; const f32x4 a = *(const GAS f32x4*)cp, b = *(const GAS f32x4*)(cp + 4); o.x = pk2(a.x, a.y); o.y = pk2(a.z, a.w); o.z = pk2(b.x, b.y); o.w = pk2(b.z, b.w); }
            *(LAS v4u*)(Cb + r * 128 + ci * 8) = o; }
        __syncthreads();
        const int e0 = part * 32; float acc[32];
#pragma unroll
        for (int e = 0; e < 32; ++e) acc[e] = 0.f;
        float qn = 0.f;
        for (int d = 0; d < 128; ++d) { const float a = bf2f(Q[t * 128 + d]);
#pragma unroll
            for (int i = 0; i < 4; ++i) { const v4u w = *(const LAS v4u*)(Cb + d * 128 + e0 + 8 * i);
                acc[8 * i + 0] += a * blo(w.x); acc[8 * i + 1] += a * bhi(w.x); acc[8 * i + 2] += a * blo(w.y); acc[8 * i + 3] += a * bhi(w.y); acc[8 * i + 4] += a * blo(w.z); acc[8 * i + 5] += a * bhi(w.z); acc[8 * i + 6] += a * blo(w.w); acc[8 * i + 7] += a * bhi(w.w); } }
#pragma unroll
        for (int j = 0; j < 32; ++j) qn += bf2f(Q[t * 128 + s0 + j]) * sh[256 + s0 + j];
        qn += __shfl_xor(qn, 1); qn += __shfl_xor(qn, 2);
#pragma unroll
        for (int e = 0; e < 32; ++e) acc[e] *= winter;
        for (int s = 0; s < 128; ++s) { const float a = bf2f(SC[t * 128 + s]);
#pragma unroll
            for (int i = 0; i < 4; ++i) { const v4u w = *(const LAS v4u*)(V + s * 128 + e0 + 8 * i);
                acc[8 * i + 0] += a * blo(w.x); acc[8 * i + 1] += a * bhi(w.x); acc[8 * i + 2] += a * blo(w.y); acc[8 * i + 3] += a * bhi(w.y); acc[8 * i + 4] += a * blo(w.z); acc[8 * i + 5] += a * bhi(w.z); acc[8 * i + 6] += a * blo(w.w); acc[8 * i + 7] += a * bhi(w.w); } }
        const float den = winter * qn + rsum, dd = 1.0f / fmaxf(fabsf(den), __expf(-mt));
        const size_t go = (size_t)(t0 + t) * 512 + h * 128 + e0; float sm = 0.f;
#pragma unroll
        for (int i = 0; i < 4; ++i) { const v4u w = *(const GAS v4u*)(om + go + 8 * i);
            acc[8 * i + 0] *= dd * sigm(blo(w.x)); acc[8 * i + 1] *= dd * sigm(bhi(w.x)); acc[8 * i + 2] *= dd * sigm(blo(w.y)); acc[8 * i + 3] *= dd * sigm(bhi(w.y)); acc[8 * i + 4] *= dd * sigm(blo(w.z)); acc[8 * i + 5] *= dd * sigm(bhi(w.z)); acc[8 * i + 6] *= dd * sigm(blo(w.w)); acc[8 * i + 7] *= dd * sigm(bhi(w.w)); }
#pragma unroll
        for (int e = 0; e < 32; ++e) sm += acc[e];
        sm += __shfl_xor(sm, 1); sm += __shfl_xor(sm, 2);
        const float mu = sm * (1.0f / 128.0f); float vs = 0.f;
#pragma unroll
        for (int e = 0; e < 32; ++e) { acc[e] -= mu; vs += acc[e] * acc[e]; }
        vs += __shfl_xor(vs, 1); vs += __shfl_xor(vs, 2);
        const float rstd = 1.0f / sqrtf(vs * (1.0f / 128.0f) + EPS);
#pragma unroll
        for (int i = 0; i < 4; ++i) { const f32x4 g0 = *(const GAS f32x4*)(F.mnorm_g + h * 128 + e0 + 8 * i), g1 = *(const GAS f32x4*)(F.mnorm_g + h * 128 + e0 + 8 * i + 4); v4u o;
            o.x = pk2(acc[8 * i] * rstd * g0.x, acc[8 * i + 1] * rstd * g0.y); o.y = pk2(acc[8 * i + 2] * rstd * g0.z, acc[8 * i + 3] * rstd * g0.w);
            o.z = pk2(acc[8 * i + 4] * rstd * g1.x, acc[8 * i + 5] * rstd * g1.y); o.w = pk2(acc[8 * i + 6] * rstd * g1.z, acc[8 * i + 7] * rstd * g1.w);
            *(GAS v4u*)(ym + go + 8 * i) = o; }
    }
    __syncthreads();
}

__device__ __forceinline__ void p11_final_norm(Frame& F) {
    const int gw = F.vcu * NWAVES + F.wave, NGW = F.G * NWAVES, lane = F.lane;
    f32x4 gv[4];
#pragma unroll
    for (int j = 0; j < 4; ++j) gv[j] = ((const GAS f32x4*)F.fin_g)[lane + 64 * j];
    for (int m = gw; m < M; m += NGW) {
        GAS f32x4* xr = (GAS f32x4*)(F.out + (size_t)m * D) + lane;
        f32x4 v[4]; float s = 0.f;
#pragma unroll
        for (int j = 0; j < 4; ++j) { v[j] = xr[64 * j]; s += (v[j].x * v[j].x + v[j].y * v[j].y) + (v[j].z * v[j].z + v[j].w * v[j].w); }
        const float rstd = 1.0f / sqrtf(wave_sum(s) * (1.f / D) + EPS);
#pragma unroll
        for (int j = 0; j < 4; ++j) xr[64 * j] = v[j] * rstd * gv[j];
    }
}

struct Args { const float* in[15]; float* out; unsigned char* ws; int ph_lo, ph_hi, li, pad; };
__global__ void __launch_bounds__(NWAVES * 64, 2) mk_fwd(Args args) {
    extern __shared__ __attribute__((aligned(16))) unsigned char lds[];
    Frame F;
    F.lds = (LAS unsigned char*)lds;
    F.MISC = (volatile LAS unsigned*)(F.lds + MISC_OFF);
    F.tid = threadIdx.x; F.lane = F.tid & 63; F.wave = __builtin_amdgcn_readfirstlane(F.tid >> 6);
    F.G = gridDim.x; { const int bx = blockIdx.x; F.vcu = (F.G % 8 == 0) ? (bx % 8) * (F.G / 8) + bx / 8 : bx; }
    F.ws = args.ws; F.ctl = (gu32*)(args.ws + WS_CTL); F.out = args.out;
    F.x = args.in[0]; F.mix_g = args.in[1]; F.w_in = args.in[2]; F.conv_qk = args.in[3]; F.b_ig = args.in[4]; F.b_fg = args.in[5]; F.mnorm_g = args.in[6];
    F.w_oa = args.in[7]; F.w_om = args.in[8]; F.w_o = args.in[9]; F.ffn_g = args.in[10]; F.w_fg = args.in[11]; F.w_fu = args.in[12]; F.w_fd = args.in[13]; F.fin_g = args.in[14];
    for (int u = F.tid; u < (LDS_BYTES - LDSCTL_OFF) / 4; u += NWAVES * 64) ((LAS unsigned*)(F.lds + LDSCTL_OFF))[u] = 0u;
    __syncthreads();
    XcdBarrier bar; bar.bar = (unsigned*)(F.ctl + CW_BAR); bar.x = 0; bar.st = nullptr;
    if (N_LAUNCHES == 1) bar = xcd_barrier_post((unsigned*)(F.ctl + CW_BAR), F.MISC + 8);
#define GRID_BAR() do { if (N_LAUNCHES == 1) xcd_barrier(bar); } while (0)
    const int lo = args.ph_lo, hi = args.ph_hi;
#define IN(k) (lo <= (k) && (k) < hi)
#define SEAM(k) do { if (IN(k) && IN((k) + 1)) GRID_BAR(); } while (0)
    bf16* segs = WSP(bf16, WS_B);
    static_assert(WS_C == WS_B + (size_t)3 * M * 512 * 2, "segments contiguous");
    bf16* ga = WSP(bf16, WS_D); bf16* gm = ga + (size_t)M * 1024;
    bf16* ya = (bf16*)F.out + (size_t)2 * M * 512; bf16* ym = (bf16*)F.out + (size_t)3 * M * 512;
    bf16* P1 = WSP(bf16, WS_C); bf16* merged = WSP(bf16, WS_C + 32 * MiB);
    bf16* x1b = WSP(bf16, WS_A); bf16* hid = WSP(bf16, WS_HID);

    if (IN(0)) { p0_prologue(F); } SEAM(0);
    if (IN(1)) { pg8::Gemm g{WSP(bf16, WS_A), WSP(bf16, WS_WIN), M, NIN, D}; pg8::StaticOrder S; S.init(M, NIN, F.G, (int)blockIdx.x);
        pg8::EpiIn E{segs, ga, C2, M};
        pg8::gemm_phase<pg8::EpiIn, pg8::StaticOrder, PG8_ALIGN, PG8_SP2>(F.lds + RING_OFF, g, S, E); } SEAM(1);
    if (IN(2)) { p2_prep(F); } SEAM(2);
    if (IN(3)) { p3_gate_cloc(F); } SEAM(3);
    if (IN(4)) { p4_attn_scan(F); } SEAM(4);
    if (IN(5)) { p5_mlstm_out(F); } SEAM(5);
    if (IN(6)) { pg8::Gemm g{ya, WSP(bf16, WS_WA), M, D, AW}; pg8::StaticOrder S; S.init(M, D, F.G, (int)blockIdx.x);
        pg8::EpiGate<0> E{ga, nullptr, P1};
        pg8::gemm_phase<pg8::EpiGate<0>, pg8::StaticOrder, PG8_ALIGN, PG8_SP2>(F.lds + RING_OFF, g, S, E); } SEAM(6);
    if (IN(7)) { pg8::Gemm g{ym, WSP(bf16, WS_WM), M, D, MW}; pg8::StaticOrder S; S.init(M, D, F.G, (int)blockIdx.x);
        pg8::EpiGate<1> E{gm, P1, merged};
        pg8::gemm_phase<pg8::EpiGate<1>, pg8::StaticOrder, PG8_ALIGN, PG8_SP2>(F.lds + RING_OFF, g, S, E); } SEAM(7);
    if (IN(8)) { pg8::Gemm g{merged, WSP(bf16, WS_WO), M, D, D}; pg8::StaticOrder S; S.init(M, D, F.G, (int)blockIdx.x);
        pg8::EpiRes<true> E{F.x, F.out, x1b, WSP(float, MS_SSQ1)};
        pg8::gemm_phase<pg8::EpiRes<true>, pg8::StaticOrder, PG8_ALIGN, PG8_SP2>(F.lds + RING_OFF, g, S, E); } SEAM(8);
    if (IN(9)) { pg8::Gemm g{x1b, WSP(bf16, WS_WGU), M, NIN, D}; pg8::StaticOrder S; S.init(M, NIN, F.G, (int)blockIdx.x);
        pg8::EpiSwiGLU E{WSP(float, MS_SSQ1), hid, FF, EPS};
        pg8::gemm_phase<pg8::EpiSwiGLU, pg8::StaticOrder, PG8_ALIGN, PG8_SP2>(F.lds + RING_OFF, g, S, E); } SEAM(9);
    if (IN(10)) { pg8::Gemm g{hid, WSP(bf16, WS_WD), M, D, FF}; pg8::StaticOrder S; S.init(M, D, F.G, (int)blockIdx.x);
        pg8::EpiRes<false> E{F.out, F.out, nullptr, WSP(float, MS_SSQ2)};
        pg8::gemm_phase<pg8::EpiRes<false>, pg8::StaticOrder, PG8_ALIGN, PG8_SP2>(F.lds + RING_OFF, g, S, E); } SEAM(10);
    if (IN(11)) { p11_final_norm(F); }
#undef IN
#undef SEAM
}

extern "C" void kernel_launch(void* const* d_in, const int* in_sizes, int n_in, void* d_out, int out_size, void* d_ws, size_t ws_size, hipStream_t stream) {
    static int grid = 0;
    if (grid == 0) {
        if (n_in != 15 || in_sizes[0] != M * D || out_size != M * D || ws_size < WS_END) { fprintf(stderr, "kernel_launch: unexpected shapes: n_in %d in0 %d out %d ws %zu\n", n_in, n_in > 0 ? in_sizes[0] : -1, out_size, ws_size); grid = -1; return; }
        int dev = 0, cus = 0, per_cu = 0;
        if (hipGetDevice(&dev) != hipSuccess || hipDeviceGetAttribute(&cus, hipDeviceAttributeMultiprocessorCount, dev) != hipSuccess) { grid = -1; return; }
        if (hipFuncSetAttribute((const void*)mk_fwd, hipFuncAttributeMaxDynamicSharedMemorySize, LDS_BYTES) != hipSuccess) { fprintf(stderr, "kernel_launch: hipFuncSetAttribute failed\n"); grid = -1; return; }
        if (hipOccupancyMaxActiveBlocksPerMultiprocessor(&per_cu, (const void*)mk_fwd, NWAVES * 64, LDS_BYTES) != hipSuccess || per_cu < 1) { fprintf(stderr, "kernel_launch: occupancy query says %d blocks per CU\n", per_cu); per_cu = 1; }
        (void)hipGetLastError();
        grid = cus;
    }
    if (grid < 0) return;
    if (hipMemsetAsync((char*)d_ws + WS_CTL, 0, CTL_ZERO_BYTES, stream) != hipSuccess) { fprintf(stderr, "kernel_launch: memset failed\n"); return; }
    Args a{};
    for (int i = 0; i < 15; ++i) a.in[i] = (const float*)d_in[i];
    a.out = (float*)d_out; a.ws = (unsigned char*)d_ws;
    for (int li = 0; li < N_LAUNCHES; ++li) {
        a.ph_lo = (N_LAUNCHES == 1) ? 0 : li; a.ph_hi = (N_LAUNCHES == 1) ? N_PHASES : li + 1; a.li = li;
        hipLaunchKernelGGL(mk_fwd, dim3(grid), dim3(NWAVES * 64), LDS_BYTES, stream, a);
        const hipError_t le = hipPeekAtLastError();
        if (le != hipSuccess) { fprintf(stderr, "kernel_launch: launch %d failed: %s\n", li, hipGetErrorName(le)); break; }
    }
}
```

```cpp
#include <hip/hip_runtime.h>
#include <cstdio>
#include <cstdint>
namespace pg8 {
#define PG8_LAS __attribute__((address_space(3)))
typedef unsigned short bf16_t;
typedef short bf16x8 __attribute__((ext_vector_type(8)));
typedef float f32x4 __attribute__((ext_vector_type(4)));
typedef unsigned u32x4 __attribute__((ext_vector_type(4)));
constexpr int BM = 256, BK = 64, HALF = 128, HTB = HALF * BK * 2  , STAGE_BYTES = 8 * HTB, NXCD = 8, WGM = 8;

__host__ __device__ __forceinline__ int lds_byte(int r, int c) { const int st = (r >> 4) * 2 + (c >> 5), rr = r & 15, cc = c & 31, ob = rr * 64 + cc * 2; return st * 1024 + (ob ^ (((ob >> 9) & 1) << 5)); }
__host__ __device__ __forceinline__ void stage_rc(int b, int& R, int& C) { const int st = b / 1024, sb = b % 1024, swz = sb ^ (((sb >> 9) & 1) << 5); R = (st >> 1) * 16 + swz / 64; C = (st & 1) * 32 + (swz % 64) / 2; }
__host__ __device__ __forceinline__ int perm32(int rho) { const int n = rho >> 4, i = rho & 15; return 8 * (i >> 2) + 4 * n + (i & 3); }

struct Unit { int pm, pn; };
struct Gemm { const bf16_t* A; const bf16_t* Bt; int M, N, K; };

struct StaticOrder {
    int nM, nN, nwg, G, c;
    __host__ __device__ void init(int M, int N, int G_, int c_) { nM = M / BM; nN = N / BM; nwg = nM * nN; G = G_; c = c_; }
    __host__ __device__ bool next(int i, Unit& u) const {
        const long L = (long)i * G + c; if (L >= nwg) return false;
        int wgid = (int)L; { const int q = nwg / NXCD, r = nwg % NXCD, xcd = wgid % NXCD, off = wgid / NXCD; wgid = (xcd < r ? xcd * (q + 1) : r * (q + 1) + (xcd - r) * q) + off; }
        const int nig = WGM * nN, gid = wgid / nig, fm = gid * WGM, gsz = (nM - fm) < WGM ? (nM - fm) : WGM;
        u.pm = fm + ((wgid % nig) % gsz); u.pn = (wgid % nig) / gsz; return true;
    }
    __device__ __forceinline__ void a_ready(const Unit&) const {}
    __device__ __forceinline__ void done(const Unit&) const {}
};

__device__ __forceinline__ unsigned cvt_pk_bf16(float lo, float hi) { unsigned r; asm volatile("v_cvt_pk_bf16_f32 %0, %1, %2" : "=v"(r) : "v"(lo), "v"(hi)); return r; }
typedef float f32x2 __attribute__((ext_vector_type(2)));
template <class Epi, class Sched, bool ALIGN_EPI = false, bool SP2 = false>
__device__ __forceinline__ void gemm_phase(PG8_LAS unsigned char* lds, const Gemm g, const Sched& S, const Epi& E) {
    const int tid = threadIdx.x, wid = __builtin_amdgcn_readfirstlane(tid >> 6), lane = tid & 63, wr = wid >> 2, wc = wid & 3, fr = lane & 15, fq = lane >> 4;
    const int K = g.K, nt = K / BK;
    unsigned voffA[2], voffB[2];
#pragma unroll
    for (int i = 0; i < 2; ++i) { int R, C; stage_rc(tid * 16 + i * 8192, R, C); const int Rb = Epi::PERM ? ((R & ~31) + perm32(R & 31)) : R;
        voffA[i] = (unsigned)(R * K + C) * 2u; voffB[i] = (unsigned)(Rb * K + C) * 2u; }
    const size_t kstep = (size_t)(BK * 2);
    const size_t hstep = (size_t)HALF * K * 2;
    const size_t tstep = 2 * hstep;
    const unsigned ldsw = (unsigned)wid * 1024u;
    const int aoff = lds_byte(wr * 64 + fr, fq * 8), boff = lds_byte(wc * 32 + fr, fq * 8);
#define PG8_SA(b, h) (((b) * 2 + (h)) * HTB)
#define PG8_SB(b, h) ((4 + (b) * 2 + (h)) * HTB)
#define PG8_STAGE(bufoff, gbase, voff) do { _Pragma("unroll") for (int _i = 0; _i < 2; ++_i) \
        __builtin_amdgcn_global_load_lds((const unsigned*)((const char*)(gbase) + (voff)[_i]), (PG8_LAS unsigned*)(lds + (bufoff) + ldsw + _i * 8192), 16, 0, 0); } while (0)
#define PG8_LDA(dst, b, h) do { _Pragma("unroll") for (int m = 0; m < 4; ++m) _Pragma("unroll") for (int k = 0; k < 2; ++k) dst[m][k] = *(const PG8_LAS bf16x8*)(lds + PG8_SA(b, h) + aoff + m * 2048 + k * 1024); } while (0)
#define PG8_LDB(dst, b, h) do { _Pragma("unroll") for (int n = 0; n < 2; ++n) _Pragma("unroll") for (int k = 0; k < 2; ++k) dst[n][k] = *(const PG8_LAS bf16x8*)(lds + PG8_SB(b, h) + boff + n * 2048 + k * 1024); } while (0)
#define PG8_MMA(ai, bj, At, Bt) do { __builtin_amdgcn_s_setprio(1); _Pragma("unroll") for (int m = 0; m < 4; ++m) _Pragma("unroll") for (int n = 0; n < 2; ++n) _Pragma("unroll") for (int k = 0; k < 2; ++k) \
        acc[ai][bj][m][n] = __builtin_amdgcn_mfma_f32_16x16x32_bf16(Bt[n][k], At[m][k], acc[ai][bj][m][n], 0, 0, 0); __builtin_amdgcn_s_setprio(0); } while (0)
#define PG8_WAIT_V(n) asm volatile("s_waitcnt vmcnt(" #n ")" ::: "memory")
#define PG8_WAIT_L(n) asm volatile("s_waitcnt lgkmcnt(" #n ")" ::: "memory")
#define PG8_BAR __builtin_amdgcn_s_barrier()
#define PG8_SCHED __builtin_amdgcn_sched_barrier(0)
    Unit cur, nxt; int ui = 0;
    if (!S.next(0, cur)) return;
    f32x4 acc[2][2][4][2];
#pragma unroll
    for (int a = 0; a < 2; ++a)
#pragma unroll
        for (int b = 0; b < 2; ++b)
#pragma unroll
            for (int m = 0; m < 4; ++m)
#pragma unroll
                for (int n = 0; n < 2; ++n) acc[a][b][m][n] = (f32x4){0.f, 0.f, 0.f, 0.f};
    bf16x8 At[4][2], B0[2][2], B1[2][2];
    const char* cA = (const char*)g.A + (size_t)cur.pm * tstep; const char* cB = (const char*)g.Bt + (size_t)cur.pn * tstep;
    S.a_ready(cur);
    if constexpr (SP2) {
        PG8_STAGE(PG8_SB(0, 0), cB, voffB); PG8_STAGE(PG8_SB(0, 1), cB + hstep, voffB); PG8_STAGE(PG8_SA(0, 0), cA, voffA); PG8_STAGE(PG8_SA(0, 1), cA + hstep, voffA);
        if (wr == 1) PG8_BAR;
        PG8_WAIT_V(2); PG8_BAR;
        PG8_STAGE(PG8_SB(1, 0), cB + kstep, voffB); PG8_STAGE(PG8_SA(1, 0), cA + kstep, voffA); PG8_STAGE(PG8_SB(1, 1), cB + hstep + kstep, voffB);
        PG8_WAIT_V(6); PG8_BAR;
    } else {
        PG8_STAGE(PG8_SB(0, 0), cB, voffB); PG8_STAGE(PG8_SA(0, 0), cA, voffA); PG8_STAGE(PG8_SB(0, 1), cB + hstep, voffB); PG8_STAGE(PG8_SA(0, 1), cA + hstep, voffA);
        if (wr == 1) PG8_BAR;
        PG8_WAIT_V(4); PG8_BAR;
        PG8_STAGE(PG8_SB(1, 0), cB + kstep, voffB); PG8_STAGE(PG8_SA(1, 0), cA + kstep, voffA); PG8_STAGE(PG8_SB(1, 1), cB + hstep + kstep, voffB);
        PG8_WAIT_V(6); PG8_BAR;
    }
    for (;;) {
        const bool has_next = S.next(ui + 1, nxt);
        const char* nA = has_next ? (const char*)g.A + (size_t)nxt.pm * tstep : cA; const char* nB = has_next ? (const char*)g.Bt + (size_t)nxt.pn * tstep : cB;
        for (int t = 0; t < nt; t += 2) {
            const bool last = (t == nt - 2);
            const char* a1 = cA + (size_t)(t + 1) * kstep;
            const char* a2 = last ? nA : cA + (size_t)(t + 2) * kstep; const char* b2 = last ? nB : cB + (size_t)(t + 2) * kstep;
            const char* a3 = a2 + kstep; const char* b3 = b2 + kstep;
            if (last && has_next) S.a_ready(nxt);
            if constexpr (SP2) {
            PG8_LDB(B0, 0, 0); PG8_LDB(B1, 0, 1); PG8_SCHED; PG8_LDA(At, 0, 0); PG8_STAGE(PG8_SA(1, 1), a1 + hstep, voffA);
            PG8_WAIT_V(8); PG8_WAIT_L(0); PG8_BAR; PG8_MMA(0, 0, At, B0); PG8_MMA(0, 1, At, B1); PG8_BAR; PG8_SCHED;
            PG8_LDA(At, 0, 1); PG8_STAGE(PG8_SB(0, 0), b2, voffB); PG8_STAGE(PG8_SB(0, 1), b2 + hstep, voffB); PG8_STAGE(PG8_SA(0, 0), a2, voffA);
            PG8_WAIT_V(8); PG8_WAIT_L(0); PG8_BAR; PG8_MMA(1, 0, At, B0); PG8_MMA(1, 1, At, B1); PG8_BAR; PG8_SCHED;
            PG8_LDB(B0, 1, 0); PG8_LDB(B1, 1, 1); PG8_SCHED; PG8_LDA(At, 1, 0); PG8_STAGE(PG8_SA(0, 1), a2 + hstep, voffA);
            PG8_WAIT_V(8); PG8_WAIT_L(0); PG8_BAR; PG8_MMA(0, 0, At, B0); PG8_MMA(0, 1, At, B1); PG8_BAR; PG8_SCHED;
            PG8_LDA(At, 1, 1); PG8_STAGE(PG8_SB(1, 0), b3, voffB); PG8_STAGE(PG8_SB(1, 1), b3 + hstep, voffB); PG8_STAGE(PG8_SA(1, 0), a3, voffA);
            PG8_WAIT_V(8); PG8_WAIT_L(0); PG8_BAR; PG8_MMA(1, 0, At, B0); PG8_MMA(1, 1, At, B1); PG8_BAR; PG8_SCHED;
            } else {
            PG8_LDB(B0, 0, 0); PG8_SCHED; PG8_LDA(At, 0, 0); PG8_STAGE(PG8_SA(1, 1), a1 + hstep, voffA);
            PG8_WAIT_L(8); PG8_BAR; PG8_WAIT_L(0); PG8_MMA(0, 0, At, B0); PG8_BAR; PG8_SCHED;
            PG8_LDB(B1, 0, 1); PG8_STAGE(PG8_SB(0, 0), b2, voffB);
            PG8_BAR; PG8_WAIT_L(0); PG8_MMA(0, 1, At, B1); PG8_BAR;
            PG8_LDA(At, 0, 1); PG8_STAGE(PG8_SA(0, 0), a2, voffA);
            PG8_BAR; PG8_WAIT_L(0); PG8_MMA(1, 0, At, B0); PG8_BAR; PG8_SCHED;
            PG8_STAGE(PG8_SB(0, 1), b2 + hstep, voffB);
            PG8_WAIT_V(6); PG8_BAR; PG8_MMA(1, 1, At, B1); PG8_BAR;
            PG8_LDB(B0, 1, 0); PG8_SCHED; PG8_LDA(At, 1, 0); PG8_STAGE(PG8_SA(0, 1), a2 + hstep, voffA);
            PG8_WAIT_L(8); PG8_BAR; PG8_WAIT_L(0); PG8_MMA(0, 0, At, B0); PG8_BAR; PG8_SCHED;
            PG8_LDB(B1, 1, 1); PG8_STAGE(PG8_SB(1, 0), b3, voffB);
            PG8_BAR; PG8_WAIT_L(0); PG8_MMA(0, 1, At, B1); PG8_BAR;
            PG8_LDA(At, 1, 1); PG8_STAGE(PG8_SA(1, 0), a3, voffA);
            PG8_BAR; PG8_WAIT_L(0); PG8_MMA(1, 0, At, B0); PG8_BAR; PG8_SCHED;
            PG8_STAGE(PG8_SB(1, 1), b3 + hstep, voffB);
            PG8_WAIT_V(6); PG8_BAR; PG8_MMA(1, 1, At, B1); PG8_BAR;
            }
        }
        if constexpr (ALIGN_EPI) { if (wr == 0) PG8_BAR; }
        if constexpr (!Epi::AFTER_DRAIN) { E(acc, cur, wr, wc, fr, fq); S.done(cur); }
        if (!has_next) break;
#pragma unroll
        for (int a = 0; a < 2; ++a)
#pragma unroll
            for (int b = 0; b < 2; ++b)
#pragma unroll
                for (int m = 0; m < 4; ++m)
#pragma unroll
                    for (int n = 0; n < 2; ++n) acc[a][b][m][n] = (f32x4){0.f, 0.f, 0.f, 0.f};
        cur = nxt; cA = nA; cB = nB; ++ui;
        if constexpr (ALIGN_EPI) { if (wr == 1) PG8_BAR; }
    }
    PG8_WAIT_V(0);
    if constexpr (!ALIGN_EPI) { if (wr == 0) PG8_BAR; }
    PG8_BAR;
    if constexpr (Epi::AFTER_DRAIN) { E.fused(acc, cur, wr, wc, fr, fq, lds, wid, lane); S.done(cur); }
#undef PG8_SA
#undef PG8_SB
#undef PG8_STAGE
#undef PG8_LDA
#undef PG8_LDB
#undef PG8_MMA
#undef PG8_WAIT_V
#undef PG8_WAIT_L
#undef PG8_BAR
#undef PG8_SCHED
}
}

#ifndef PG8_SP2
#define PG8_SP2 true
#endif
#ifndef PG8_ALIGN
#define PG8_ALIGN true
#endif
namespace pg8 {
__device__ __forceinline__ float sigmoidf_fast(float x) { return __builtin_amdgcn_rcpf(1.0f + __builtin_amdgcn_exp2f(-1.4426950408889634f * x)); }
__device__ __forceinline__ float bflo(unsigned w) { return __uint_as_float(w << 16); }
__device__ __forceinline__ float bfhi(unsigned w) { return __uint_as_float(w & 0xffff0000u); }

struct EpiIn {
    static constexpr bool PERM = true, AFTER_DRAIN = false;
    bf16_t* seg; bf16_t* gates; float qscale; int Mrows;
    __device__ __forceinline__ void operator()(const f32x4 (&acc)[2][2][4][2], const Unit& u, int wr, int wc, int fr, int fq) const {
        const int pn = u.pn; bf16_t* base; int ldc, colt, mode;
        if (pn < 14) { const int s = pn >> 1; base = seg + (size_t)s * Mrows * 512; ldc = 512; colt = (pn & 1) * 256; mode = (s == 0) ? 1 : 0; }
        else { const int g = (pn - 14) >> 2; base = gates + (size_t)g * Mrows * 1024; ldc = 1024; colt = ((pn - 14) & 3) * 256; mode = 2; }
        const int row0 = u.pm * BM + wr * 64 + fr, col0 = colt + wc * 32 + 8 * fq;
#pragma unroll
        for (int ai = 0; ai < 2; ++ai)
#pragma unroll
            for (int m = 0; m < 4; ++m) { bf16_t* rowp = base + (size_t)(row0 + ai * HALF + m * 16) * ldc + col0;
#pragma unroll
                for (int bj = 0; bj < 2; ++bj) { f32x4 v0 = acc[ai][bj][m][0], v1 = acc[ai][bj][m][1];
                    if (mode == 1) { v0 = v0 * qscale; v1 = v1 * qscale; }
                    else if (mode == 2) {
#pragma unroll
                        for (int e = 0; e < 4; ++e) { v0[e] = sigmoidf_fast(v0[e]); v1[e] = sigmoidf_fast(v1[e]); } }
                    u32x4 w; w.x = cvt_pk_bf16(v0[0], v0[1]); w.y = cvt_pk_bf16(v0[2], v0[3]); w.z = cvt_pk_bf16(v1[0], v1[1]); w.w = cvt_pk_bf16(v1[2], v1[3]);
                    *(u32x4*)(rowp + bj * HALF) = w; } }
    }
};
template <int MODE> struct EpiGate {
    static constexpr bool PERM = true, AFTER_DRAIN = false;
    const bf16_t* G; const bf16_t* P; bf16_t* O;
    __device__ __forceinline__ void operator()(const f32x4 (&acc)[2][2][4][2], const Unit& u, int wr, int wc, int fr, int fq) const {
        const int row0 = u.pm * BM + wr * 64 + fr, col0 = u.pn * BM + wc * 32 + 8 * fq;
#pragma unroll
        for (int ai = 0; ai < 2; ++ai)
#pragma unroll
            for (int m = 0; m < 4; ++m) { const size_t off = (size_t)(row0 + ai * HALF + m * 16) * 1024 + col0;
#pragma unroll
                for (int bj = 0; bj < 2; ++bj) { const f32x4 v0 = acc[ai][bj][m][0], v1 = acc[ai][bj][m][1];
                    const u32x4 g = *(const u32x4*)(G + off + bj * HALF);
                    float r[8] = { bflo(g.x) * v0[0], bfhi(g.x) * v0[1], bflo(g.y) * v0[2], bfhi(g.y) * v0[3], bflo(g.z) * v1[0], bfhi(g.z) * v1[1], bflo(g.w) * v1[2], bfhi(g.w) * v1[3] };
                    if (MODE == 1) { const u32x4 p = *(const u32x4*)(P + off + bj * HALF);
                        r[0] += bflo(p.x); r[1] += bfhi(p.x); r[2] += bflo(p.y); r[3] += bfhi(p.y); r[4] += bflo(p.z); r[5] += bfhi(p.z); r[6] += bflo(p.w); r[7] += bfhi(p.w); }
                    u32x4 w; w.x = cvt_pk_bf16(r[0], r[1]); w.y = cvt_pk_bf16(r[2], r[3]); w.z = cvt_pk_bf16(r[4], r[5]); w.w = cvt_pk_bf16(r[6], r[7]);
                    *(u32x4*)(O + off + bj * HALF) = w; } }
    }
};
template <bool WITH_BF> struct EpiRes {
    static constexpr bool PERM = false, AFTER_DRAIN = false;
    const float* base; float* out; bf16_t* xb; float* ssq;
    __device__ __forceinline__ void operator()(const f32x4 (&acc)[2][2][4][2], const Unit& u, int wr, int wc, int fr, int fq) const {
        typedef unsigned u32x2v __attribute__((ext_vector_type(2)));
        const int row0 = u.pm * BM + wr * 64 + fr, col0 = u.pn * BM + wc * 32 + 4 * fq;
#pragma unroll
        for (int ai = 0; ai < 2; ++ai)
#pragma unroll
            for (int m = 0; m < 4; ++m) { const int row = row0 + ai * HALF + m * 16; const size_t off = (size_t)row * 1024 + col0; float ss = 0.f;
#pragma unroll
                for (int bj = 0; bj < 2; ++bj)
#pragma unroll
                    for (int n = 0; n < 2; ++n) { const size_t o2 = off + bj * HALF + n * 16; const f32x4 o = *(const f32x4*)(base + o2) + acc[ai][bj][m][n];
                        *(f32x4*)(out + o2) = o; ss += (o[0] * o[0] + o[1] * o[1]) + (o[2] * o[2] + o[3] * o[3]);
                        if (WITH_BF) { u32x2v w; w.x = cvt_pk_bf16(o[0], o[1]); w.y = cvt_pk_bf16(o[2], o[3]); *(u32x2v*)(xb + o2) = w; } }
                ss += __shfl_xor(ss, 16); ss += __shfl_xor(ss, 32);
                if (fq == 0) ssq[(size_t)row * 16 + u.pn * 4 + wc] = ss; }
    }
};
struct EpiSwiGLU {
    static constexpr bool PERM = true, AFTER_DRAIN = false;
    const float* ssq; bf16_t* Hd; int ldh; float eps;
    __device__ __forceinline__ void operator()(const f32x4 (&acc)[2][2][4][2], const Unit& u, int wr, int wc, int fr, int fq) const {
        const int row0 = u.pm * BM + wr * 64 + fr, col0 = u.pn * HALF + wc * 32 + 8 * fq;
#pragma unroll
        for (int ai = 0; ai < 2; ++ai)
#pragma unroll
            for (int m = 0; m < 4; ++m) { const int row = row0 + ai * HALF + m * 16; const f32x4* sp = (const f32x4*)(ssq + (size_t)row * 16);
                const f32x4 s0 = sp[0], s1 = sp[1], s2 = sp[2], s3 = sp[3];
                const float tot = ((s0[0] + s0[1]) + (s0[2] + s0[3])) + ((s1[0] + s1[1]) + (s1[2] + s1[3])) + ((s2[0] + s2[1]) + (s2[2] + s2[3])) + ((s3[0] + s3[1]) + (s3[2] + s3[3]));
                const float rs = 1.0f / sqrtf(tot * (1.0f / 1024.0f) + eps);
                float r[8];
#pragma unroll
                for (int n = 0; n < 2; ++n)
#pragma unroll
                    for (int e = 0; e < 4; ++e) { const float g = acc[ai][0][m][n][e] * rs, up = acc[ai][1][m][n][e] * rs; r[n * 4 + e] = g * sigmoidf_fast(g) * up; }
                u32x4 w; w.x = cvt_pk_bf16(r[0], r[1]); w.y = cvt_pk_bf16(r[2], r[3]); w.z = cvt_pk_bf16(r[4], r[5]); w.w = cvt_pk_bf16(r[6], r[7]);
                *(u32x4*)(Hd + (size_t)row * ldh + col0) = w; }
    }
};
}
#define GAS __attribute__((address_space(1)))
#define LAS __attribute__((address_space(3)))
typedef unsigned short bf16;
typedef unsigned v4u __attribute__((ext_vector_type(4)));
typedef float f32x4 __attribute__((ext_vector_type(4)));
typedef short bf16x8 __attribute__((ext_vector_type(8)));
typedef GAS unsigned gu32;
typedef GAS unsigned long long gu64;
#define RLX_AGENT __ATOMIC_RELAXED, __HIP_MEMORY_SCOPE_AGENT
#define LDS_WAIT() asm volatile("s_waitcnt lgkmcnt(0)" ::: "memory")
#define VM_WAIT() asm volatile("s_waitcnt vmcnt(0)" ::: "memory")
__device__ __forceinline__ unsigned long long rt() { return __builtin_amdgcn_s_memrealtime(); }
__device__ __forceinline__ unsigned f2bf(float f) { unsigned u = __builtin_bit_cast(unsigned, f); return (u + 0x7fffu + ((u >> 16) & 1u)) >> 16; }
__device__ __forceinline__ unsigned pk2(float lo, float hi) { return f2bf(lo) | (f2bf(hi) << 16); }

#define XB_TMO      128
#define XB_XCNT(j)  (256  + 64 * (j))
#define XB_XSUB(j)  (1280 + 64 * (j))
#define XB_XGEN(j)  (2304 + 64 * (j))
#define XB_TOP      3328
#define XB_TOPGEN   3392
#define XCD_BAR_WORDS 3456
#define XB_SPIN_CAP (1u << 18)

__device__ __forceinline__ unsigned xb_ld(unsigned* p)              { return __hip_atomic_load(p, __ATOMIC_RELAXED, __HIP_MEMORY_SCOPE_AGENT); }
__device__ __forceinline__ unsigned xb_add(unsigned* p, unsigned v) { return __hip_atomic_fetch_add(p, v, __ATOMIC_RELAXED, __HIP_MEMORY_SCOPE_AGENT); }
__device__ __forceinline__ unsigned xb_xcc_id() { return (unsigned)__builtin_amdgcn_s_getreg((3 << 11) | 20) & 0xFu; }
#define XB_SPIN(cond, bar) do { unsigned _sp = 0; while (cond) { __builtin_amdgcn_s_sleep(1); \
    if ((++_sp & 255u) == 0u) { if (xb_ld(&(bar)[XB_TMO])) break; if (_sp > XB_SPIN_CAP) { atomicAdd(&(bar)[XB_TMO], 1u); break; } } } } while (0)

struct XcdBarrier {
    unsigned* bar; unsigned x;
    volatile LAS unsigned* st;
};

__device__ __forceinline__ XcdBarrier xcd_barrier_post(unsigned* bar, volatile LAS unsigned* st) {
    XcdBarrier b; b.bar = bar; b.x = xb_xcc_id(); b.st = st;
    if (threadIdx.x == 0) (void)xb_add(&bar[XB_XCNT(b.x)], 1u);
    return b;
}
__device__ __forceinline__ void xcd_barrier_complete(unsigned* bar, unsigned x, unsigned& nloc, unsigned& nx) {
    const unsigned G = gridDim.x * gridDim.y * gridDim.z;
    unsigned sum, cnt, mine, sp = 0u;
    for (;;) {
        sum = 0u; cnt = 0u; mine = 0u;
#pragma unroll
        for (unsigned j = 0; j < 16; ++j) { const unsigned c = xb_ld(&bar[XB_XCNT(j)]); sum += c; cnt += (c > 0u) ? 1u : 0u; mine = (j == x) ? c : mine; }
        if (sum == G) break;
        __builtin_amdgcn_s_sleep(1);
        if ((++sp & 255u) == 0u) { if (xb_ld(&bar[XB_TMO])) break; if (sp > XB_SPIN_CAP) { atomicAdd(&bar[XB_TMO], 1u); break; } }
    }
    nloc = mine > 0u ? mine : 1u; nx = cnt > 0u ? cnt : 1u;
}

__device__ __forceinline__ void xcd_barrier(const XcdBarrier& b) {
    asm volatile("s_waitcnt vmcnt(0)" ::: "memory");
    __syncthreads();
    if (threadIdx.x == 0) {
        unsigned* bar = b.bar;
        __builtin_amdgcn_s_waitcnt(0);
        unsigned nloc = b.st[0], nx = b.st[1];
        if (nloc == 0u) { xcd_barrier_complete(bar, b.x, nloc, nx); b.st[0] = nloc; b.st[1] = nx; }
        const unsigned old = xb_add(&bar[XB_XSUB(b.x)], 1u);
        const unsigned gen = old / nloc;
        if (old + 1u == (gen + 1u) * nloc) {
            __builtin_amdgcn_fence(__ATOMIC_RELEASE, "agent");
            asm volatile("s_waitcnt vmcnt(0)" ::: "memory");
            const unsigned og = xb_add(&bar[XB_TOP], 1u);
            const unsigned tg = og / nx;
            if (og + 1u == (tg + 1u) * nx) xb_add(&bar[XB_TOPGEN], 1u);
            else XB_SPIN(xb_ld(&bar[XB_TOPGEN]) == tg, bar);
            __builtin_amdgcn_fence(__ATOMIC_ACQUIRE, "agent");
            xb_add(&bar[XB_XGEN(b.x)], 1u);
            asm volatile("s_waitcnt vmcnt(0)" ::: "memory");
        } else {
            XB_SPIN(xb_ld(&bar[XB_XGEN(b.x)]) == gen, bar);
            __builtin_amdgcn_fence(__ATOMIC_ACQUIRE, "agent");
            asm volatile("s_waitcnt vmcnt(0)" ::: "memory");
        }
    }
    __syncthreads();
}
constexpr int NWAVES = 8;
constexpr int N_PHASES = 12;
#ifndef MK_N_LAUNCHES
#define MK_N_LAUNCHES 1
#endif
constexpr int N_LAUNCHES = MK_N_LAUNCHES;

constexpr int M = 16384, D = 1024, NIN = 5632, FF = 2816, INW = 5640;
constexpr int AH = 8, AD = 64, AW = 512, MH = 4, MD = 128, MW = 512, NBLK = 64, NCH = 128, CL = 128;
constexpr float EPS = 1e-6f;
constexpr float LOG2E = 1.4426950408889634f;
constexpr float C2 = 0.125f * LOG2E;

constexpr size_t MiB = 1u << 20;
constexpr size_t WS_CTL = 0, CTL_ZERO_BYTES = 1 * MiB;
constexpr size_t WS_WIN = 1 * MiB;
constexpr size_t WS_WGU = 12 * MiB;
constexpr size_t WS_WD = 23 * MiB;
constexpr size_t WS_WO = 29 * MiB;
constexpr size_t WS_WA = 31 * MiB;
constexpr size_t WS_WM = 32 * MiB;
constexpr size_t WS_MISC = 33 * MiB;
constexpr size_t MS_LOGI = WS_MISC;
constexpr size_t MS_LOGF = MS_LOGI + 256 * 1024;
constexpr size_t MS_BCUM = MS_LOGF + 256 * 1024;
constexpr size_t MS_KMEAN = MS_BCUM + 256 * 1024;
constexpr size_t MS_SEL = MS_KMEAN + 128 * 1024;
constexpr size_t MS_CHS = MS_SEL + 512 * 1024;
constexpr size_t MS_NST = MS_CHS + 64 * 1024;
constexpr size_t MS_SSQ1 = MS_NST + 256 * 1024;
constexpr size_t MS_SSQ2 = MS_SSQ1 + 1024 * 1024;
static_assert(MS_SSQ2 + 1024 * 1024 <= 40 * MiB, "misc");
constexpr size_t WS_A = 40 * MiB;
constexpr size_t WS_B = 72 * MiB;
constexpr size_t WS_C = 120 * MiB;
constexpr size_t WS_D = 184 * MiB;
constexpr size_t WS_HID = 72 * MiB;
constexpr size_t WS_END = 256 * MiB;
static_assert(WS_HID + (size_t)M * FF * 2 <= WS_D, "hidden overlay");

constexpr int CW_TMO = 0, CW_CODE = 1, CW_BAR = 4096;

constexpr int RING_OFF = 0, RING_BYTES = 131072;
constexpr int LDS_BYTES = 147456;
constexpr int LDSCTL_OFF = LDS_BYTES - 512, MISC_OFF = LDSCTL_OFF + 320;


__device__ __forceinline__ float bf2f(unsigned short v) { return __uint_as_float((unsigned)v << 16); }
__device__ __forceinline__ float blo(unsigned w) { return __uint_as_float(w << 16); }
__device__ __forceinline__ float bhi(unsigned w) { return __uint_as_float(w & 0xffff0000u); }
__device__ __forceinline__ float wave_sum(float v) {
#pragma unroll
    for (int o = 1; o < 64; o <<= 1) v += __shfl_xor(v, o);
    return v;
}
__device__ __forceinline__ float wave_max(float v) {
#pragma unroll
    for (int o = 1; o < 64; o <<= 1) v = fmaxf(v, __shfl_xor(v, o));
    return v;
}
__device__ __forceinline__ float sigm(float x) { return 1.0f / (1.0f + __expf(-x)); }

struct Frame {
    LAS unsigned char* lds;
    volatile LAS unsigned* MISC;
    gu32* ctl;
    int tid, lane, wave, vcu, G;
    const float *x, *mix_g, *w_in, *conv_qk, *b_ig, *b_fg, *mnorm_g, *w_oa, *w_om, *w_o, *ffn_g, *w_fg, *w_fu, *w_fd, *fin_g;
    float* out; unsigned char* ws;
};
#define WSP(T, off) ((T*)(F.ws + (off)))

__device__ __forceinline__ void tr_item(const float* W, int ldw, int k0, int n_src0, bf16* WT, int ldt, int dst_row0, const float* kscale, LAS float* scr, int lane) {
#pragma unroll 8
    for (int i = 0; i < 32; ++i) { const int kk = 2 * i + (lane >> 5); float v = W[(size_t)(k0 + kk) * ldw + n_src0 + (lane & 31)]; if (kscale) v *= kscale[k0 + kk]; scr[kk * 33 + (lane & 31)] = v; }
    LDS_WAIT(); asm volatile("" ::: "memory");
    const int c = lane & 7;
#pragma unroll
    for (int j = 0; j < 4; ++j) { const int n = (lane >> 3) + 8 * j; const LAS float* s = scr + (8 * c) * 33 + n;
        v4u o; o.x = pk2(s[0 * 33], s[1 * 33]); o.y = pk2(s[2 * 33], s[3 * 33]); o.z = pk2(s[4 * 33], s[5 * 33]); o.w = pk2(s[6 * 33], s[7 * 33]);
        *(GAS v4u*)(WT + (size_t)(dst_row0 + n) * ldt + k0 + 8 * c) = o; }
    LDS_WAIT(); asm volatile("" ::: "memory");
}
__device__ __forceinline__ float log_sigmoid(float z) { return fminf(z, 0.f) - log1pf(__expf(-fabsf(z))); }

__device__ __forceinline__ void p0_prologue(Frame& F) {
    const int gw = F.vcu * NWAVES + F.wave, NGW = F.G * NWAVES, lane = F.lane;
    LAS float* gt = (LAS float*)(F.lds + RING_OFF);
    for (int i = F.tid; i < 8192; i += NWAVES * 64) { const int k = i >> 3, c = i & 7; gt[c * 1024 + k] = F.w_in[(size_t)k * INW + 3584 + c]; }
    __syncthreads();
    LAS float* scr = (LAS float*)(F.lds + RING_OFF + 32768 + F.wave * 8704);
    constexpr int I_IN = 16 * 176, I_GU = 16 * 88, I_D = 44 * 32, I_O = 16 * 32, I_A = 8 * 32;
    constexpr int NITEMS = I_IN + 2 * I_GU + I_D + I_O + 2 * I_A;
    bf16* Win = WSP(bf16, WS_WIN); bf16* Wgu = WSP(bf16, WS_WGU); bf16* Wd = WSP(bf16, WS_WD); bf16* Wo = WSP(bf16, WS_WO); bf16* Wa = WSP(bf16, WS_WA); bf16* Wm = WSP(bf16, WS_WM);
    for (int it = gw; it < NITEMS; it += NGW) {
        int r = it;
        if (r < I_IN) { const int kb = r / 176, nb = r % 176; const int ns = nb < 112 ? 32 * nb : 3592 + 32 * (nb - 112), nd = nb < 112 ? 32 * nb : 3584 + 32 * (nb - 112);
            tr_item(F.w_in, INW, 64 * kb, ns, Win, D, nd, nullptr, scr, lane); continue; } r -= I_IN;
        if (r < I_GU) { const int kb = r / 88, nb = r % 88; tr_item(F.w_fg, FF, 64 * kb, 32 * nb, Wgu, D, 256 * (nb >> 2) + 32 * (nb & 3), F.ffn_g, scr, lane); continue; } r -= I_GU;
        if (r < I_GU) { const int kb = r / 88, nb = r % 88; tr_item(F.w_fu, FF, 64 * kb, 32 * nb, Wgu, D, 256 * (nb >> 2) + 128 + 32 * (nb & 3), F.ffn_g, scr, lane); continue; } r -= I_GU;
        if (r < I_D) { const int kb = r / 32, nb = r % 32; tr_item(F.w_fd, D, 64 * kb, 32 * nb, Wd, FF, 32 * nb, nullptr, scr, lane); continue; } r -= I_D;
        if (r < I_O) { const int kb = r / 32, nb = r % 32; tr_item(F.w_o, D, 64 * kb, 32 * nb, Wo, D, 32 * nb, nullptr, scr, lane); continue; } r -= I_O;
        if (r < I_A) { const int kb = r / 32, nb = r % 32; tr_item(F.w_oa, D, 64 * kb, 32 * nb, Wa, AW, 32 * nb, nullptr, scr, lane); continue; } r -= I_A;
        { const int kb = r / 32, nb = r % 32; tr_item(F.w_om, D, 64 * kb, 32 * nb, Wm, MW, 32 * nb, nullptr, scr, lane); }
    }
    bf16* Hn = WSP(bf16, WS_A); float* logi = WSP(float, MS_LOGI); float* logf = WSP(float, MS_LOGF);
    f32x4 gv[4];
#pragma unroll
    for (int j = 0; j < 4; ++j) gv[j] = ((const GAS f32x4*)F.mix_g)[lane + 64 * j];
    for (int m = gw; m < M; m += NGW) {
        const GAS f32x4* xr = (const GAS f32x4*)(F.x + (size_t)m * D) + lane;
        f32x4 v[4]; float s = 0.f;
#pragma unroll
        for (int j = 0; j < 4; ++j) { v[j] = xr[64 * j]; s += (v[j].x * v[j].x + v[j].y * v[j].y) + (v[j].z * v[j].z + v[j].w * v[j].w); }
        const float rstd = 1.0f / sqrtf(wave_sum(s) * (1.f / D) + EPS);
#pragma unroll
        for (int j = 0; j < 4; ++j) v[j] = v[j] * rstd * gv[j];
        GAS unsigned long long* o8 = (GAS unsigned long long*)(Hn + (size_t)m * D) + lane;
#pragma unroll
        for (int j = 0; j < 4; ++j) o8[64 * j] = (unsigned long long)pk2(v[j].x, v[j].y) | ((unsigned long long)pk2(v[j].z, v[j].w) << 32);
        float ga[8];
#pragma unroll
        for (int c = 0; c < 8; ++c) { float a = 0.f;
#pragma unroll
            for (int j = 0; j < 4; ++j) { const f32x4 w = *(const LAS f32x4*)(gt + c * 1024 + 4 * lane + 256 * j); a += (v[j].x * w.x + v[j].y * w.y) + (v[j].z * w.z + v[j].w * w.w); }
            ga[c] = wave_sum(a); }
#pragma unroll
        for (int c = 0; c < 4; ++c) { if (lane == c) logi[(size_t)m * 4 + c] = ga[c] + F.b_ig[c]; if (lane == 4 + c) logf[(size_t)m * 4 + c] = log_sigmoid(ga[4 + c] + F.b_fg[c]); }
    }
}

__device__ __forceinline__ float wave_incl_scan(float v, int lane) {
#pragma unroll
    for (int o = 1; o < 64; o <<= 1) { const float t = __shfl_up(v, o); if (lane >= o) v += t; }
    return v;
}
__device__ __forceinline__ void p2_prep(Frame& F) {
    const int gw = F.vcu * NWAVES + F.wave, NGW = F.G * NWAVES, lane = F.lane;
    const bf16* ka = WSP(bf16, WS_B) + (size_t)M * 512;
    float* kmean = WSP(float, MS_KMEAN);
    for (int it = gw; it < AH * NBLK; it += NGW) { const int h = it >> 6, j = it & 63; float s = 0.f;
        for (int r = 0; r < 256; ++r) s += bf2f(ka[(size_t)(j * 256 + r) * 512 + h * 64 + lane]);
        kmean[(size_t)it * 64 + lane] = s * (1.0f / 256.0f); }
    const float* logi = WSP(float, MS_LOGI); const float* logf = WSP(float, MS_LOGF); float* bcum = WSP(float, MS_BCUM); float* chs = WSP(float, MS_CHS);
    for (int it = gw; it < MH * NCH; it += NGW) { const int h = it >> 7, c = it & 127, t0 = c * CL;
        float v0 = logf[(size_t)(t0 + lane) * 4 + h], v1 = logf[(size_t)(t0 + 64 + lane) * 4 + h];
        v0 = wave_incl_scan(v0, lane); const float tot0 = __shfl(v0, 63); v1 = wave_incl_scan(v1, lane) + tot0; const float bl = __shfl(v1, 63);
        bcum[(size_t)h * M + t0 + lane] = v0; bcum[(size_t)h * M + t0 + 64 + lane] = v1;
        const float g0 = bl - v0 + logi[(size_t)(t0 + lane) * 4 + h], g1 = bl - v1 + logi[(size_t)(t0 + 64 + lane) * 4 + h];
        const float gm = wave_max(fmaxf(g0, g1));
        if (lane == 0) { chs[0 * 512 + it] = bl; chs[1 * 512 + it] = gm; } }
    const bf16* qm = WSP(bf16, WS_C); const bf16* km = WSP(bf16, WS_C) + (size_t)M * 512;
    bf16* qc = (bf16*)F.out; bf16* kc = (bf16*)F.out + (size_t)M * 512;
    const int gt = F.vcu * (NWAVES * 64) + F.tid, NGT = F.G * NWAVES * 64;
    for (int it = gt; it < M * 128; it += NGT) { const int t = it >> 7, cg = it & 127; const bool isk = cg >= 64; const int c0 = (cg & 63) * 8;
        const bf16* src = isk ? km : qm; float acc[8];
#pragma unroll
        for (int e = 0; e < 8; ++e) acc[e] = 0.f;
#pragma unroll
        for (int j = 0; j < 4; ++j) { const int tt = t - 3 + j; if (tt >= 0) { const v4u w = *(const GAS v4u*)(src + (size_t)tt * 512 + c0); const float* cw = F.conv_qk + (size_t)j * 1024 + cg * 8;
                acc[0] += blo(w.x) * cw[0]; acc[1] += bhi(w.x) * cw[1]; acc[2] += blo(w.y) * cw[2]; acc[3] += bhi(w.y) * cw[3]; acc[4] += blo(w.z) * cw[4]; acc[5] += bhi(w.z) * cw[5]; acc[6] += blo(w.w) * cw[6]; acc[7] += bhi(w.w) * cw[7]; } }
        const float sc = isk ? 0.08838834764831845f : 1.0f;
#pragma unroll
        for (int e = 0; e < 8; ++e) acc[e] = acc[e] * sigm(acc[e]) * sc;
        v4u o; o.x = pk2(acc[0], acc[1]); o.y = pk2(acc[2], acc[3]); o.z = pk2(acc[4], acc[5]); o.w = pk2(acc[6], acc[7]);
        *(GAS v4u*)((isk ? kc : qc) + (size_t)t * 512 + c0) = o; }
}

__device__ __forceinline__ void p3_gate_cloc(Frame& F) {
    const int lane = F.lane, tid = F.tid;
    {
        const bf16* qa = WSP(bf16, WS_B); const float* kmean = WSP(float, MS_KMEAN); unsigned* sel = WSP(unsigned, MS_SEL);
        LAS float* kl = (LAS float*)(F.lds + RING_OFF);
        for (int qg = F.vcu; qg < M / 64; qg += F.G) {
            const int b = (qg * 64) >> 8;
            __syncthreads();
            for (int i = tid; i < 8 * 64 * 16; i += NWAVES * 64) { const int h = i >> 10, rem = i & 1023; if ((rem >> 4) < b) *(LAS f32x4*)(kl + h * 4096 + rem * 4) = *(const GAS f32x4*)(kmean + h * 4096 + rem * 4); }
            __syncthreads();
            const int h = F.wave, q = qg * 64 + lane;
            float qf[64];
            { const GAS v4u* qp = (const GAS v4u*)(qa + (size_t)q * 512 + h * 64);
#pragma unroll
              for (int i = 0; i < 8; ++i) { const v4u w = qp[i]; qf[8 * i + 0] = blo(w.x); qf[8 * i + 1] = bhi(w.x); qf[8 * i + 2] = blo(w.y); qf[8 * i + 3] = bhi(w.y); qf[8 * i + 4] = blo(w.z); qf[8 * i + 5] = bhi(w.z); qf[8 * i + 6] = blo(w.w); qf[8 * i + 7] = bhi(w.w); } }
            float v0 = -INFINITY, v1 = -INFINITY, v2 = -INFINITY; int j0 = 0, j1 = 0, j2 = 0;
            for (int j = 0; j < b; ++j) { const LAS f32x4* kp = (const LAS f32x4*)(kl + h * 4096 + j * 64); float s = 0.f;
#pragma unroll
                for (int i = 0; i < 16; ++i) { const f32x4 k4 = kp[i]; s += (qf[4 * i] * k4.x + qf[4 * i + 1] * k4.y) + (qf[4 * i + 2] * k4.z + qf[4 * i + 3] * k4.w); }
                if (s > v2) { if (s > v1) { v2 = v1; j2 = j1; if (s > v0) { v1 = v0; j1 = j0; v0 = s; j0 = j; } else { v1 = s; j1 = j; } } else { v2 = s; j2 = j; } } }
            const int n = b < 3 ? b : 3;
            sel[(size_t)q * 8 + h] = (unsigned)j0 | ((unsigned)j1 << 8) | ((unsigned)j2 << 16) | ((unsigned)n << 24);
        }
        __syncthreads();
    }
    {
        const bf16* kc = (const bf16*)F.out + (size_t)M * 512; const bf16* vm = WSP(bf16, WS_C) + (size_t)2 * M * 512;
        const float* logi = WSP(float, MS_LOGI); const float* bcum = WSP(float, MS_BCUM); float* chs = WSP(float, MS_CHS);
        float* Cl = WSP(float, WS_A); float* nst = WSP(float, MS_NST);
        LAS bf16* KW = (LAS bf16*)(F.lds + RING_OFF); LAS bf16* VV = (LAS bf16*)(F.lds + RING_OFF + 32768); LAS float* sh = (LAS float*)(F.lds + RING_OFF + 65536);
        for (int it = F.vcu; it < MH * NCH; it += F.G) { const int h = it >> 7, c = it & 127, t0 = c * CL;
            __syncthreads();
            if (tid == 0) { float m = 0.f, mp = 0.f; for (int cc = 0; cc <= c; ++cc) { mp = m; m = fmaxf(chs[0 * 512 + h * 128 + cc] + m, chs[1 * 512 + h * 128 + cc]); }
                sh[0] = mp; sh[1] = m; const float bl = chs[0 * 512 + it]; chs[2 * 512 + it] = mp; chs[3 * 512 + it] = m; chs[4 * 512 + it] = __expf(bl + mp - m); }
            __syncthreads();
            if (tid < 128) { const float bl = chs[0 * 512 + it]; sh[8 + tid] = __expf(bl - bcum[(size_t)h * M + t0 + tid] + logi[(size_t)(t0 + tid) * 4 + h] - sh[1]); }
            __syncthreads();
#pragma unroll
            for (int i = 0; i < 4; ++i) { const int idx = tid + 512 * i, r = idx >> 4, ci = idx & 15; const float w = sh[8 + r];
                const v4u kk = *(const GAS v4u*)(kc + (size_t)(t0 + r) * 512 + h * 128 + ci * 8); v4u o;
                o.x = pk2(blo(kk.x) * w, bhi(kk.x) * w); o.y = pk2(blo(kk.y) * w, bhi(kk.y) * w); o.z = pk2(blo(kk.z) * w, bhi(kk.z) * w); o.w = pk2(blo(kk.w) * w, bhi(kk.w) * w);
                *(LAS v4u*)(KW + r * 128 + ci * 8) = o;
                *(LAS v4u*)(VV + r * 128 + ci * 8) = *(const GAS v4u*)(vm + (size_t)(t0 + r) * 512 + h * 128 + ci * 8); }
            __syncthreads();
            const int dk = tid >> 2, e0 = (tid & 3) * 32; float acc[32]; float ns = 0.f;
#pragma unroll
            for (int e = 0; e < 32; ++e) acc[e] = 0.f;
            for (int s = 0; s < 128; ++s) { const float a = bf2f(KW[s * 128 + dk]); ns += a;
#pragma unroll
                for (int i = 0; i < 4; ++i) { const v4u w = *(const LAS v4u*)(VV + s * 128 + e0 + 8 * i);
                    acc[8 * i + 0] += a * blo(w.x); acc[8 * i + 1] += a * bhi(w.x); acc[8 * i + 2] += a * blo(w.y); acc[8 * i + 3] += a * bhi(w.y); acc[8 * i + 4] += a * blo(w.z); acc[8 * i + 5] += a * bhi(w.z); acc[8 * i + 6] += a * blo(w.w); acc[8 * i + 7] += a * bhi(w.w); } }
            float* dst = Cl + ((size_t)it * 128 + dk) * 128 + e0;
#pragma unroll
            for (int i = 0; i < 8; ++i) *(GAS f32x4*)(dst + 4 * i) = (f32x4){acc[4 * i], acc[4 * i + 1], acc[4 * i + 2], acc[4 * i + 3]};
            if ((tid & 3) == 0) nst[(size_t)it * 128 + dk] = ns;
        }
        __syncthreads();
    }
}

__device__ __forceinline__ void p4_attn_scan(Frame& F) {
    const int lane = F.lane, tid = F.tid;
    {
        float* Cl = WSP(float, WS_A); float* nst = WSP(float, MS_NST); const float* chs = WSP(float, MS_CHS);
        const int gt = F.vcu * (NWAVES * 64) + tid, NGT = F.G * NWAVES * 64;
        for (int idx = gt; idx < MH * 16384 + MH * 128; idx += NGT) {
            if (idx < MH * 16384) { const int h = idx >> 14, el = idx & 16383; float a = 0.f;
                for (int c = 0; c < NCH; ++c) { float* p = Cl + ((size_t)(h * 128 + c) << 14) + el; a = chs[4 * 512 + h * 128 + c] * a + *p; *p = a; } }
            else { const int i2 = idx - MH * 16384, h = i2 >> 7, el = i2 & 127; float a = 0.f;
                for (int c = 0; c < NCH; ++c) { float* p = nst + (size_t)(h * 128 + c) * 128 + el; a = chs[4 * 512 + h * 128 + c] * a + *p; *p = a; } }
        }
    }
    {
        const bf16* qa = WSP(bf16, WS_B); const bf16* ka = qa + (size_t)M * 512; const bf16* va = ka + (size_t)M * 512; const unsigned* sel = WSP(unsigned, MS_SEL);
        bf16* ya = (bf16*)F.out + (size_t)2 * M * 512;
        LAS float* pbuf = (LAS float*)(F.lds + RING_OFF) + F.wave * 1024;
        const int gw = F.vcu * NWAVES + F.wave, NGW = F.G * NWAVES;
        for (int it = gw; it < M * AH; it += NGW) { const int q = it >> 3, h = it & 7, b = q >> 8;
            const unsigned sl = sel[it]; const int n = (int)(sl >> 24);
            float qf[64];
            { const GAS v4u* qp = (const GAS v4u*)(qa + (size_t)q * 512 + h * 64);
#pragma unroll
              for (int i = 0; i < 8; ++i) { const v4u w = qp[i]; qf[8 * i + 0] = blo(w.x); qf[8 * i + 1] = bhi(w.x); qf[8 * i + 2] = blo(w.y); qf[8 * i + 3] = bhi(w.y); qf[8 * i + 4] = blo(w.z); qf[8 * i + 5] = bhi(w.z); qf[8 * i + 6] = blo(w.w); qf[8 * i + 7] = bhi(w.w); } }
            const float ch = exp2f(-(float)(h + 1)) * LOG2E;
            float s[16]; float mx = -INFINITY;
#pragma unroll
            for (int g = 0; g < 4; ++g) { const bool own = (g == 3); const bool act = own || (g < n); const int blk = own ? b : (int)((sl >> (8 * g)) & 0xffu);
#pragma unroll
                for (int r = 0; r < 4; ++r) { const int key = blk * 256 + r * 64 + lane; float d = -INFINITY;
                    if (act && (!own || key <= q)) { const GAS v4u* kp = (const GAS v4u*)(ka + (size_t)key * 512 + h * 64); float a = 0.f;
#pragma unroll
                        for (int i = 0; i < 8; ++i) { const v4u w = kp[i]; a += (qf[8 * i] * blo(w.x) + qf[8 * i + 1] * bhi(w.x)) + (qf[8 * i + 2] * blo(w.y) + qf[8 * i + 3] * bhi(w.y)) + (qf[8 * i + 4] * blo(w.z) + qf[8 * i + 5] * bhi(w.z)) + (qf[8 * i + 6] * blo(w.w) + qf[8 * i + 7] * bhi(w.w)); }
                        d = a + ch * (float)(key - q); }
                    s[g * 4 + r] = d; mx = fmaxf(mx, d); } }
            mx = wave_max(mx); float l = 0.f;
#pragma unroll
            for (int i = 0; i < 16; ++i) { const float p = exp2f(s[i] - mx); l += p; pbuf[i * 64 + lane] = p; }
            l = wave_sum(l);
            asm volatile("s_waitcnt lgkmcnt(0)" ::: "memory");
            float o = 0.f;
#pragma unroll
            for (int g = 0; g < 4; ++g) { const bool own = (g == 3); const bool act = own || (g < n); const int blk = own ? b : (int)((sl >> (8 * g)) & 0xffu);
                if (act) { const bf16* vp = va + (size_t)(blk * 256) * 512 + h * 64 + lane;
#pragma unroll 8
                    for (int i = 0; i < 256; ++i) o += pbuf[g * 256 + i] * bf2f(vp[(size_t)i * 512]); } }
            asm volatile("s_waitcnt lgkmcnt(0)" ::: "memory");
            ya[(size_t)q * 512 + h * 64 + lane] = (bf16)f2bf(o / l);
        }
    }
}

__device__ __forceinline__ void p5_mlstm_out(Frame& F) {
    const int tid = F.tid;
    const bf16* qc = (const bf16*)F.out; const bf16* kc = qc + (size_t)M * 512; const bf16* vm = WSP(bf16, WS_C) + (size_t)2 * M * 512; const bf16* om = WSP(bf16, WS_C) + (size_t)3 * M * 512;
    const float* logi = WSP(float, MS_LOGI); const float* bcum = WSP(float, MS_BCUM); const float* chs = WSP(float, MS_CHS);
    const float* Cst = WSP(float, WS_A); const float* nst = WSP(float, MS_NST);
    bf16* ym = (bf16*)F.out + (size_t)3 * M * 512;
    LAS bf16* Q = (LAS bf16*)(F.lds + RING_OFF); LAS bf16* K = (LAS bf16*)(F.lds + RING_OFF + 32768); LAS bf16* V = (LAS bf16*)(F.lds + RING_OFF + 65536); LAS bf16* SC = (LAS bf16*)(F.lds + RING_OFF + 98304); LAS bf16* Cb = K;
    LAS float* sh = (LAS float*)(F.lds + RING_OFF + 131072);
    for (int it = F.vcu; it < MH * NCH; it += F.G) { const int h = it >> 7, c = it & 127, t0 = c * CL;
        __syncthreads();
#pragma unroll
        for (int i = 0; i < 4; ++i) { const int idx = tid + 512 * i, r = idx >> 4, ci = idx & 15; const size_t go = (size_t)(t0 + r) * 512 + h * 128 + ci * 8;
            *(LAS v4u*)(Q + r * 128 + ci * 8) = *(const GAS v4u*)(qc + go); *(LAS v4u*)(K + r * 128 + ci * 8) = *(const GAS v4u*)(kc + go); *(LAS v4u*)(V + r * 128 + ci * 8) = *(const GAS v4u*)(vm + go);
 }
        if (tid < 128) { const float bt = bcum[(size_t)h * M + t0 + tid]; sh[tid] = bt; sh[128 + tid] = logi[(size_t)(t0 + tid) * 4 + h] - bt; sh[256 + tid] = (c > 0) ? nst[(size_t)(it - 1) * 128 + tid] : 0.f; }
        __syncthreads();
        const float mprev = chs[2 * 512 + it];
        const int t = tid >> 2, part = tid & 3, s0 = part * 32;
        const float bt = sh[t];
        float lm = -INFINITY;
        for (int j = 0; j < 32; ++j) if (s0 + j <= t) lm = fmaxf(lm, sh[128 + s0 + j]);
        lm = fmaxf(lm, __shfl_xor(lm, 1)); lm = fmaxf(lm, __shfl_xor(lm, 2));
        const float inter = bt + mprev, mt = fmaxf(inter, bt + lm), winter = __expf(inter - mt);
        float rsum = 0.f;
        {
            unsigned qp[64];
#pragma unroll
            for (int i = 0; i < 16; ++i) { const v4u w = *(const LAS v4u*)(Q + t * 128 + 8 * i); qp[4 * i] = w.x; qp[4 * i + 1] = w.y; qp[4 * i + 2] = w.z; qp[4 * i + 3] = w.w; }
#pragma unroll 1
            for (int j = 0; j < 32; ++j) { float a = 0.f; const LAS bf16* kr = K + (s0 + j) * 128;
#pragma unroll
                for (int i = 0; i < 16; ++i) { const v4u w = *(const LAS v4u*)(kr + 8 * i);
                    a += (blo(qp[4 * i]) * blo(w.x) + bhi(qp[4 * i]) * bhi(w.x)) + (blo(qp[4 * i + 1]) * blo(w.y) + bhi(qp[4 * i + 1]) * bhi(w.y)) + (blo(qp[4 * i + 2]) * blo(w.z) + bhi(qp[4 * i + 2]) * bhi(w.z)) + (blo(qp[4 * i + 3]) * blo(w.w) + bhi(qp[4 * i + 3]) * bhi(w.w)); }
                const float w = (s0 + j <= t) ? __expf(bt + sh[128 + s0 + j] - mt) : 0.f; a *= w; rsum += a;
                SC[t * 128 + s0 + j] = (bf16)f2bf(a); }
        }
        rsum += __shfl_xor(rsum, 1); rsum += __shfl_xor(rsum, 2);
        __syncthreads();
#pragma unroll
        for (int i = 0; i < 4; ++i) { const int idx = tid + 512 * i, r = idx >> 4, ci = idx & 15;
            v4u o = (v4u){0u, 0u, 0u, 0u};
            if (c > 0) { const float* cp = Cst + ((size_t)(it - 1) * 128 + r) * 128 + ci * 8; const f32x4 a = *(const GAS f32x4*)cp, b = *(const GAS f32x4*)(cp + 4); o.x = pk2(a.x, a.y); o.y = pk2(a.z, a.w); o.z = pk2(b.x, b.y); o.w = pk2(b.z, b.w); }
            *(LAS v4u*)(Cb + r * 128 + ci * 8) = o; }
        __syncthreads();
        const int e0 = part * 32; float acc[32];
#pragma unroll
        for (int e = 0; e < 32; ++e) acc[e] = 0.f;
        float qn = 0.f;
        for (int d = 0; d < 128; ++d) { const float a = bf2f(Q[t * 128 + d]);
#pragma unroll
            for (int i = 0; i < 4; ++i) { const v4u w = *(const LAS v4u*)(Cb + d * 128 + e0 + 8 * i);
                acc[8 * i + 0] += a * blo(w.x); acc[8 * i + 1] += a * bhi(w.x); acc[8 * i + 2] += a * blo(w.y); acc[8 * i + 3] += a * bhi(w.y); acc[8 * i + 4] += a * blo(w.z); acc[8 * i + 5] += a * bhi(w.z); acc[8 * i + 6] += a * blo(w.w); acc[8 * i + 7] += a * bhi(w.w); } }
#pragma unroll
        for (int j = 0; j < 32; ++j) qn += bf2f(Q[t * 128 + s0 + j]) * sh[256 + s0 + j];
        qn += __shfl_xor(qn, 1); qn += __shfl_xor(qn, 2);
#pragma unroll
        for (int e = 0; e < 32; ++e) acc[e] *= winter;
        for (int s = 0; s < 128; ++s) { const float a = bf2f(SC[t * 128 + s]);
#pragma unroll
            for (int i = 0; i < 4; ++i) { const v4u w = *(const LAS v4u*)(V + s * 128 + e0 + 8 * i);
                acc[8 * i + 0] += a * blo(w.x); acc[8 * i + 1] += a * bhi(w.x); acc[8 * i + 2] += a * blo(w.y); acc[8 * i + 3] += a * bhi(w.y); acc[8 * i + 4] += a * blo(w.z); acc[8 * i + 5] += a * bhi(w.z); acc[8 * i + 6] += a * blo(w.w); acc[8 * i + 7] += a * bhi(w.w); } }
        const float den = winter * qn + rsum, dd = 1.0f / fmaxf(fabsf(den), __expf(-mt));
        const size_t go = (size_t)(t0 + t) * 512 + h * 128 + e0; float sm = 0.f;
#pragma unroll
        for (int i = 0; i < 4; ++i) { const v4u w = *(const GAS v4u*)(om + go + 8 * i);
            acc[8 * i + 0] *= dd * sigm(blo(w.x)); acc[8 * i + 1] *= dd * sigm(bhi(w.x)); acc[8 * i + 2] *= dd * sigm(blo(w.y)); acc[8 * i + 3] *= dd * sigm(bhi(w.y)); acc[8 * i + 4] *= dd * sigm(blo(w.z)); acc[8 * i + 5] *= dd * sigm(bhi(w.z)); acc[8 * i + 6] *= dd * sigm(blo(w.w)); acc[8 * i + 7] *= dd * sigm(bhi(w.w)); }
#pragma unroll
        for (int e = 0; e < 32; ++e) sm += acc[e];
        sm += __shfl_xor(sm, 1); sm += __shfl_xor(sm, 2);
        const float mu = sm * (1.0f / 128.0f); float vs = 0.f;
#pragma unroll
        for (int e = 0; e < 32; ++e) { acc[e] -= mu; vs += acc[e] * acc[e]; }
        vs += __shfl_xor(vs, 1); vs += __shfl_xor(vs, 2);
        const float rstd = 1.0f / sqrtf(vs * (1.0f / 128.0f) + EPS);
#pragma unroll
        for (int i = 0; i < 4; ++i) { const f32x4 g0 = *(const GAS f32x4*)(F.mnorm_g + h * 128 + e0 + 8 * i), g1 = *(const GAS f32x4*)(F.mnorm_g + h * 128 + e0 + 8 * i + 4); v4u o;
            o.x = pk2(acc[8 * i] * rstd * g0.x, acc[8 * i + 1] * rstd * g0.y); o.y = pk2(acc[8 * i + 2] * rstd * g0.z, acc[8 * i + 3] * rstd * g0.w);
            o.z = pk2(acc[8 * i + 4] * rstd * g1.x, acc[8 * i + 5] * rstd * g1.y); o.w = pk2(acc[8 * i + 6] * rstd * g1.z, acc[8 * i + 7] * rstd * g1.w);
            *(GAS v4u*)(ym + go + 8 * i) = o; }
    }
    __syncthreads();
}

__device__ __forceinline__ void p11_final_norm(Frame& F) {
    const int gw = F.vcu * NWAVES + F.wave, NGW = F.G * NWAVES, lane = F.lane;
    f32x4 gv[4];
#pragma unroll
    for (int j = 0; j < 4; ++j) gv[j] = ((const GAS f32x4*)F.fin_g)[lane + 64 * j];
    for (int m = gw; m < M; m += NGW) {
        GAS f32x4* xr = (GAS f32x4*)(F.out + (size_t)m * D) + lane;
        f32x4 v[4]; float s = 0.f;
#pragma unroll
        for (int j = 0; j < 4; ++j) { v[j] = xr[64 * j]; s += (v[j].x * v[j].x + v[j].y * v[j].y) + (v[j].z * v[j].z + v[j].w * v[j].w); }
        const float rstd = 1.0f / sqrtf(wave_sum(s) * (1.f / D) + EPS);
#pragma unroll
        for (int j = 0; j < 4; ++j) xr[64 * j] = v[j] * rstd * gv[j];
    }
}

struct Args { const float* in[15]; float* out; unsigned char* ws; int ph_lo, ph_hi, li, pad; };
__global__ void __launch_bounds__(NWAVES * 64, 2) mk_fwd(Args args) {
    extern __shared__ __attribute__((aligned(16))) unsigned char lds[];
    Frame F;
    F.lds = (LAS unsigned char*)lds;
    F.MISC = (volatile LAS unsigned*)(F.lds + MISC_OFF);
    F.tid = threadIdx.x; F.lane = F.tid & 63; F.wave = __builtin_amdgcn_readfirstlane(F.tid >> 6);
    F.G = gridDim.x; { const int bx = blockIdx.x; F.vcu = (F.G % 8 == 0) ? (bx % 8) * (F.G / 8) + bx / 8 : bx; }
    F.ws = args.ws; F.ctl = (gu32*)(args.ws + WS_CTL); F.out = args.out;
    F.x = args.in[0]; F.mix_g = args.in[1]; F.w_in = args.in[2]; F.conv_qk = args.in[3]; F.b_ig = args.in[4]; F.b_fg = args.in[5]; F.mnorm_g = args.in[6];
    F.w_oa = args.in[7]; F.w_om = args.in[8]; F.w_o = args.in[9]; F.ffn_g = args.in[10]; F.w_fg = args.in[11]; F.w_fu = args.in[12]; F.w_fd = args.in[13]; F.fin_g = args.in[14];
    for (int u = F.tid; u < (LDS_BYTES - LDSCTL_OFF) / 4; u += NWAVES * 64) ((LAS unsigned*)(F.lds + LDSCTL_OFF))[u] = 0u;
    __syncthreads();
    XcdBarrier bar; bar.bar = (unsigned*)(F.ctl + CW_BAR); bar.x = 0; bar.st = nullptr;
    if (N_LAUNCHES == 1) bar = xcd_barrier_post((unsigned*)(F.ctl + CW_BAR), F.MISC + 8);
#define GRID_BAR() do { if (N_LAUNCHES == 1) xcd_barrier(bar); } while (0)
    const int lo = args.ph_lo, hi = args.ph_hi;
#define IN(k) (lo <= (k) && (k) < hi)
#define SEAM(k) do { if (IN(k) && IN((k) + 1)) GRID_BAR(); } while (0)
    bf16* segs = WSP(bf16, WS_B);
    static_assert(WS_C == WS_B + (size_t)3 * M * 512 * 2, "segments contiguous");
    bf16* ga = WSP(bf16, WS_D); bf16* gm = ga + (size_t)M * 1024;
    bf16* ya = (bf16*)F.out + (size_t)2 * M * 512; bf16* ym = (bf16*)F.out + (size_t)3 * M * 512;
    bf16* P1 = WSP(bf16, WS_C); bf16* merged = WSP(bf16, WS_C + 32 * MiB);
    bf16* x1b = WSP(bf16, WS_A); bf16* hid = WSP(bf16, WS_HID);

    if (IN(0)) { p0_prologue(F); } SEAM(0);
    if (IN(1)) { pg8::Gemm g{WSP(bf16, WS_A), WSP(bf16, WS_WIN), M, NIN, D}; pg8::StaticOrder S; S.init(M, NIN, F.G, (int)blockIdx.x);
        pg8::EpiIn E{segs, ga, C2, M};
        pg8::gemm_phase<pg8::EpiIn, pg8::StaticOrder, PG8_ALIGN, PG8_SP2>(F.lds + RING_OFF, g, S, E); } SEAM(1);
    if (IN(2)) { p2_prep(F); } SEAM(2);
    if (IN(3)) { p3_gate_cloc(F); } SEAM(3);
    if (IN(4)) { p4_attn_scan(F); } SEAM(4);
    if (IN(5)) { p5_mlstm_out(F); } SEAM(5);
    if (IN(6)) { pg8::Gemm g{ya, WSP(bf16, WS_WA), M, D, AW}; pg8::StaticOrder S; S.init(M, D, F.G, (int)blockIdx.x);
        pg8::EpiGate<0> E{ga, nullptr, P1};
        pg8::gemm_phase<pg8::EpiGate<0>, pg8::StaticOrder, PG8_ALIGN, PG8_SP2>(F.lds + RING_OFF, g, S, E); } SEAM(6);
    if (IN(7)) { pg8::Gemm g{ym, WSP(bf16, WS_WM), M, D, MW}; pg8::StaticOrder S; S.init(M, D, F.G, (int)blockIdx.x);
        pg8::EpiGate<1> E{gm, P1, merged};
        pg8::gemm_phase<pg8::EpiGate<1>, pg8::StaticOrder, PG8_ALIGN, PG8_SP2>(F.lds + RING_OFF, g, S, E); } SEAM(7);
    if (IN(8)) { pg8::Gemm g{merged, WSP(bf16, WS_WO), M, D, D}; pg8::StaticOrder S; S.init(M, D, F.G, (int)blockIdx.x);
        pg8::EpiRes<true> E{F.x, F.out, x1b, WSP(float, MS_SSQ1)};
        pg8::gemm_phase<pg8::EpiRes<true>, pg8::StaticOrder, PG8_ALIGN, PG8_SP2>(F.lds + RING_OFF, g, S, E); } SEAM(8);
    if (IN(9)) { pg8::Gemm g{x1b, WSP(bf16, WS_WGU), M, NIN, D}; pg8::StaticOrder S; S.init(M, NIN, F.G, (int)blockIdx.x);
        pg8::EpiSwiGLU E{WSP(float, MS_SSQ1), hid, FF, EPS};
        pg8::gemm_phase<pg8::EpiSwiGLU, pg8::StaticOrder, PG8_ALIGN, PG8_SP2>(F.lds + RING_OFF, g, S, E); } SEAM(9);
    if (IN(10)) { pg8::Gemm g{hid, WSP(bf16, WS_WD), M, D, FF}; pg8::StaticOrder S; S.init(M, D, F.G, (int)blockIdx.x);
        pg8::EpiRes<false> E{F.out, F.out, nullptr, WSP(float, MS_SSQ2)};
        pg8::gemm_phase<pg8::EpiRes<false>, pg8::StaticOrder, PG8_ALIGN, PG8_SP2>(F.lds + RING_OFF, g, S, E); } SEAM(10);
    if (IN(11)) { p11_final_norm(F); }
#undef IN
#undef SEAM
}

extern "C" void kernel_launch(void* const* d_in, const int* in_sizes, int n_in, void* d_out, int out_size, void* d_ws, size_t ws_size, hipStream_t stream) {
    static int grid = 0;
    if (grid == 0) {
        if (n_in != 15 || in_sizes[0] != M * D || out_size != M * D || ws_size < WS_END) { fprintf(stderr, "kernel_launch: unexpected shapes: n_in %d in0 %d out %d ws %zu\n", n_in, n_in > 0 ? in_sizes[0] : -1, out_size, ws_size); grid = -1; return; }
        int dev = 0, cus = 0, per_cu = 0;
        if (hipGetDevice(&dev) != hipSuccess || hipDeviceGetAttribute(&cus, hipDeviceAttributeMultiprocessorCount, dev) != hipSuccess) { grid = -1; return; }
        if (hipFuncSetAttribute((const void*)mk_fwd, hipFuncAttributeMaxDynamicSharedMemorySize, LDS_BYTES) != hipSuccess) { fprintf(stderr, "kernel_launch: hipFuncSetAttribute failed\n"); grid = -1; return; }
        if (hipOccupancyMaxActiveBlocksPerMultiprocessor(&per_cu, (const void*)mk_fwd, NWAVES * 64, LDS_BYTES) != hipSuccess || per_cu < 1) { fprintf(stderr, "kernel_launch: occupancy query says %d blocks per CU\n", per_cu); per_cu = 1; }
        (void)hipGetLastError();
        grid = cus;
    }
    if (grid < 0) return;
    if (hipMemsetAsync((char*)d_ws + WS_CTL, 0, CTL_ZERO_BYTES, stream) != hipSuccess) { fprintf(stderr, "kernel_launch: memset failed\n"); return; }
    Args a{};
    for (int i = 0; i < 15; ++i) a.in[i] = (const float*)d_in[i];
    a.out = (float*)d_out; a.ws = (unsigned char*)d_ws;
    for (int li = 0; li < N_LAUNCHES; ++li) {
        a.ph_lo = (N_LAUNCHES == 1) ? 0 : li; a.ph_hi = (N_LAUNCHES == 1) ? N_PHASES : li + 1; a.li = li;
        hipLaunchKernelGGL(mk_fwd, dim3(grid), dim3(NWAVES * 64), LDS_BYTES, stream, a);
        const hipError_t le = hipPeekAtLastError();
        if (le != hipSuccess) { fprintf(stderr, "kernel_launch: launch %d failed: %s\n", li, hipGetErrorName(le)); break; }
    }
}
```

```cpp
#include <hip/hip_runtime.h>
#include <cstdio>
#include <cstdint>
namespace pg8 {
#define PG8_LAS __attribute__((address_space(3)))
typedef unsigned short bf16_t;
typedef short bf16x8 __attribute__((ext_vector_type(8)));
typedef float f32x4 __attribute__((ext_vector_type(4)));
typedef unsigned u32x4 __attribute__((ext_vector_type(4)));
constexpr int BM = 256, BK = 64, HALF = 128, HTB = HALF * BK * 2  , STAGE_BYTES = 8 * HTB, NXCD = 8, WGM = 8;

__host__ __device__ __forceinline__ int lds_byte(int r, int c) { const int st = (r >> 4) * 2 + (c >> 5), rr = r & 15, cc = c & 31, ob = rr * 64 + cc * 2; return st * 1024 + (ob ^ (((ob >> 9) & 1) << 5)); }
__host__ __device__ __forceinline__ void stage_rc(int b, int& R, int& C) { const int st = b / 1024, sb = b % 1024, swz = sb ^ (((sb >> 9) & 1) << 5); R = (st >> 1) * 16 + swz / 64; C = (st & 1) * 32 + (swz % 64) / 2; }
__host__ __device__ __forceinline__ int perm32(int rho) { const int n = rho >> 4, i = rho & 15; return 8 * (i >> 2) + 4 * n + (i & 3); }

struct Unit { int pm, pn; };
struct Gemm { const bf16_t* A; const bf16_t* Bt; int M, N, K; };

struct StaticOrder {
    int nM, nN, nwg, G, c;
    __host__ __device__ void init(int M, int N, int G_, int c_) { nM = M / BM; nN = N / BM; nwg = nM * nN; G = G_; c = c_; }
    __host__ __device__ bool next(int i, Unit& u) const {
        const long L = (long)i * G + c; if (L >= nwg) return false;
        int wgid = (int)L; { const int q = nwg / NXCD, r = nwg % NXCD, xcd = wgid % NXCD, off = wgid / NXCD; wgid = (xcd < r ? xcd * (q + 1) : r * (q + 1) + (xcd - r) * q) + off; }
        const int nig = WGM * nN, gid = wgid / nig, fm = gid * WGM, gsz = (nM - fm) < WGM ? (nM - fm) : WGM;
        u.pm = fm + ((wgid % nig) % gsz); u.pn = (wgid % nig) / gsz; return true;
    }
    __device__ __forceinline__ void a_ready(const Unit&) const {}
    __device__ __forceinline__ void done(const Unit&) const {}
};

__device__ __forceinline__ unsigned cvt_pk_bf16(float lo, float hi) { unsigned r; asm volatile("v_cvt_pk_bf16_f32 %0, %1, %2" : "=v"(r) : "v"(lo), "v"(hi)); return r; }
typedef float f32x2 __attribute__((ext_vector_type(2)));
template <class Epi, class Sched, bool ALIGN_EPI = false, bool SP2 = false>
__device__ __forceinline__ void gemm_phase(PG8_LAS unsigned char* lds, const Gemm g, const Sched& S, const Epi& E, const int tid) {
    const int wid = __builtin_amdgcn_readfirstlane(tid >> 6), lane = tid & 63, wr = wid >> 2, wc = wid & 3, fr = lane & 15, fq = lane >> 4;
    const int K = g.K, nt = K / BK;
    unsigned voffA[2], voffB[2];
#pragma unroll
    for (int i = 0; i < 2; ++i) { int R, C; stage_rc(tid * 16 + i * 8192, R, C); const int Rb = Epi::PERM ? ((R & ~31) + perm32(R & 31)) : R;
        voffA[i] = (unsigned)(R * K + C) * 2u; voffB[i] = (unsigned)(Rb * K + C) * 2u; }
    const size_t kstep = (size_t)(BK * 2);
    const size_t hstep = (size_t)HALF * K * 2;
    const size_t tstep = 2 * hstep;
    const unsigned ldsw = (unsigned)wid * 1024u;
    const int aoff = lds_byte(wr * 64 + fr, fq * 8), boff = lds_byte(wc * 32 + fr, fq * 8);
#define PG8_SA(b, h) (((b) * 2 + (h)) * HTB)
#define PG8_SB(b, h) ((4 + (b) * 2 + (h)) * HTB)
#define PG8_STAGE(bufoff, gbase, voff) do { _Pragma("unroll") for (int _i = 0; _i < 2; ++_i) \
        __builtin_amdgcn_global_load_lds((const unsigned*)((const char*)(gbase) + (voff)[_i]), (PG8_LAS unsigned*)(lds + (bufoff) + ldsw + _i * 8192), 16, 0, 0); } while (0)
#define PG8_LDA(dst, b, h) do { _Pragma("unroll") for (int m = 0; m < 4; ++m) _Pragma("unroll") for (int k = 0; k < 2; ++k) dst[m][k] = *(const PG8_LAS bf16x8*)(lds + PG8_SA(b, h) + aoff + m * 2048 + k * 1024); } while (0)
#define PG8_LDB(dst, b, h) do { _Pragma("unroll") for (int n = 0; n < 2; ++n) _Pragma("unroll") for (int k = 0; k < 2; ++k) dst[n][k] = *(const PG8_LAS bf16x8*)(lds + PG8_SB(b, h) + boff + n * 2048 + k * 1024); } while (0)
#define PG8_MMA(ai, bj, At, Bt) do { __builtin_amdgcn_s_setprio(1); _Pragma("unroll") for (int m = 0; m < 4; ++m) _Pragma("unroll") for (int n = 0; n < 2; ++n) _Pragma("unroll") for (int k = 0; k < 2; ++k) \
        acc[ai][bj][m][n] = __builtin_amdgcn_mfma_f32_16x16x32_bf16(Bt[n][k], At[m][k], acc[ai][bj][m][n], 0, 0, 0); __builtin_amdgcn_s_setprio(0); } while (0)
#define PG8_WAIT_V(n) asm volatile("s_waitcnt vmcnt(" #n ")" ::: "memory")
#define PG8_WAIT_L(n) asm volatile("s_waitcnt lgkmcnt(" #n ")" ::: "memory")
#define PG8_BAR __builtin_amdgcn_s_barrier()
#define PG8_SCHED __builtin_amdgcn_sched_barrier(0)
    Unit cur, nxt; int ui = 0;
    if (!S.next(0, cur)) return;
    f32x4 acc[2][2][4][2];
#pragma unroll
    for (int a = 0; a < 2; ++a)
#pragma unroll
        for (int b = 0; b < 2; ++b)
#pragma unroll
            for (int m = 0; m < 4; ++m)
#pragma unroll
                for (int n = 0; n < 2; ++n) acc[a][b][m][n] = (f32x4){0.f, 0.f, 0.f, 0.f};
    bf16x8 At[4][2], B0[2][2], B1[2][2];
    const char* cA = (const char*)g.A + (size_t)cur.pm * tstep; const char* cB = (const char*)g.Bt + (size_t)cur.pn * tstep;
    S.a_ready(cur);
    if constexpr (SP2) {
        PG8_STAGE(PG8_SB(0, 0), cB, voffB); PG8_STAGE(PG8_SB(0, 1), cB + hstep, voffB); PG8_STAGE(PG8_SA(0, 0), cA, voffA); PG8_STAGE(PG8_SA(0, 1), cA + hstep, voffA);
        if (wr == 1) PG8_BAR;
        PG8_WAIT_V(2); PG8_BAR;
        PG8_STAGE(PG8_SB(1, 0), cB + kstep, voffB); PG8_STAGE(PG8_SA(1, 0), cA + kstep, voffA); PG8_STAGE(PG8_SB(1, 1), cB + hstep + kstep, voffB);
        PG8_WAIT_V(6); PG8_BAR;
    } else {
        PG8_STAGE(PG8_SB(0, 0), cB, voffB); PG8_STAGE(PG8_SA(0, 0), cA, voffA); PG8_STAGE(PG8_SB(0, 1), cB + hstep, voffB); PG8_STAGE(PG8_SA(0, 1), cA + hstep, voffA);
        if (wr == 1) PG8_BAR;
        PG8_WAIT_V(4); PG8_BAR;
        PG8_STAGE(PG8_SB(1, 0), cB + kstep, voffB); PG8_STAGE(PG8_SA(1, 0), cA + kstep, voffA); PG8_STAGE(PG8_SB(1, 1), cB + hstep + kstep, voffB);
        PG8_WAIT_V(6); PG8_BAR;
    }
    for (;;) {
        const bool has_next = S.next(ui + 1, nxt);
        const char* nA = has_next ? (const char*)g.A + (size_t)nxt.pm * tstep : cA; const char* nB = has_next ? (const char*)g.Bt + (size_t)nxt.pn * tstep : cB;
        for (int t = 0; t < nt; t += 2) {
            const bool last = (t == nt - 2);
            const char* a1 = cA + (size_t)(t + 1) * kstep;
            const char* a2 = last ? nA : cA + (size_t)(t + 2) * kstep; const char* b2 = last ? nB : cB + (size_t)(t + 2) * kstep;
            const char* a3 = a2 + kstep; const char* b3 = b2 + kstep;
            if (last && has_next) S.a_ready(nxt);
            if constexpr (SP2) {
            PG8_LDB(B0, 0, 0); PG8_LDB(B1, 0, 1); PG8_SCHED; PG8_LDA(At, 0, 0); PG8_STAGE(PG8_SA(1, 1), a1 + hstep, voffA);
            PG8_WAIT_V(8); PG8_WAIT_L(0); PG8_BAR; PG8_MMA(0, 0, At, B0); PG8_MMA(0, 1, At, B1); PG8_BAR; PG8_SCHED;
            PG8_LDA(At, 0, 1); PG8_STAGE(PG8_SB(0, 0), b2, voffB); PG8_STAGE(PG8_SB(0, 1), b2 + hstep, voffB); PG8_STAGE(PG8_SA(0, 0), a2, voffA);
            PG8_WAIT_V(8); PG8_WAIT_L(0); PG8_BAR; PG8_MMA(1, 0, At, B0); PG8_MMA(1, 1, At, B1); PG8_BAR; PG8_SCHED;
            PG8_LDB(B0, 1, 0); PG8_LDB(B1, 1, 1); PG8_SCHED; PG8_LDA(At, 1, 0); PG8_STAGE(PG8_SA(0, 1), a2 + hstep, voffA);
            PG8_WAIT_V(8); PG8_WAIT_L(0); PG8_BAR; PG8_MMA(0, 0, At, B0); PG8_MMA(0, 1, At, B1); PG8_BAR; PG8_SCHED;
            PG8_LDA(At, 1, 1); PG8_STAGE(PG8_SB(1, 0), b3, voffB); PG8_STAGE(PG8_SB(1, 1), b3 + hstep, voffB); PG8_STAGE(PG8_SA(1, 0), a3, voffA);
            PG8_WAIT_V(8); PG8_WAIT_L(0); PG8_BAR; PG8_MMA(1, 0, At, B0); PG8_MMA(1, 1, At, B1); PG8_BAR; PG8_SCHED;
            } else {
            PG8_LDB(B0, 0, 0); PG8_SCHED; PG8_LDA(At, 0, 0); PG8_STAGE(PG8_SA(1, 1), a1 + hstep, voffA);
            PG8_WAIT_L(8); PG8_BAR; PG8_WAIT_L(0); PG8_MMA(0, 0, At, B0); PG8_BAR; PG8_SCHED;
            PG8_LDB(B1, 0, 1); PG8_STAGE(PG8_SB(0, 0), b2, voffB);
            PG8_BAR; PG8_WAIT_L(0); PG8_MMA(0, 1, At, B1); PG8_BAR;
            PG8_LDA(At, 0, 1); PG8_STAGE(PG8_SA(0, 0), a2, voffA);
            PG8_BAR; PG8_WAIT_L(0); PG8_MMA(1, 0, At, B0); PG8_BAR; PG8_SCHED;
            PG8_STAGE(PG8_SB(0, 1), b2 + hstep, voffB);
            PG8_WAIT_V(6); PG8_BAR; PG8_MMA(1, 1, At, B1); PG8_BAR;
            PG8_LDB(B0, 1, 0); PG8_SCHED; PG8_LDA(At, 1, 0); PG8_STAGE(PG8_SA(0, 1), a2 + hstep, voffA);
            PG8_WAIT_L(8); PG8_BAR; PG8_WAIT_L(0); PG8_MMA(0, 0, At, B0); PG8_BAR; PG8_SCHED;
            PG8_LDB(B1, 1, 1); PG8_STAGE(PG8_SB(1, 0), b3, voffB);
            PG8_BAR; PG8_WAIT_L(0); PG8_MMA(0, 1, At, B1); PG8_BAR;
            PG8_LDA(At, 1, 1); PG8_STAGE(PG8_SA(1, 0), a3, voffA);
            PG8_BAR; PG8_WAIT_L(0); PG8_MMA(1, 0, At, B0); PG8_BAR; PG8_SCHED;
            PG8_STAGE(PG8_SB(1, 1), b3 + hstep, voffB);
            PG8_WAIT_V(6); PG8_BAR; PG8_MMA(1, 1, At, B1); PG8_BAR;
            }
        }
        if constexpr (ALIGN_EPI) { if (wr == 0) PG8_BAR; }
        if constexpr (!Epi::AFTER_DRAIN) { E(acc, cur, wr, wc, fr, fq); S.done(cur); }
        if (!has_next) break;
#pragma unroll
        for (int a = 0; a < 2; ++a)
#pragma unroll
            for (int b = 0; b < 2; ++b)
#pragma unroll
                for (int m = 0; m < 4; ++m)
#pragma unroll
                    for (int n = 0; n < 2; ++n) acc[a][b][m][n] = (f32x4){0.f, 0.f, 0.f, 0.f};
        cur = nxt; cA = nA; cB = nB; ++ui;
        if constexpr (ALIGN_EPI) { if (wr == 1) PG8_BAR; }
    }
    PG8_WAIT_V(0);
    if constexpr (!ALIGN_EPI) { if (wr == 0) PG8_BAR; }
    PG8_BAR;
    if constexpr (Epi::AFTER_DRAIN) { E.fused(acc, cur, wr, wc, fr, fq, lds, wid, lane); S.done(cur); }
#undef PG8_SA
#undef PG8_SB
#undef PG8_STAGE
#undef PG8_LDA
#undef PG8_LDB
#undef PG8_MMA
#undef PG8_WAIT_V
#undef PG8_WAIT_L
#undef PG8_BAR
#undef PG8_SCHED
}
}

#ifndef PG8_SP2
#define PG8_SP2 true
#endif
#ifndef PG8_ALIGN
#define PG8_ALIGN true
#endif
namespace pg8 {
__device__ __forceinline__ float sigmoidf_fast(float x) { return __builtin_amdgcn_rcpf(1.0f + __builtin_amdgcn_exp2f(-1.4426950408889634f * x)); }
__device__ __forceinline__ float bflo(unsigned w) { return __uint_as_float(w << 16); }
__device__ __forceinline__ float bfhi(unsigned w) { return __uint_as_float(w & 0xffff0000u); }

struct EpiIn {
    static constexpr bool PERM = true, AFTER_DRAIN = false;
    bf16_t* seg; bf16_t* gates; float qscale; int Mrows; float* ksum;
    __device__ __forceinline__ void operator()(const f32x4 (&acc)[2][2][4][2], const Unit& u, int wr, int wc, int fr, int fq) const {
        const int pn = u.pn;
        if (pn >= 2 && pn < 6) {
            const bool isk = pn < 4; bf16_t* base = seg + (size_t)(isk ? 1 : 2) * Mrows * 512; const int j = u.pm;
            float cs[2][8];
#pragma unroll
            for (int bj = 0; bj < 2; ++bj)
#pragma unroll
                for (int e = 0; e < 8; ++e) cs[bj][e] = 0.f;
#pragma unroll
            for (int bj = 0; bj < 2; ++bj) { const int cc = (pn & 1) * 256 + bj * HALF + wc * 32, h = cc >> 6;
                bf16_t* tb = base + (size_t)(h * 64 + j) * 16384 + (isk ? (4 * (wc & 1) + fq) * 2048 : (wc & 1) * 8192 + 8 * fq);
#pragma unroll
                for (int ai = 0; ai < 2; ++ai)
#pragma unroll
                    for (int m = 0; m < 4; ++m) { const int key = ai * HALF + wr * 64 + m * 16 + fr; const f32x4 v0 = acc[ai][bj][m][0], v1 = acc[ai][bj][m][1];
                        u32x4 w; w.x = cvt_pk_bf16(v0[0], v0[1]); w.y = cvt_pk_bf16(v0[2], v0[3]); w.z = cvt_pk_bf16(v1[0], v1[1]); w.w = cvt_pk_bf16(v1[2], v1[3]);
                        *(u32x4*)(tb + (size_t)key * (isk ? 8 : 32)) = w;
                        if (isk) {
#pragma unroll
                            for (int e = 0; e < 4; ++e) { cs[bj][e] += v0[e]; cs[bj][4 + e] += v1[e]; } } } }
            if (isk) {
#pragma unroll
                for (int bj = 0; bj < 2; ++bj)
#pragma unroll
                    for (int e = 0; e < 8; ++e) { float v = cs[bj][e]; v += __shfl_xor(v, 1); v += __shfl_xor(v, 2); v += __shfl_xor(v, 4); v += __shfl_xor(v, 8); cs[bj][e] = v; }
                if (fr == 0) {
#pragma unroll
                    for (int bj = 0; bj < 2; ++bj) { const int cc = (pn & 1) * 256 + bj * HALF + wc * 32 + 8 * fq;
#pragma unroll
                        for (int e = 0; e < 8; ++e) atomicAdd(ksum + ((size_t)((cc >> 6) * 64 + j)) * 64 + (cc & 63) + e, cs[bj][e]); } }
            }
            return;
        }
        bf16_t* base; int ldc, colt, mode;
        if (pn < 14) { const int s = pn >> 1; base = seg + (size_t)s * Mrows * 512; ldc = 512; colt = (pn & 1) * 256; mode = (s == 0) ? 1 : 0; }
        else { const int g = (pn - 14) >> 2; base = gates + (size_t)g * Mrows * 1024; ldc = 1024; colt = ((pn - 14) & 3) * 256; mode = 2; }
        const int row0 = u.pm * BM + wr * 64 + fr, col0 = colt + wc * 32 + 8 * fq;
#pragma unroll
        for (int ai = 0; ai < 2; ++ai)
#pragma unroll
            for (int m = 0; m < 4; ++m) { bf16_t* rowp = base + (size_t)(row0 + ai * HALF + m * 16) * ldc + col0;
#pragma unroll
                for (int bj = 0; bj < 2; ++bj) { f32x4 v0 = acc[ai][bj][m][0], v1 = acc[ai][bj][m][1];
                    if (mode == 1) { v0 = v0 * qscale; v1 = v1 * qscale; }
                    else if (mode == 2) {
#pragma unroll
                        for (int e = 0; e < 4; ++e) { v0[e] = sigmoidf_fast(v0[e]); v1[e] = sigmoidf_fast(v1[e]); } }
                    u32x4 w; w.x = cvt_pk_bf16(v0[0], v0[1]); w.y = cvt_pk_bf16(v0[2], v0[3]); w.z = cvt_pk_bf16(v1[0], v1[1]); w.w = cvt_pk_bf16(v1[2], v1[3]);
                    *(u32x4*)(rowp + bj * HALF) = w; } }
    }
};
template <int MODE> struct EpiGate {
    static constexpr bool PERM = true, AFTER_DRAIN = false;
    const bf16_t* G; const bf16_t* P; bf16_t* O;
    __device__ __forceinline__ void operator()(const f32x4 (&acc)[2][2][4][2], const Unit& u, int wr, int wc, int fr, int fq) const {
        const int row0 = u.pm * BM + wr * 64 + fr, col0 = u.pn * BM + wc * 32 + 8 * fq;
#pragma unroll
        for (int ai = 0; ai < 2; ++ai)
#pragma unroll
            for (int m = 0; m < 4; ++m) { const size_t off = (size_t)(row0 + ai * HALF + m * 16) * 1024 + col0;
#pragma unroll
                for (int bj = 0; bj < 2; ++bj) { const f32x4 v0 = acc[ai][bj][m][0], v1 = acc[ai][bj][m][1];
                    const u32x4 g = *(const u32x4*)(G + off + bj * HALF);
                    float r[8] = { bflo(g.x) * v0[0], bfhi(g.x) * v0[1], bflo(g.y) * v0[2], bfhi(g.y) * v0[3], bflo(g.z) * v1[0], bfhi(g.z) * v1[1], bflo(g.w) * v1[2], bfhi(g.w) * v1[3] };
                    if (MODE == 1) { const u32x4 p = *(const u32x4*)(P + off + bj * HALF);
                        r[0] += bflo(p.x); r[1] += bfhi(p.x); r[2] += bflo(p.y); r[3] += bfhi(p.y); r[4] += bflo(p.z); r[5] += bfhi(p.z); r[6] += bflo(p.w); r[7] += bfhi(p.w); }
                    u32x4 w; w.x = cvt_pk_bf16(r[0], r[1]); w.y = cvt_pk_bf16(r[2], r[3]); w.z = cvt_pk_bf16(r[4], r[5]); w.w = cvt_pk_bf16(r[6], r[7]);
                    *(u32x4*)(O + off + bj * HALF) = w; } }
    }
};
template <bool WITH_BF> struct EpiRes {
    static constexpr bool PERM = false, AFTER_DRAIN = false;
    const float* base; float* out; bf16_t* xb; float* ssq;
    __device__ __forceinline__ void operator()(const f32x4 (&acc)[2][2][4][2], const Unit& u, int wr, int wc, int fr, int fq) const {
        typedef unsigned u32x2v __attribute__((ext_vector_type(2)));
        const int row0 = u.pm * BM + wr * 64 + fr, col0 = u.pn * BM + wc * 32 + 4 * fq;
#pragma unroll
        for (int ai = 0; ai < 2; ++ai)
#pragma unroll
            for (int m = 0; m < 4; ++m) { const int row = row0 + ai * HALF + m * 16; const size_t off = (size_t)row * 1024 + col0; float ss = 0.f;
#pragma unroll
                for (int bj = 0; bj < 2; ++bj)
#pragma unroll
                    for (int n = 0; n < 2; ++n) { const size_t o2 = off + bj * HALF + n * 16; const f32x4 o = *(const f32x4*)(base + o2) + acc[ai][bj][m][n];
                        *(f32x4*)(out + o2) = o; ss += (o[0] * o[0] + o[1] * o[1]) + (o[2] * o[2] + o[3] * o[3]);
                        if (WITH_BF) { u32x2v w; w.x = cvt_pk_bf16(o[0], o[1]); w.y = cvt_pk_bf16(o[2], o[3]); *(u32x2v*)(xb + o2) = w; } }
                ss += __shfl_xor(ss, 16); ss += __shfl_xor(ss, 32);
                if (fq == 0) ssq[(size_t)row * 16 + u.pn * 4 + wc] = ss; }
    }
};
struct EpiSwiGLU {
    static constexpr bool PERM = true, AFTER_DRAIN = false;
    const float* ssq; bf16_t* Hd; int ldh; float eps;
    __device__ __forceinline__ void operator()(const f32x4 (&acc)[2][2][4][2], const Unit& u, int wr, int wc, int fr, int fq) const {
        const int row0 = u.pm * BM + wr * 64 + fr, col0 = u.pn * HALF + wc * 32 + 8 * fq;
#pragma unroll
        for (int ai = 0; ai < 2; ++ai)
#pragma unroll
            for (int m = 0; m < 4; ++m) { const int row = row0 + ai * HALF + m * 16; const f32x4* sp = (const f32x4*)(ssq + (size_t)row * 16);
                const f32x4 s0 = sp[0], s1 = sp[1], s2 = sp[2], s3 = sp[3];
                const float tot = ((s0[0] + s0[1]) + (s0[2] + s0[3])) + ((s1[0] + s1[1]) + (s1[2] + s1[3])) + ((s2[0] + s2[1]) + (s2[2] + s2[3])) + ((s3[0] + s3[1]) + (s3[2] + s3[3]));
                const float rs = 1.0f / sqrtf(tot * (1.0f / 1024.0f) + eps);
                float r[8];
#pragma unroll
                for (int n = 0; n < 2; ++n)
#pragma unroll
                    for (int e = 0; e < 4; ++e) { const float g = acc[ai][0][m][n][e] * rs, up = acc[ai][1][m][n][e] * rs; r[n * 4 + e] = g * sigmoidf_fast(g) * up; }
                u32x4 w; w.x = cvt_pk_bf16(r[0], r[1]); w.y = cvt_pk_bf16(r[2], r[3]); w.z = cvt_pk_bf16(r[4], r[5]); w.w = cvt_pk_bf16(r[6], r[7]);
                *(u32x4*)(Hd + (size_t)row * ldh + col0) = w; }
    }
};
}
#define GAS __attribute__((address_space(1)))
#define LAS __attribute__((address_space(3)))
typedef unsigned short bf16;
typedef unsigned v4u __attribute__((ext_vector_type(4)));
typedef float f32x4 __attribute__((ext_vector_type(4)));
typedef short bf16x8 __attribute__((ext_vector_type(8)));
typedef GAS unsigned gu32;
typedef GAS unsigned long long gu64;
#define RLX_AGENT __ATOMIC_RELAXED, __HIP_MEMORY_SCOPE_AGENT
#define LDS_WAIT() asm volatile("s_waitcnt lgkmcnt(0)" ::: "memory")
#define VM_WAIT() asm volatile("s_waitcnt vmcnt(0)" ::: "memory")
__device__ __forceinline__ unsigned long long rt() { return __builtin_amdgcn_s_memrealtime(); }
__device__ __forceinline__ unsigned f2bf(float f) { unsigned u = __builtin_bit_cast(unsigned, f); return (u + 0x7fffu + ((u >> 16) & 1u)) >> 16; }
__device__ __forceinline__ unsigned pk2(float lo, float hi) { return f2bf(lo) | (f2bf(hi) << 16); }

#define XB_TMO      128
#define XB_XCNT(j)  (256  + 64 * (j))
#define XB_XSUB(j)  (1280 + 64 * (j))
#define XB_XGEN(j)  (2304 + 64 * (j))
#define XB_TOP      3328
#define XB_TOPGEN   3392
#define XCD_BAR_WORDS 3456
#define XB_SPIN_CAP (1u << 18)

__device__ __forceinline__ unsigned xb_ld(unsigned* p)              { return __hip_atomic_load(p, __ATOMIC_RELAXED, __HIP_MEMORY_SCOPE_AGENT); }
__device__ __forceinline__ unsigned xb_add(unsigned* p, unsigned v) { return __hip_atomic_fetch_add(p, v, __ATOMIC_RELAXED, __HIP_MEMORY_SCOPE_AGENT); }
__device__ __forceinline__ unsigned xb_xcc_id() { return (unsigned)__builtin_amdgcn_s_getreg((3 << 11) | 20) & 0xFu; }
#define XB_SPIN(cond, bar) do { unsigned _sp = 0; while (cond) { __builtin_amdgcn_s_sleep(1); \
    if ((++_sp & 255u) == 0u) { if (xb_ld(&(bar)[XB_TMO])) break; if (_sp > XB_SPIN_CAP) { atomicAdd(&(bar)[XB_TMO], 1u); break; } } } } while (0)

struct XcdBarrier {
    unsigned* bar; unsigned x;
    volatile LAS unsigned* st;
};

__device__ __forceinline__ XcdBarrier xcd_barrier_post(unsigned* bar, volatile LAS unsigned* st, const int tid_) {
    XcdBarrier b; b.bar = bar; b.x = xb_xcc_id(); b.st = st;
    if (tid_ == 0) (void)xb_add(&bar[XB_XCNT(b.x)], 1u);
    return b;
}
__device__ __forceinline__ void xcd_barrier_complete(unsigned* bar, unsigned x, unsigned& nloc, unsigned& nx) {
    const unsigned G = gridDim.x * gridDim.y * gridDim.z;
    unsigned sum, cnt, mine, sp = 0u;
    for (;;) {
        sum = 0u; cnt = 0u; mine = 0u;
#pragma unroll
        for (unsigned j = 0; j < 16; ++j) { const unsigned c = xb_ld(&bar[XB_XCNT(j)]); sum += c; cnt += (c > 0u) ? 1u : 0u; mine = (j == x) ? c : mine; }
        if (sum == G) break;
        __builtin_amdgcn_s_sleep(1);
        if ((++sp & 255u) == 0u) { if (xb_ld(&bar[XB_TMO])) break; if (sp > XB_SPIN_CAP) { atomicAdd(&bar[XB_TMO], 1u); break; } }
    }
    nloc = mine > 0u ? mine : 1u; nx = cnt > 0u ? cnt : 1u;
}

__device__ __forceinline__ void xcd_barrier(const XcdBarrier& b, const int tid_) {
    asm volatile("s_waitcnt vmcnt(0)" ::: "memory");
    __syncthreads();
    if (tid_ == 0) {
        unsigned* bar = b.bar;
        __builtin_amdgcn_s_waitcnt(0);
        unsigned nloc = b.st[0], nx = b.st[1];
        if (nloc == 0u) { xcd_barrier_complete(bar, b.x, nloc, nx); b.st[0] = nloc; b.st[1] = nx; }
        const unsigned old = xb_add(&bar[XB_XSUB(b.x)], 1u);
        const unsigned gen = old / nloc;
        if (old + 1u == (gen + 1u) * nloc) {
            __builtin_amdgcn_fence(__ATOMIC_RELEASE, "agent");
            asm volatile("s_waitcnt vmcnt(0)" ::: "memory");
            const unsigned og = xb_add(&bar[XB_TOP], 1u);
            const unsigned tg = og / nx;
            if (og + 1u == (tg + 1u) * nx) xb_add(&bar[XB_TOPGEN], 1u);
            else XB_SPIN(xb_ld(&bar[XB_TOPGEN]) == tg, bar);
            __builtin_amdgcn_fence(__ATOMIC_ACQUIRE, "agent");
            xb_add(&bar[XB_XGEN(b.x)], 1u);
            asm volatile("s_waitcnt vmcnt(0)" ::: "memory");
        } else {
            XB_SPIN(xb_ld(&bar[XB_XGEN(b.x)]) == gen, bar);
            __builtin_amdgcn_fence(__ATOMIC_ACQUIRE, "agent");
            asm volatile("s_waitcnt vmcnt(0)" ::: "memory");
        }
    }
    __syncthreads();
}
constexpr int NWAVES = 8;
constexpr int N_PHASES = 11;
#ifndef MK_N_LAUNCHES
#define MK_N_LAUNCHES 1
#endif
constexpr int N_LAUNCHES = MK_N_LAUNCHES;

constexpr int M = 16384, D = 1024, NIN = 5632, FF = 2816, INW = 5640;
constexpr int AH = 8, AD = 64, AW = 512, MH = 4, MD = 128, MW = 512, NBLK = 64, NCH = 128, CL = 128;
constexpr float EPS = 1e-6f;
constexpr float LOG2E = 1.4426950408889634f;
constexpr float C2 = 0.125f * LOG2E;

constexpr size_t MiB = 1u << 20;
constexpr size_t WS_CTL = 0, CTL_ZERO_BYTES = 1 * MiB;
constexpr size_t WS_WIN = 1 * MiB;
constexpr size_t WS_WGU = 12 * MiB;
constexpr size_t WS_WD = 23 * MiB;
constexpr size_t WS_WO = 29 * MiB;
constexpr size_t WS_WA = 31 * MiB;
constexpr size_t WS_WM = 32 * MiB;
constexpr size_t WS_MISC = 33 * MiB;
constexpr size_t MS_LOGI = WS_MISC;
constexpr size_t MS_LOGF = MS_LOGI + 256 * 1024;
constexpr size_t MS_BCUM = MS_LOGF + 256 * 1024;
constexpr size_t MS_KMEAN = MS_BCUM + 256 * 1024;
constexpr size_t MS_SEL = MS_KMEAN + 128 * 1024;
constexpr size_t MS_CHS = MS_SEL + 512 * 1024;
constexpr size_t MS_NST = MS_CHS + 64 * 1024;
constexpr size_t MS_SSQ1 = MS_NST + 256 * 1024;
constexpr size_t MS_SSQ2 = MS_SSQ1 + 1024 * 1024;
constexpr size_t MS_MASK = MS_SSQ2 + 1024 * 1024;
static_assert(MS_MASK + 1024 * 1024 <= 40 * MiB, "misc");
constexpr size_t WS_A = 40 * MiB;
constexpr size_t WS_B = 72 * MiB;
constexpr size_t WS_C = 120 * MiB;
constexpr size_t WS_D = 184 * MiB;
constexpr size_t WS_HID = 120 * MiB;
constexpr size_t WS_END = 256 * MiB;
static_assert(WS_HID + (size_t)M * FF * 2 <= WS_END, "hidden overlay");

constexpr int CW_TMO = 0, CW_CODE = 1, CW_TOT = 2048  , CW_BAR = 4096, CW_KSUM = 65536  ;

constexpr int RING_OFF = 0, RING_BYTES = 131072;
constexpr int LDS_BYTES = 147456;
constexpr int LDSCTL_OFF = LDS_BYTES - 512, MISC_OFF = LDSCTL_OFF + 320;


__device__ __forceinline__ float bf2f(unsigned short v) { return __uint_as_float((unsigned)v << 16); }
__device__ __forceinline__ float blo(unsigned w) { return __uint_as_float(w << 16); }
__device__ __forceinline__ float bhi(unsigned w) { return __uint_as_float(w & 0xffff0000u); }
__device__ __forceinline__ float wave_sum(float v) {
#pragma unroll
    for (int o = 1; o < 64; o <<= 1) v += __shfl_xor(v, o);
    return v;
}
__device__ __forceinline__ float wave_max(float v) {
#pragma unroll
    for (int o = 1; o < 64; o <<= 1) v = fmaxf(v, __shfl_xor(v, o));
    return v;
}
__device__ __forceinline__ float sigm(float x) { return 1.0f / (1.0f + __expf(-x)); }

struct Frame {
    LAS unsigned char* lds;
    volatile LAS unsigned* MISC;
    gu32* ctl;
    int tid, lane, wave, vcu, G;
    float* out; unsigned char* ws;
};
typedef const float* cfptr;
#define INP(k) (((LAS cfptr*)(F.lds + LDSCTL_OFF))[k])
#define IN_X INP(0)
#define IN_MIXG INP(1)
#define IN_WIN INP(2)
#define IN_CONV INP(3)
#define IN_BIG INP(4)
#define IN_BFG INP(5)
#define IN_MNG INP(6)
#define IN_WOA INP(7)
#define IN_WOM INP(8)
#define IN_WO INP(9)
#define IN_FFNG INP(10)
#define IN_WFG INP(11)
#define IN_WFU INP(12)
#define IN_WFD INP(13)
#define IN_FING INP(14)
#define WSP(T, off) ((T*)(F.ws + (off)))

__device__ __forceinline__ void tr_item(const float* W, int ldw, int k0, int n_src0, bf16* WT, int ldt, int dst_row0, const float* kscale, LAS float* scr, int lane) {
#pragma unroll 8
    for (int i = 0; i < 32; ++i) { const int kk = 2 * i + (lane >> 5); float v = W[(size_t)(k0 + kk) * ldw + n_src0 + (lane & 31)]; if (kscale) v *= kscale[k0 + kk]; scr[kk * 33 + (lane & 31)] = v; }
    LDS_WAIT(); asm volatile("" ::: "memory");
    const int c = lane & 7;
#pragma unroll
    for (int j = 0; j < 4; ++j) { const int n = (lane >> 3) + 8 * j; const LAS float* s = scr + (8 * c) * 33 + n;
        v4u o; o.x = pk2(s[0 * 33], s[1 * 33]); o.y = pk2(s[2 * 33], s[3 * 33]); o.z = pk2(s[4 * 33], s[5 * 33]); o.w = pk2(s[6 * 33], s[7 * 33]);
        *(GAS v4u*)(WT + (size_t)(dst_row0 + n) * ldt + k0 + 8 * c) = o; }
    LDS_WAIT(); asm volatile("" ::: "memory");
}
__device__ __forceinline__ float log_sigmoid(float z) { return fminf(z, 0.f) - log1pf(__expf(-fabsf(z))); }

__device__ __forceinline__ void p0_prologue(Frame& F) {
    const int gw = F.vcu * NWAVES + F.wave, NGW = F.G * NWAVES, lane = F.lane;
    LAS float* gt = (LAS float*)(F.lds + RING_OFF);
    for (int i = F.tid; i < 8192; i += NWAVES * 64) { const int k = i >> 3, c = i & 7; gt[c * 1024 + k] = IN_WIN[(size_t)k * INW + 3584 + c]; }
    __syncthreads();
    LAS float* scr = (LAS float*)(F.lds + RING_OFF + 32768 + F.wave * 8704);
    constexpr int I_IN = 16 * 176, I_GU = 16 * 88, I_D = 44 * 32, I_O = 16 * 32, I_A = 8 * 32;
    constexpr int NITEMS = I_IN + 2 * I_GU + I_D + I_O + 2 * I_A;
    bf16* Win = WSP(bf16, WS_WIN); bf16* Wgu = WSP(bf16, WS_WGU); bf16* Wd = WSP(bf16, WS_WD); bf16* Wo = WSP(bf16, WS_WO); bf16* Wa = WSP(bf16, WS_WA); bf16* Wm = WSP(bf16, WS_WM);
    for (int it = gw; it < NITEMS; it += NGW) {
        int r = it;
        if (r < I_IN) { const int kb = r / 176, nb = r % 176; const int ns = nb < 112 ? 32 * nb : 3592 + 32 * (nb - 112), nd = nb < 112 ? 32 * nb : 3584 + 32 * (nb - 112);
            tr_item(IN_WIN, INW, 64 * kb, ns, Win, D, nd, nullptr, scr, lane); continue; } r -= I_IN;
        if (r < I_GU) { const int kb = r / 88, nb = r % 88; tr_item(IN_WFG, FF, 64 * kb, 32 * nb, Wgu, D, 256 * (nb >> 2) + 32 * (nb & 3), IN_FFNG, scr, lane); continue; } r -= I_GU;
        if (r < I_GU) { const int kb = r / 88, nb = r % 88; tr_item(IN_WFU, FF, 64 * kb, 32 * nb, Wgu, D, 256 * (nb >> 2) + 128 + 32 * (nb & 3), IN_FFNG, scr, lane); continue; } r -= I_GU;
        if (r < I_D) { const int kb = r / 32, nb = r % 32; tr_item(IN_WFD, D, 64 * kb, 32 * nb, Wd, FF, 32 * nb, nullptr, scr, lane); continue; } r -= I_D;
        if (r < I_O) { const int kb = r / 32, nb = r % 32; tr_item(IN_WO, D, 64 * kb, 32 * nb, Wo, D, 32 * nb, nullptr, scr, lane); continue; } r -= I_O;
        if (r < I_A) { const int kb = r / 32, nb = r % 32; tr_item(IN_WOA, D, 64 * kb, 32 * nb, Wa, AW, 32 * nb, nullptr, scr, lane); continue; } r -= I_A;
        { const int kb = r / 32, nb = r % 32; tr_item(IN_WOM, D, 64 * kb, 32 * nb, Wm, MW, 32 * nb, nullptr, scr, lane); }
    }
    bf16* Hn = WSP(bf16, WS_A); float* logi = WSP(float, MS_LOGI); float* logf = WSP(float, MS_LOGF);
    f32x4 gv[4];
#pragma unroll
    for (int j = 0; j < 4; ++j) gv[j] = ((const GAS f32x4*)IN_MIXG)[lane + 64 * j];
    for (int m = gw; m < M; m += NGW) {
        const GAS f32x4* xr = (const GAS f32x4*)(IN_X + (size_t)m * D) + lane;
        f32x4 v[4]; float s = 0.f;
#pragma unroll
        for (int j = 0; j < 4; ++j) { v[j] = xr[64 * j]; s += (v[j].x * v[j].x + v[j].y * v[j].y) + (v[j].z * v[j].z + v[j].w * v[j].w); }
        const float rstd = 1.0f / sqrtf(wave_sum(s) * (1.f / D) + EPS);
#pragma unroll
        for (int j = 0; j < 4; ++j) v[j] = v[j] * rstd * gv[j];
        GAS unsigned long long* o8 = (GAS unsigned long long*)(Hn + (size_t)m * D) + lane;
#pragma unroll
        for (int j = 0; j < 4; ++j) o8[64 * j] = (unsigned long long)pk2(v[j].x, v[j].y) | ((unsigned long long)pk2(v[j].z, v[j].w) << 32);
        float ga[8];
#pragma unroll
        for (int c = 0; c < 8; ++c) { float a = 0.f;
#pragma unroll
            for (int j = 0; j < 4; ++j) { const f32x4 w = *(const LAS f32x4*)(gt + c * 1024 + 4 * lane + 256 * j); a += (v[j].x * w.x + v[j].y * w.y) + (v[j].z * w.z + v[j].w * w.w); }
            ga[c] = wave_sum(a); }
#pragma unroll
        for (int c = 0; c < 4; ++c) { if (lane == c) logi[(size_t)m * 4 + c] = ga[c] + IN_BIG[c]; if (lane == 4 + c) logf[(size_t)m * 4 + c] = log_sigmoid(ga[4 + c] + IN_BFG[c]); }
    }
}

__device__ __forceinline__ float wave_incl_scan(float v, int lane) {
#pragma unroll
    for (int o = 1; o < 64; o <<= 1) { const float t = __shfl_up(v, o); if (lane >= o) v += t; }
    return v;
}
__device__ __forceinline__ void gate_prep(Frame& F) {
    const int gw = F.vcu * NWAVES + F.wave, NGW = F.G * NWAVES, lane = F.lane;
    const float* logi = WSP(float, MS_LOGI); const float* logf = WSP(float, MS_LOGF); float* bcum = WSP(float, MS_BCUM); float* chs = WSP(float, MS_CHS);
    for (int it = gw; it < MH * NCH; it += NGW) { const int h = it >> 7, c = it & 127, t0 = c * CL;
        float v0 = logf[(size_t)(t0 + lane) * 4 + h], v1 = logf[(size_t)(t0 + 64 + lane) * 4 + h];
        v0 = wave_incl_scan(v0, lane); const float tot0 = __shfl(v0, 63); v1 = wave_incl_scan(v1, lane) + tot0; const float bl = __shfl(v1, 63);
        bcum[(size_t)h * M + t0 + lane] = v0; bcum[(size_t)h * M + t0 + 64 + lane] = v1;
        const float g0 = bl - v0 + logi[(size_t)(t0 + lane) * 4 + h], g1 = bl - v1 + logi[(size_t)(t0 + 64 + lane) * 4 + h];
        const float gm = wave_max(fmaxf(g0, g1));
        if (lane == 0) { chs[0 * 512 + it] = bl; chs[1 * 512 + it] = gm; } }
}
__device__ __forceinline__ void conv8(const bf16* src, int t, int c0, const float* cw, float scale, float (&acc)[8]) {
#pragma unroll
    for (int e = 0; e < 8; ++e) acc[e] = 0.f;
#pragma unroll
    for (int j = 0; j < 4; ++j) { const int tt = t - 3 + j; if (tt >= 0) { const v4u w = *(const GAS v4u*)(src + (size_t)tt * 512 + c0); const f32x4 w0 = *(const GAS f32x4*)(cw + (size_t)j * 1024), w1 = *(const GAS f32x4*)(cw + (size_t)j * 1024 + 4);
            acc[0] += blo(w.x) * w0.x; acc[1] += bhi(w.x) * w0.y; acc[2] += blo(w.y) * w0.z; acc[3] += bhi(w.y) * w0.w; acc[4] += blo(w.z) * w1.x; acc[5] += bhi(w.z) * w1.y; acc[6] += blo(w.w) * w1.z; acc[7] += bhi(w.w) * w1.w; } }
#pragma unroll
    for (int e = 0; e < 8; ++e) acc[e] = acc[e] * sigm(acc[e]) * scale;
}

__device__ __forceinline__ void p2_gate_cloc(Frame& F) {
    const int lane = F.lane, tid = F.tid;
    {
        const bf16* qa = WSP(bf16, WS_B); const float* kmean = (const float*)(F.ctl + CW_KSUM); unsigned* sel = WSP(unsigned, MS_SEL); unsigned long long* mask3 = WSP(unsigned long long, MS_MASK); unsigned* tot = (unsigned*)(F.ctl + CW_TOT);
        LAS float* kl = (LAS float*)(F.lds + RING_OFF);
        for (int qg = F.vcu; qg < M / 64; qg += F.G) {
            const int b = (qg * 64) >> 8;
            __syncthreads();
            for (int i = tid; i < 8 * 64 * 16; i += NWAVES * 64) { const int h = i >> 10, rem = i & 1023; if ((rem >> 4) < b) *(LAS f32x4*)(kl + h * 4096 + rem * 4) = *(const GAS f32x4*)(kmean + h * 4096 + rem * 4); }
            __syncthreads();
            const int h = F.wave, q = qg * 64 + lane;
            float qf[64];
            { const GAS v4u* qp = (const GAS v4u*)(qa + (size_t)q * 512 + h * 64);
#pragma unroll
              for (int i = 0; i < 8; ++i) { const v4u w = qp[i]; qf[8 * i + 0] = blo(w.x); qf[8 * i + 1] = bhi(w.x); qf[8 * i + 2] = blo(w.y); qf[8 * i + 3] = bhi(w.y); qf[8 * i + 4] = blo(w.z); qf[8 * i + 5] = bhi(w.z); qf[8 * i + 6] = blo(w.w); qf[8 * i + 7] = bhi(w.w); } }
            float v0 = -INFINITY, v1 = -INFINITY, v2 = -INFINITY; int j0 = 0, j1 = 0, j2 = 0;
            for (int j = 0; j < b; ++j) { const LAS f32x4* kp = (const LAS f32x4*)(kl + h * 4096 + j * 64); float s = 0.f;
#pragma unroll
                for (int i = 0; i < 16; ++i) { const f32x4 k4 = kp[i]; s += (qf[4 * i] * k4.x + qf[4 * i + 1] * k4.y) + (qf[4 * i + 2] * k4.z + qf[4 * i + 3] * k4.w); }
                if (s > v2) { if (s > v1) { v2 = v1; j2 = j1; if (s > v0) { v1 = v0; j1 = j0; v0 = s; j0 = j; } else { v1 = s; j1 = j; } } else { v2 = s; j2 = j; } } }
            const int n = b < 3 ? b : 3;
            sel[(size_t)h * M + q] = (unsigned)j0 | ((unsigned)j1 << 8) | ((unsigned)j2 << 16) | ((unsigned)n << 24);
            unsigned long long mymask = 0ull;
            for (int j = 0; j < b; ++j) { const unsigned long long mk = __ballot((n > 0 && j0 == j) || (n > 1 && j1 == j) || (n > 2 && j2 == j)); if (lane == j) mymask = mk; }
            if (lane < b) { mask3[((size_t)h * 256 + qg) * 64 + lane] = mymask; const int pc = __popcll(mymask); if (pc) atomicAdd(tot + h * 64 + lane, (unsigned)pc); }
        }
        __syncthreads();
    }
    {
        const bf16* km = WSP(bf16, WS_C) + (size_t)M * 512; const bf16* vm = WSP(bf16, WS_C) + (size_t)2 * M * 512;
        const float* logi = WSP(float, MS_LOGI); const float* bcum = WSP(float, MS_BCUM); float* chs = WSP(float, MS_CHS);
        float* Cl = WSP(float, WS_A); float* nst = WSP(float, MS_NST);
        LAS bf16* KW = (LAS bf16*)(F.lds + RING_OFF); LAS bf16* VV = (LAS bf16*)(F.lds + RING_OFF + 32768); LAS float* sh = (LAS float*)(F.lds + RING_OFF + 65536);
        for (int it = F.vcu; it < MH * NCH; it += F.G) { const int h = it >> 7, c = it & 127, t0 = c * CL;
            __syncthreads();
            if (tid == 0) { float m = 0.f, mp = 0.f; for (int cc = 0; cc <= c; ++cc) { mp = m; m = fmaxf(chs[0 * 512 + h * 128 + cc] + m, chs[1 * 512 + h * 128 + cc]); }
                sh[0] = mp; sh[1] = m; const float bl = chs[0 * 512 + it]; chs[2 * 512 + it] = mp; chs[3 * 512 + it] = m; chs[4 * 512 + it] = __expf(bl + mp - m); }
            __syncthreads();
            if (tid < 128) { const float bl = chs[0 * 512 + it]; sh[8 + tid] = __expf(bl - bcum[(size_t)h * M + t0 + tid] + logi[(size_t)(t0 + tid) * 4 + h] - sh[1]); }
            __syncthreads();
#pragma unroll
            for (int i = 0; i < 4; ++i) { const int idx = tid + 512 * i, r = idx >> 4, ci = idx & 15; const float w = sh[8 + r];
                float kk[8]; conv8(km, t0 + r, h * 128 + ci * 8, IN_CONV + 512 + h * 128 + ci * 8, 0.08838834764831845f, kk); v4u o;
                { const float k0 = bf2f((bf16)f2bf(kk[0])), k1 = bf2f((bf16)f2bf(kk[1])), k2 = bf2f((bf16)f2bf(kk[2])), k3 = bf2f((bf16)f2bf(kk[3])), k4 = bf2f((bf16)f2bf(kk[4])), k5 = bf2f((bf16)f2bf(kk[5])), k6 = bf2f((bf16)f2bf(kk[6])), k7 = bf2f((bf16)f2bf(kk[7]));
                  o.x = pk2(k0 * w, k1 * w); o.y = pk2(k2 * w, k3 * w); o.z = pk2(k4 * w, k5 * w); o.w = pk2(k6 * w, k7 * w); }
                *(LAS v4u*)(KW + r * 128 + ci * 8) = o;
                *(LAS v4u*)(VV + r * 128 + ci * 8) = *(const GAS v4u*)(vm + (size_t)(t0 + r) * 512 + h * 128 + ci * 8); }
            __syncthreads();
            const int dk = tid >> 2, e0 = (tid & 3) * 32; float acc[32]; float ns = 0.f;
#pragma unroll
            for (int e = 0; e < 32; ++e) acc[e] = 0.f;
            for (int s = 0; s < 128; ++s) { const float a = bf2f(KW[s * 128 + dk]); ns += a;
#pragma unroll
                for (int i = 0; i < 4; ++i) { const v4u w = *(const LAS v4u*)(VV + s * 128 + e0 + 8 * i);
                    acc[8 * i + 0] += a * blo(w.x); acc[8 * i + 1] += a * bhi(w.x); acc[8 * i + 2] += a * blo(w.y); acc[8 * i + 3] += a * bhi(w.y); acc[8 * i + 4] += a * blo(w.z); acc[8 * i + 5] += a * bhi(w.z); acc[8 * i + 6] += a * blo(w.w); acc[8 * i + 7] += a * bhi(w.w); } }
            float* dst = Cl + ((size_t)it * 128 + dk) * 128 + e0;
#pragma unroll
            for (int i = 0; i < 8; ++i) *(GAS f32x4*)(dst + 4 * i) = (f32x4){acc[4 * i], acc[4 * i + 1], acc[4 * i + 2], acc[4 * i + 3]};
            if ((tid & 3) == 0) nst[(size_t)it * 128 + dk] = ns;
        }
        __syncthreads();
    }
}

__device__ __forceinline__ void p3_scan(Frame& F) {
    const int tid = F.tid;
    float* Cl = WSP(float, WS_A); float* nst = WSP(float, MS_NST); const float* chs = WSP(float, MS_CHS);
    const int gt = F.vcu * (NWAVES * 64) + tid, NGT = F.G * NWAVES * 64;
    for (int idx = gt; idx < MH * 16384 + MH * 128; idx += NGT) {
        const bool isc = idx < MH * 16384; const int i2 = isc ? idx : idx - MH * 16384;
        const int h = isc ? (i2 >> 14) : (i2 >> 7), el = isc ? (i2 & 16383) : (i2 & 127);
        float* base = isc ? (Cl + ((size_t)(h * 128) << 14) + el) : (nst + (size_t)(h * 128) * 128 + el);
        const size_t stride = isc ? 16384 : 128; float a = 0.f;
        for (int c0 = 0; c0 < NCH; c0 += 16) { float v[16];
#pragma unroll
            for (int i = 0; i < 16; ++i) v[i] = base[(size_t)(c0 + i) * stride];
#pragma unroll
            for (int i = 0; i < 16; ++i) { a = chs[4 * 512 + h * 128 + c0 + i] * a + v[i]; v[i] = a; }
#pragma unroll
            for (int i = 0; i < 16; ++i) base[(size_t)(c0 + i) * stride] = v[i]; }
    }
}
typedef float f32x16 __attribute__((ext_vector_type(16)));
typedef short s16x4 __attribute__((ext_vector_type(4)));
typedef short v4i16_t __attribute__((ext_vector_type(4)));
typedef unsigned u32x4a __attribute__((ext_vector_type(4)));
__device__ __forceinline__ int crow(int r, int hi) { return (r & 3) + 8 * (r >> 2) + 4 * hi; }
__device__ __forceinline__ unsigned cvtpk(float lo, float hi) { unsigned r; asm("v_cvt_pk_bf16_f32 %0, %1, %2" : "=v"(r) : "v"(lo), "v"(hi)); return r; }
__device__ __forceinline__ s16x4 vtr(const LAS unsigned char* p) { return __builtin_bit_cast(s16x4, __builtin_amdgcn_ds_read_tr16_b64_v4i16((LAS v4i16_t*)p)); }
__device__ __forceinline__ float swapmax(float m) { auto rr = __builtin_amdgcn_permlane32_swap(__float_as_uint(m), __float_as_uint(m), false, false); return fmaxf(__uint_as_float(rr[0]), __uint_as_float(rr[1])); }
__device__ __forceinline__ float swapsum(float m) { auto rr = __builtin_amdgcn_permlane32_swap(__float_as_uint(m), __float_as_uint(m), false, false); return __uint_as_float(rr[0]) + __uint_as_float(rr[1]); }

__device__ __forceinline__ void attn_tile(const LAS unsigned char* Kl, const LAS unsigned char* Vl, const bf16x8 (&qr)[4], int nkb, bool diag, int qrel, float ch, int lane,
                                          f32x16& o0, f32x16& o1, float& mxo, float& lo_) {
    const int r32 = lane & 31, hi = lane >> 5;
    f32x16 p[8];
    const float base = ch * (float)(4 * hi - qrel);
    const LAS unsigned char* kb0 = Kl + hi * 4096 + r32 * 16;
#pragma unroll
    for (int kb = 0; kb < 8; ++kb) {
        if (kb < nkb) {
            f32x16 c;
#pragma unroll
            for (int r = 0; r < 16; ++r) c[r] = __builtin_fmaf(ch, (float)(32 * kb + (r & 3) + 8 * (r >> 2)), base);
#pragma unroll
            for (int d0 = 0; d0 < 4; ++d0) { const bf16x8 ka = *(const LAS bf16x8*)(kb0 + d0 * 8192 + kb * 512); c = __builtin_amdgcn_mfma_f32_32x32x16_bf16(ka, qr[d0], c, 0, 0, 0); }
            if (diag && kb == nkb - 1) {
#pragma unroll
                for (int r = 0; r < 16; ++r) if (32 * kb + crow(r, hi) > qrel) c[r] = -INFINITY;
            }
            p[kb] = c;
        }
    }
    float mx = -INFINITY;
#pragma unroll
    for (int kb = 0; kb < 8; ++kb) if (kb < nkb) {
#pragma unroll
        for (int r = 0; r < 16; ++r) mx = fmaxf(mx, p[kb][r]);
    }
    mx = swapmax(mx);
    float l = 0.f;
    u32x4a pw[8][2];
#pragma unroll
    for (int kb = 0; kb < 8; ++kb) {
        if (kb < nkb) {
            f32x16 e;
#pragma unroll
            for (int r = 0; r < 16; ++r) { e[r] = __builtin_amdgcn_exp2f(p[kb][r] - mx); l += e[r]; }
            pw[kb][0] = (u32x4a){cvtpk(e[0], e[1]), cvtpk(e[2], e[3]), cvtpk(e[4], e[5]), cvtpk(e[6], e[7])};
            pw[kb][1] = (u32x4a){cvtpk(e[8], e[9]), cvtpk(e[10], e[11]), cvtpk(e[12], e[13]), cvtpk(e[14], e[15])};
        } else { pw[kb][0] = (u32x4a){0u, 0u, 0u, 0u}; pw[kb][1] = (u32x4a){0u, 0u, 0u, 0u}; }
    }
    l = swapsum(l);
    f32x16 a0, a1;
#pragma unroll
    for (int r = 0; r < 16; ++r) { a0[r] = 0.f; a1[r] = 0.f; }
    const LAS unsigned char* vb = Vl + ((lane >> 4) & 1) * 32 + (lane & 3) * 8 + (4 * hi + ((lane & 15) >> 2)) * 64;
#pragma unroll
    for (int kb = 0; kb < 8; ++kb) {
        if ((kb & ~1) < nkb) {
#pragma unroll
            for (int k2 = 0; k2 < 2; ++k2) {
                const bf16x8 pa = __builtin_bit_cast(bf16x8, pw[kb][k2]);
                const LAS unsigned char* vp = vb + (kb * 2 + k2) * 1024;
                const s16x4 l0 = vtr(vp), h0 = vtr(vp + 512), l1 = vtr(vp + 16384), h1 = vtr(vp + 16384 + 512);
                const bf16x8 v0 = (bf16x8){l0[0], l0[1], l0[2], l0[3], h0[0], h0[1], h0[2], h0[3]};
                const bf16x8 v1 = (bf16x8){l1[0], l1[1], l1[2], l1[3], h1[0], h1[1], h1[2], h1[3]};
                a0 = __builtin_amdgcn_mfma_f32_32x32x16_bf16(pa, v0, a0, 0, 0, 0);
                a1 = __builtin_amdgcn_mfma_f32_32x32x16_bf16(pa, v1, a1, 0, 0, 0);
            }
        }
    }
    o0 = a0; o1 = a1; mxo = mx; lo_ = l;
}

__device__ __forceinline__ void load_kv_tile(const bf16* Kt, const bf16* Vt, int h, int j, LAS unsigned char* Kl, LAS unsigned char* Vl, int tid) {
    const GAS unsigned char* ks = (const GAS unsigned char*)Kt + (size_t)(h * 64 + j) * 32768; const GAS unsigned char* vs = (const GAS unsigned char*)Vt + (size_t)(h * 64 + j) * 32768;
#pragma unroll
    for (int i = 0; i < 4; ++i) { const unsigned off = (unsigned)(tid + 512 * i) * 16u; *(LAS v4u*)(Kl + off) = *(const GAS v4u*)(ks + off); *(LAS v4u*)(Vl + off) = *(const GAS v4u*)(vs + off); }
}
__device__ __forceinline__ int select_bit(unsigned long long m, int k) {
    int pos = 0; unsigned x = (unsigned)m; int c = __popc(x);
    if (k >= c) { k -= c; pos = 32; x = (unsigned)(m >> 32); }
    c = __popc(x & 0xffffu); if (k >= c) { k -= c; pos += 16; x >>= 16; }
    c = __popc(x & 0xffu); if (k >= c) { k -= c; pos += 8; x >>= 8; }
    c = __popc(x & 0xfu); if (k >= c) { k -= c; pos += 4; x >>= 4; }
    c = __popc(x & 0x3u); if (k >= c) { k -= c; pos += 2; x >>= 2; }
    c = (int)(x & 1u); if (k >= c) pos += 1;
    return pos;
}
__device__ __forceinline__ int block_incl_scan(int v, LAS int* scr, int tid, int lane, int wave) {
#pragma unroll
    for (int o = 1; o < 64; o <<= 1) { const int t = __shfl_up(v, o); if (lane >= o) v += t; }
    __syncthreads();
    if (lane == 63) scr[wave] = v;
    __syncthreads();
    int add = 0;
#pragma unroll
    for (int w = 0; w < 8; ++w) { const int t = scr[w]; if (w < wave) add += t; }
    return v + add;
}

__device__ __forceinline__ void p3_attn_selected(Frame& F) {
    const int tid = F.tid, lane = F.lane, wave = F.wave, r32 = lane & 31, hi = lane >> 5;
    const bf16* Qa = WSP(bf16, WS_B); const bf16* Kt = Qa + (size_t)M * 512; const bf16* Vt = Kt + (size_t)M * 512;
    const unsigned* sel = WSP(unsigned, MS_SEL); const unsigned long long* mask3 = WSP(unsigned long long, MS_MASK); const unsigned* tot = (const unsigned*)(F.ctl + CW_TOT);
    bf16* Op = (bf16*)F.out; float* Lp = (float*)((unsigned char*)F.out + 48 * MiB);
    LAS unsigned char* Kl = F.lds + RING_OFF; LAS unsigned char* Vl = F.lds + RING_OFF + 32768;
    LAS int* pre = (LAS int*)(F.lds + RING_OFF + 65536); LAS int* gpx = pre + 520; LAS unsigned long long* lmask = (LAS unsigned long long*)(gpx + 264);
    LAS int* rowq = (LAS int*)(lmask + 256); LAS int* rowslot = rowq + 256; LAS int* scr = rowslot + 256; LAS float* wsf = (LAS float*)(scr + 16) + wave * 64;
    { const int n = (int)tot[tid]; const int rounds = (n + 255) >> 8; const int inc = block_incl_scan(rounds, scr, tid, lane, wave); pre[tid + 1] = inc; if (tid == 0) pre[0] = 0; }
    __syncthreads();
    const int TOTAL = pre[512];
    const int s_lo = (int)(((long)TOTAL * F.vcu) / F.G), s_hi = (int)(((long)TOTAL * (F.vcu + 1)) / F.G);
    int cur_item = -1, n_item = 0;
    for (int sidx = s_lo; sidx < s_hi; ++sidx) {
        int a = 0, b = 512;
        while (b - a > 1) { const int mid = (a + b) >> 1; if (pre[mid] <= sidx) a = mid; else b = mid; }
        const int item = a, h = item >> 6, j = item & 63, r0 = (sidx - pre[item]) * 256;
        __syncthreads();
        if (item != cur_item) {
            cur_item = item; n_item = (int)tot[item];
            load_kv_tile(Kt, Vt, h, j, Kl, Vl, tid);
            int pc = 0;
            if (tid < 256) { unsigned long long mk = 0ull; if (tid >= 4 * (j + 1)) mk = mask3[((size_t)h * 256 + tid) * 64 + j]; lmask[tid] = mk; pc = __popcll(mk); }
            const int inc = block_incl_scan(pc, scr, tid, lane, wave);
            if (tid < 256) gpx[tid + 1] = inc; if (tid == 0) gpx[0] = 0;
        }
        __syncthreads();
        if (tid < 256) { const int row = r0 + tid; int q = -1, slot = 0;
            if (row < n_item) { int a2 = 0, b2 = 256; while (b2 - a2 > 1) { const int mid = (a2 + b2) >> 1; if (gpx[mid] <= row) a2 = mid; else b2 = mid; }
                const int pos = select_bit(lmask[a2], row - gpx[a2]); q = a2 * 64 + pos;
                const unsigned sl = sel[(size_t)h * M + q]; slot = ((int)(sl & 0xffu) == j) ? 0 : (((int)((sl >> 8) & 0xffu) == j) ? 1 : 2); }
            rowq[tid] = q; rowslot[tid] = slot; }
        __syncthreads();
        const int q_first = rowq[wave * 32];
        if (q_first >= 0) {
            int q = rowq[wave * 32 + r32]; const bool valid = q >= 0; if (!valid) q = q_first;
            bf16x8 qr[4];
#pragma unroll
            for (int d0 = 0; d0 < 4; ++d0) qr[d0] = *(const GAS bf16x8*)(Qa + (size_t)q * 512 + h * 64 + d0 * 16 + hi * 8);
            const float ch = exp2f(-(float)(h + 1)) * LOG2E;
            f32x16 o0, o1; float mx, l;
            attn_tile(Kl, Vl, qr, 8, false, q - j * 256, ch, lane, o0, o1, mx, l);
            if (hi == 0) { wsf[r32] = 1.0f / l; if (valid) Lp[((size_t)q * 8 + h) * 3 + rowslot[wave * 32 + r32]] = mx + __log2f(l); }
            asm volatile("s_waitcnt lgkmcnt(0)" ::: "memory");
#pragma unroll
            for (int r = 0; r < 16; ++r) { const int rr = crow(r, hi); const int qq = rowq[wave * 32 + rr];
                if (qq >= 0) { const float rl = wsf[rr]; bf16* dst = Op + (((size_t)qq * 8 + h) * 3 + rowslot[wave * 32 + rr]) * 64 + r32;
                    dst[0] = (bf16)f2bf(o0[r] * rl); dst[32] = (bf16)f2bf(o1[r] * rl); } }
        }
    }
    __syncthreads();
}

__device__ __forceinline__ void p4_attn_own(Frame& F) {
    const int tid = F.tid, lane = F.lane, wave = F.wave, r32 = lane & 31, hi = lane >> 5;
    bf16* Qa = WSP(bf16, WS_B); const bf16* Kt = Qa + (size_t)M * 512; const bf16* Vt = Kt + (size_t)M * 512;
    const bf16* Op = (const bf16*)F.out; const float* Lp = (const float*)((const unsigned char*)F.out + 48 * MiB);
    LAS float* tab = (LAS float*)(F.lds + RING_OFF + 131072) + wave * 128;
    for (int pr = F.vcu; pr < 256; pr += F.G) {
        const int b = pr & 63;
        __syncthreads();
        load_kv_tile(Kt, Vt, pr >> 6, b, F.lds + RING_OFF, F.lds + RING_OFF + 32768, tid);
        load_kv_tile(Kt, Vt, 4 + (pr >> 6), b, F.lds + RING_OFF + 65536, F.lds + RING_OFF + 98304, tid);
        __syncthreads();
#pragma unroll 1
        for (int half = 0; half < 2; ++half) {
            const int h = half * 4 + (pr >> 6), qt = half ? 7 - wave : wave;
            const LAS unsigned char* Kl = F.lds + RING_OFF + half * 65536; const LAS unsigned char* Vl = Kl + 32768;
            const int q = b * 256 + qt * 32 + r32;
            bf16x8 qr[4];
#pragma unroll
            for (int d0 = 0; d0 < 4; ++d0) qr[d0] = *(const GAS bf16x8*)(Qa + (size_t)q * 512 + h * 64 + d0 * 16 + hi * 8);
            const float ch = exp2f(-(float)(h + 1)) * LOG2E;
            f32x16 o0, o1; float mx, l;
            attn_tile(Kl, Vl, qr, qt + 1, true, qt * 32 + r32, ch, lane, o0, o1, mx, l);
            const int n = b < 3 ? b : 3;
            if (hi == 0) { const float lse = mx + __log2f(l); float ls[3]; float big = lse;
#pragma unroll
                for (int s = 0; s < 3; ++s) { ls[s] = (s < n) ? Lp[((size_t)q * 8 + h) * 3 + s] : -INFINITY; big = fmaxf(big, ls[s]); }
                const float wo = __builtin_amdgcn_exp2f(lse - big); float w[3]; float den = wo;
#pragma unroll
                for (int s = 0; s < 3; ++s) { w[s] = __builtin_amdgcn_exp2f(ls[s] - big); den += w[s]; }
                const float rd = 1.0f / den; tab[r32] = wo * rd / l; tab[32 + r32] = w[0] * rd; tab[64 + r32] = w[1] * rd; tab[96 + r32] = w[2] * rd; }
            asm volatile("s_waitcnt lgkmcnt(0)" ::: "memory");
#pragma unroll
            for (int r = 0; r < 16; ++r) { const int rr = crow(r, hi); const int qq = b * 256 + qt * 32 + rr;
                float y0 = o0[r] * tab[rr], y1 = o1[r] * tab[rr];
                const bf16* src = Op + ((size_t)qq * 8 + h) * 3 * 64 + r32;
#pragma unroll
                for (int s = 0; s < 3; ++s) if (s < n) { const float w = tab[32 + 32 * s + rr]; y0 += w * bf2f(src[s * 64]); y1 += w * bf2f(src[s * 64 + 32]); }
                bf16* dst = Qa + (size_t)qq * 512 + h * 64 + r32; dst[0] = (bf16)f2bf(y0); dst[32] = (bf16)f2bf(y1); }
            asm volatile("s_waitcnt lgkmcnt(0)" ::: "memory");
        }
    }
    __syncthreads();
}

__device__ __forceinline__ void p4_mlstm_out(Frame& F) {
    const int tid = F.tid;
    const bf16* qm = WSP(bf16, WS_C); const bf16* km = qm + (size_t)M * 512; const bf16* vm = WSP(bf16, WS_C) + (size_t)2 * M * 512; bf16* om = WSP(bf16, WS_C) + (size_t)3 * M * 512;
    const float* logi = WSP(float, MS_LOGI); const float* bcum = WSP(float, MS_BCUM); const float* chs = WSP(float, MS_CHS);
    const float* Cst = WSP(float, WS_A); const float* nst = WSP(float, MS_NST);
    bf16* ym = om;
    LAS bf16* Q = (LAS bf16*)(F.lds + RING_OFF); LAS bf16* K = (LAS bf16*)(F.lds + RING_OFF + 32768); LAS bf16* V = (LAS bf16*)(F.lds + RING_OFF + 65536); LAS bf16* SC = (LAS bf16*)(F.lds + RING_OFF + 98304); LAS bf16* Cb = K;
    LAS float* sh = (LAS float*)(F.lds + RING_OFF + 131072);
    for (int it = F.vcu; it < MH * NCH; it += F.G) { const int h = it >> 7, c = it & 127, t0 = c * CL;
        __syncthreads();
#pragma unroll
        for (int i = 0; i < 4; ++i) { const int idx = tid + 512 * i, r = idx >> 4, ci = idx & 15; const size_t go = (size_t)(t0 + r) * 512 + h * 128 + ci * 8;
            float cq[8], ck[8]; conv8(qm, t0 + r, h * 128 + ci * 8, IN_CONV + h * 128 + ci * 8, 1.0f, cq); conv8(km, t0 + r, h * 128 + ci * 8, IN_CONV + 512 + h * 128 + ci * 8, 0.08838834764831845f, ck);
            *(LAS v4u*)(Q + r * 128 + ci * 8) = (v4u){pk2(cq[0], cq[1]), pk2(cq[2], cq[3]), pk2(cq[4], cq[5]), pk2(cq[6], cq[7])};
            *(LAS v4u*)(K + r * 128 + ci * 8) = (v4u){pk2(ck[0], ck[1]), pk2(ck[2], ck[3]), pk2(ck[4], ck[5]), pk2(ck[6], ck[7])};
            *(LAS v4u*)(V + r * 128 + ci * 8) = *(const GAS v4u*)(vm + go);
 }
        if (tid < 128) { const float bt = bcum[(size_t)h * M + t0 + tid]; sh[tid] = bt; sh[128 + tid] = logi[(size_t)(t0 + tid) * 4 + h] - bt; sh[256 + tid] = (c > 0) ? nst[(size_t)(it - 1) * 128 + tid] : 0.f; }
        __syncthreads();
        const float mprev = chs[2 * 512 + it];
        const int t = tid >> 2, part = tid & 3, s0 = part * 32;
        const float bt = sh[t];
        float lm = -INFINITY;
        for (int j = 0; j < 32; ++j) if (s0 + j <= t) lm = fmaxf(lm, sh[128 + s0 + j]);
        lm = fmaxf(lm, __shfl_xor(lm, 1)); lm = fmaxf(lm, __shfl_xor(lm, 2));
        const float inter = bt + mprev, mt = fmaxf(inter, bt + lm), winter = __expf(inter - mt);
        float rsum = 0.f;
        {
            unsigned qp[64];
#pragma unroll
            for (int i = 0; i < 16; ++i) { const v4u w = *(const LAS v4u*)(Q + t * 128 + 8 * i); qp[4 * i] = w.x; qp[4 * i + 1] = w.y; qp[4 * i + 2] = w.z; qp[4 * i + 3] = w.w; }
#pragma unroll 1
            for (int j = 0; j < 32; ++j) { float a = 0.f; const LAS bf16* kr = K + (s0 + j) * 128;
#pragma unroll
                for (int i = 0; i < 16; ++i) { const v4u w = *(const LAS v4u*)(kr + 8 * i);
                    a += (blo(qp[4 * i]) * blo(w.x) + bhi(qp[4 * i]) * bhi(w.x)) + (blo(qp[4 * i + 1]) * blo(w.y) + bhi(qp[4 * i + 1]) * bhi(w.y)) + (blo(qp[4 * i + 2]) * blo(w.z) + bhi(qp[4 * i + 2]) * bhi(w.z)) + (blo(qp[4 * i + 3]) * blo(w.w) + bhi(qp[4 * i + 3]) * bhi(w.w)); }
                const float w = (s0 + j <= t) ? __expf(bt + sh[128 + s0 + j] - mt) : 0.f; a *= w; rsum += a;
                SC[t * 128 + s0 + j] = (bf16)f2bf(a); }
        }
        rsum += __shfl_xor(rsum, 1); rsum += __shfl_xor(rsum, 2);
        __syncthreads();
#pragma unroll
        for (int i = 0; i < 4; ++i) { const int idx = tid + 512 * i, r = idx >> 4, ci = idx & 15;
            v4u o = (v4u){0u, 0u, 0u, 0u};
            if (c > 0) { const float* cp = Cst + ((size_t)(it - 1) * 128 + r) * 128 + ci * 8; const f32x4 a = *(const GAS f32x4*)cp, b = *(const GAS f32x4*)(cp + 4); o.x = pk2(a.x, a.y); o.y = pk2(a.z, a.w); o.z = pk2(b.x, b.y); o.w = pk2(b.z, b.w); }
            *(LAS v4u*)(Cb + r * 128 + ci * 8) = o; }
        __syncthreads();
        const int e0 = part * 32; float acc[32];
#pragma unroll
        for (int e = 0; e < 32; ++e) acc[e] = 0.f;
        float qn = 0.f;
        for (int d = 0; d < 128; ++d) { const float a = bf2f(Q[t * 128 + d]);
#pragma unroll
            for (int i = 0; i < 4; ++i) { const v4u w = *(const LAS v4u*)(Cb + d * 128 + e0 + 8 * i);
                acc[8 * i + 0] += a * blo(w.x); acc[8 * i + 1] += a * bhi(w.x); acc[8 * i + 2] += a * blo(w.y); acc[8 * i + 3] += a * bhi(w.y); acc[8 * i + 4] += a * blo(w.z); acc[8 * i + 5] += a * bhi(w.z); acc[8 * i + 6] += a * blo(w.w); acc[8 * i + 7] += a * bhi(w.w); } }
#pragma unroll
        for (int j = 0; j < 32; ++j) qn += bf2f(Q[t * 128 + s0 + j]) * sh[256 + s0 + j];
        qn += __shfl_xor(qn, 1); qn += __shfl_xor(qn, 2);
#pragma unroll
        for (int e = 0; e < 32; ++e) acc[e] *= winter;
        for (int s = 0; s < 128; ++s) { const float a = bf2f(SC[t * 128 + s]);
#pragma unroll
            for (int i = 0; i < 4; ++i) { const v4u w = *(const LAS v4u*)(V + s * 128 + e0 + 8 * i);
                acc[8 * i + 0] += a * blo(w.x); acc[8 * i + 1] += a * bhi(w.x); acc[8 * i + 2] += a * blo(w.y); acc[8 * i + 3] += a * bhi(w.y); acc[8 * i + 4] += a * blo(w.z); acc[8 * i + 5] += a * bhi(w.z); acc[8 * i + 6] += a * blo(w.w); acc[8 * i + 7] += a * bhi(w.w); } }
        const float den = winter * qn + rsum, dd = 1.0f / fmaxf(fabsf(den), __expf(-mt));
        const size_t go = (size_t)(t0 + t) * 512 + h * 128 + e0; float sm = 0.f;
#pragma unroll
        for (int i = 0; i < 4; ++i) { const v4u w = *(const GAS v4u*)(om + go + 8 * i);
            acc[8 * i + 0] *= dd * sigm(blo(w.x)); acc[8 * i + 1] *= dd * sigm(bhi(w.x)); acc[8 * i + 2] *= dd * sigm(blo(w.y)); acc[8 * i + 3] *= dd * sigm(bhi(w.y)); acc[8 * i + 4] *= dd * sigm(blo(w.z)); acc[8 * i + 5] *= dd * sigm(bhi(w.z)); acc[8 * i + 6] *= dd * sigm(blo(w.w)); acc[8 * i + 7] *= dd * sigm(bhi(w.w)); }
#pragma unroll
        for (int e = 0; e < 32; ++e) sm += acc[e];
        sm += __shfl_xor(sm, 1); sm += __shfl_xor(sm, 2);
        const float mu = sm * (1.0f / 128.0f); float vs = 0.f;
#pragma unroll
        for (int e = 0; e < 32; ++e) { acc[e] -= mu; vs += acc[e] * acc[e]; }
        vs += __shfl_xor(vs, 1); vs += __shfl_xor(vs, 2);
        const float rstd = 1.0f / sqrtf(vs * (1.0f / 128.0f) + EPS);
#pragma unroll
        for (int i = 0; i < 4; ++i) { const f32x4 g0 = *(const GAS f32x4*)(IN_MNG + h * 128 + e0 + 8 * i), g1 = *(const GAS f32x4*)(IN_MNG + h * 128 + e0 + 8 * i + 4); v4u o;
            o.x = pk2(acc[8 * i] * rstd * g0.x, acc[8 * i + 1] * rstd * g0.y); o.y = pk2(acc[8 * i + 2] * rstd * g0.z, acc[8 * i + 3] * rstd * g0.w);
            o.z = pk2(acc[8 * i + 4] * rstd * g1.x, acc[8 * i + 5] * rstd * g1.y); o.w = pk2(acc[8 * i + 6] * rstd * g1.z, acc[8 * i + 7] * rstd * g1.w);
            *(GAS v4u*)(ym + go + 8 * i) = o; }
    }
    __syncthreads();
}

__device__ __forceinline__ void p10_final_norm(Frame& F) {
    const int gw = F.vcu * NWAVES + F.wave, NGW = F.G * NWAVES, lane = F.lane;
    f32x4 gv[4];
#pragma unroll
    for (int j = 0; j < 4; ++j) gv[j] = ((const GAS f32x4*)IN_FING)[lane + 64 * j];
    for (int m = gw; m < M; m += NGW) {
        GAS f32x4* xr = (GAS f32x4*)(F.out + (size_t)m * D) + lane;
        f32x4 v[4]; float s = 0.f;
#pragma unroll
        for (int j = 0; j < 4; ++j) { v[j] = xr[64 * j]; s += (v[j].x * v[j].x + v[j].y * v[j].y) + (v[j].z * v[j].z + v[j].w * v[j].w); }
        const float rstd = 1.0f / sqrtf(wave_sum(s) * (1.f / D) + EPS);
#pragma unroll
        for (int j = 0; j < 4; ++j) xr[64 * j] = v[j] * rstd * gv[j];
    }
}

struct Args { const float* in[15]; float* out; unsigned char* ws; int ph_lo, ph_hi, li, pad; };
__global__ void __launch_bounds__(NWAVES * 64, 2) mk_fwd(Args args) {
    extern __shared__ __attribute__((aligned(16))) unsigned char lds[];
    Frame F;
    F.lds = (LAS unsigned char*)lds;
    F.MISC = (volatile LAS unsigned*)(F.lds + MISC_OFF);
    F.tid = threadIdx.x; F.lane = F.tid & 63; F.wave = __builtin_amdgcn_readfirstlane(F.tid >> 6);
    F.G = gridDim.x; { const int bx = blockIdx.x; F.vcu = (F.G % 8 == 0) ? (bx % 8) * (F.G / 8) + bx / 8 : bx; }
    F.ws = args.ws; F.ctl = (gu32*)(args.ws + WS_CTL); F.out = args.out;
    for (int u = F.tid; u < (LDS_BYTES - LDSCTL_OFF) / 4; u += NWAVES * 64) ((LAS unsigned*)(F.lds + LDSCTL_OFF))[u] = 0u;
    __syncthreads();
    if (F.tid < 15) ((LAS cfptr*)(F.lds + LDSCTL_OFF))[F.tid] = args.in[F.tid];
    __syncthreads();
#define REFRESH() do { int l_; asm volatile("v_mbcnt_lo_u32_b32 %0, -1, 0\n\tv_mbcnt_hi_u32_b32 %0, -1, %0" : "=v"(l_)); F.lane = l_; F.tid = F.wave * 64 + l_; } while (0)
    XcdBarrier bar; bar.bar = (unsigned*)(F.ctl + CW_BAR); bar.x = 0; bar.st = nullptr;
    if (N_LAUNCHES == 1) bar = xcd_barrier_post((unsigned*)(F.ctl + CW_BAR), F.MISC + 8, F.tid);
#define GRID_BAR() do { if (N_LAUNCHES == 1) { REFRESH(); xcd_barrier(bar, F.tid); } } while (0)
    const int lo = args.ph_lo, hi = args.ph_hi;
#define IN(k) (lo <= (k) && (k) < hi)
#define SEAM(k) do { if (IN(k) && IN((k) + 1)) GRID_BAR(); } while (0)
    bf16* segs = WSP(bf16, WS_B);
    static_assert(WS_C == WS_B + (size_t)3 * M * 512 * 2, "segments contiguous");
    bf16* ga = WSP(bf16, WS_D); bf16* gm = ga + (size_t)M * 1024;
    bf16* ya = WSP(bf16, WS_B); bf16* ym = WSP(bf16, WS_C) + (size_t)3 * M * 512;
    bf16* P1 = WSP(bf16, WS_C); bf16* merged = WSP(bf16, WS_A);
    bf16* x1b = WSP(bf16, WS_B + 16 * MiB); bf16* hid = WSP(bf16, WS_HID);

    if (IN(0)) { p0_prologue(F); } SEAM(0);
    REFRESH(); if (IN(1)) { gate_prep(F);
        pg8::Gemm g{WSP(bf16, WS_A), WSP(bf16, WS_WIN), M, NIN, D}; pg8::StaticOrder S; S.init(M, NIN, F.G, (int)blockIdx.x);
        pg8::EpiIn E{segs, ga, C2, M, (float*)(F.ctl + CW_KSUM)};
        pg8::gemm_phase<pg8::EpiIn, pg8::StaticOrder, PG8_ALIGN, PG8_SP2>(F.lds + RING_OFF, g, S, E, F.tid); } SEAM(1);
    REFRESH(); if (IN(2)) { p2_gate_cloc(F); } SEAM(2);
    REFRESH(); if (IN(3)) { p3_scan(F); REFRESH(); p3_attn_selected(F); } SEAM(3);
    REFRESH(); if (IN(4)) { p4_attn_own(F); REFRESH(); p4_mlstm_out(F); } SEAM(4);
    REFRESH(); if (IN(5)) { pg8::Gemm g{ya, WSP(bf16, WS_WA), M, D, AW}; pg8::StaticOrder S; S.init(M, D, F.G, (int)blockIdx.x);
        pg8::EpiGate<0> E{ga, nullptr, P1};
        pg8::gemm_phase<pg8::EpiGate<0>, pg8::StaticOrder, PG8_ALIGN, PG8_SP2>(F.lds + RING_OFF, g, S, E, F.tid); } SEAM(5);
    REFRESH(); if (IN(6)) { pg8::Gemm g{ym, WSP(bf16, WS_WM), M, D, MW}; pg8::StaticOrder S; S.init(M, D, F.G, (int)blockIdx.x);
        pg8::EpiGate<1> E{gm, P1, merged};
        pg8::gemm_phase<pg8::EpiGate<1>, pg8::StaticOrder, PG8_ALIGN, PG8_SP2>(F.lds + RING_OFF, g, S, E, F.tid); } SEAM(6);
    REFRESH(); if (IN(7)) { pg8::Gemm g{merged, WSP(bf16, WS_WO), M, D, D}; pg8::StaticOrder S; S.init(M, D, F.G, (int)blockIdx.x);
        pg8::EpiRes<true> E{IN_X, F.out, x1b, WSP(float, MS_SSQ1)};
        pg8::gemm_phase<pg8::EpiRes<true>, pg8::StaticOrder, PG8_ALIGN, PG8_SP2>(F.lds + RING_OFF, g, S, E, F.tid); } SEAM(7);
    REFRESH(); if (IN(8)) { pg8::Gemm g{x1b, WSP(bf16, WS_WGU), M, NIN, D}; pg8::StaticOrder S; S.init(M, NIN, F.G, (int)blockIdx.x);
        pg8::EpiSwiGLU E{WSP(float, MS_SSQ1), hid, FF, EPS};
        pg8::gemm_phase<pg8::EpiSwiGLU, pg8::StaticOrder, PG8_ALIGN, PG8_SP2>(F.lds + RING_OFF, g, S, E, F.tid); } SEAM(8);
    REFRESH(); if (IN(9)) { pg8::Gemm g{hid, WSP(bf16, WS_WD), M, D, FF}; pg8::StaticOrder S; S.init(M, D, F.G, (int)blockIdx.x);
        pg8::EpiRes<false> E{F.out, F.out, nullptr, WSP(float, MS_SSQ2)};
        pg8::gemm_phase<pg8::EpiRes<false>, pg8::StaticOrder, PG8_ALIGN, PG8_SP2>(F.lds + RING_OFF, g, S, E, F.tid); } SEAM(9);
    REFRESH(); if (IN(10)) { p10_final_norm(F); }
#undef IN
#undef SEAM
}

extern "C" void kernel_launch(void* const* d_in, const int* in_sizes, int n_in, void* d_out, int out_size, void* d_ws, size_t ws_size, hipStream_t stream) {
    static int grid = 0;
    if (grid == 0) {
        if (n_in != 15 || in_sizes[0] != M * D || out_size != M * D || ws_size < WS_END) { fprintf(stderr, "kernel_launch: unexpected shapes: n_in %d in0 %d out %d ws %zu\n", n_in, n_in > 0 ? in_sizes[0] : -1, out_size, ws_size); grid = -1; return; }
        int dev = 0, cus = 0, per_cu = 0;
        if (hipGetDevice(&dev) != hipSuccess || hipDeviceGetAttribute(&cus, hipDeviceAttributeMultiprocessorCount, dev) != hipSuccess) { grid = -1; return; }
        if (hipFuncSetAttribute((const void*)mk_fwd, hipFuncAttributeMaxDynamicSharedMemorySize, LDS_BYTES) != hipSuccess) { fprintf(stderr, "kernel_launch: hipFuncSetAttribute failed\n"); grid = -1; return; }
        if (hipOccupancyMaxActiveBlocksPerMultiprocessor(&per_cu, (const void*)mk_fwd, NWAVES * 64, LDS_BYTES) != hipSuccess || per_cu < 1) { fprintf(stderr, "kernel_launch: occupancy query says %d blocks per CU\n", per_cu); per_cu = 1; }
        (void)hipGetLastError();
        grid = cus;
    }
    if (grid < 0) return;
    if (hipMemsetAsync((char*)d_ws + WS_CTL, 0, CTL_ZERO_BYTES, stream) != hipSuccess) { fprintf(stderr, "kernel_launch: memset failed\n"); return; }
    Args a{};
    for (int i = 0; i < 15; ++i) a.in[i] = (const float*)d_in[i];
    a.out = (float*)d_out; a.ws = (unsigned char*)d_ws;
    for (int li = 0; li < N_LAUNCHES; ++li) {
        a.ph_lo = (N_LAUNCHES == 1) ? 0 : li; a.ph_hi = (N_LAUNCHES == 1) ? N_PHASES : li + 1; a.li = li;
        hipLaunchKernelGGL(mk_fwd, dim3(grid), dim3(NWAVES * 64), LDS_BYTES, stream, a);
        const hipError_t le = hipPeekAtLastError();
        if (le != hipSuccess) { fprintf(stderr, "kernel_launch: launch %d failed: %s\n", li, hipGetErrorName(le)); break; }
    }
}
```

```cpp
#include <hip/hip_runtime.h>
#include <cstdio>
#include <cstdint>
namespace pg8 {
#define PG8_LAS __attribute__((address_space(3)))
typedef unsigned short bf16_t;
typedef short bf16x8 __attribute__((ext_vector_type(8)));
typedef float f32x4 __attribute__((ext_vector_type(4)));
typedef unsigned u32x4 __attribute__((ext_vector_type(4)));
constexpr int BM = 256, BK = 64, HALF = 128, HTB = HALF * BK * 2  , STAGE_BYTES = 8 * HTB, NXCD = 8, WGM = 8;

__host__ __device__ __forceinline__ int lds_byte(int r, int c) { const int st = (r >> 4) * 2 + (c >> 5), rr = r & 15, cc = c & 31, ob = rr * 64 + cc * 2; return st * 1024 + (ob ^ (((ob >> 9) & 1) << 5)); }
__host__ __device__ __forceinline__ void stage_rc(int b, int& R, int& C) { const int st = b / 1024, sb = b % 1024, swz = sb ^ (((sb >> 9) & 1) << 5); R = (st >> 1) * 16 + swz / 64; C = (st & 1) * 32 + (swz % 64) / 2; }
__host__ __device__ __forceinline__ int perm32(int rho) { const int n = rho >> 4, i = rho & 15; return 8 * (i >> 2) + 4 * n + (i & 3); }

struct Unit { int pm, pn; };
struct Gemm { const bf16_t* A; const bf16_t* Bt; int M, N, K; };

struct StaticOrder {
    int nM, nN, nwg, G, c;
    __host__ __device__ void init(int M, int N, int G_, int c_) { nM = M / BM; nN = N / BM; nwg = nM * nN; G = G_; c = c_; }
    __host__ __device__ bool next(int i, Unit& u) const {
        const long L = (long)i * G + c; if (L >= nwg) return false;
        int wgid = (int)L; { const int q = nwg / NXCD, r = nwg % NXCD, xcd = wgid % NXCD, off = wgid / NXCD; wgid = (xcd < r ? xcd * (q + 1) : r * (q + 1) + (xcd - r) * q) + off; }
        const int nig = WGM * nN, gid = wgid / nig, fm = gid * WGM, gsz = (nM - fm) < WGM ? (nM - fm) : WGM;
        u.pm = fm + ((wgid % nig) % gsz); u.pn = (wgid % nig) / gsz; return true;
    }
    __device__ __forceinline__ void a_ready(const Unit&) const {}
    __device__ __forceinline__ void done(const Unit&) const {}
};

__device__ __forceinline__ unsigned cvt_pk_bf16(float lo, float hi) { unsigned r; asm volatile("v_cvt_pk_bf16_f32 %0, %1, %2" : "=v"(r) : "v"(lo), "v"(hi)); return r; }
typedef float f32x2 __attribute__((ext_vector_type(2)));
template <class Epi, class Sched, bool ALIGN_EPI = false, bool SP2 = false>
__device__ __forceinline__ void gemm_phase(PG8_LAS unsigned char* lds, const Gemm g, const Sched& S, const Epi& E, const int tid) {
    const int wid = __builtin_amdgcn_readfirstlane(tid >> 6), lane = tid & 63, wr = wid >> 2, wc = wid & 3, fr = lane & 15, fq = lane >> 4;
    const int K = g.K, nt = K / BK;
    unsigned voffA[2], voffB[2];
#pragma unroll
    for (int i = 0; i < 2; ++i) { int R, C; stage_rc(tid * 16 + i * 8192, R, C); const int Rb = Epi::PERM ? ((R & ~31) + perm32(R & 31)) : R;
        voffA[i] = (unsigned)(R * K + C) * 2u; voffB[i] = (unsigned)(Rb * K + C) * 2u; }
    const size_t kstep = (size_t)(BK * 2);
    const size_t hstep = (size_t)HALF * K * 2;
    const size_t tstep = 2 * hstep;
    const unsigned ldsw = (unsigned)wid * 1024u;
    const int aoff = lds_byte(wr * 64 + fr, fq * 8), boff = lds_byte(wc * 32 + fr, fq * 8);
#define PG8_SA(b, h) (((b) * 2 + (h)) * HTB)
#define PG8_SB(b, h) ((4 + (b) * 2 + (h)) * HTB)
#define PG8_STAGE(bufoff, gbase, voff) do { _Pragma("unroll") for (int _i = 0; _i < 2; ++_i) \
        __builtin_amdgcn_global_load_lds((const unsigned*)((const char*)(gbase) + (voff)[_i]), (PG8_LAS unsigned*)(lds + (bufoff) + ldsw + _i * 8192), 16, 0, 0); } while (0)
#define PG8_LDA(dst, b, h) do { _Pragma("unroll") for (int m = 0; m < 4; ++m) _Pragma("unroll") for (int k = 0; k < 2; ++k) dst[m][k] = *(const PG8_LAS bf16x8*)(lds + PG8_SA(b, h) + aoff + m * 2048 + k * 1024); } while (0)
#define PG8_LDB(dst, b, h) do { _Pragma("unroll") for (int n = 0; n < 2; ++n) _Pragma("unroll") for (int k = 0; k < 2; ++k) dst[n][k] = *(const PG8_LAS bf16x8*)(lds + PG8_SB(b, h) + boff + n * 2048 + k * 1024); } while (0)
#define PG8_MMA(ai, bj, At, Bt) do { __builtin_amdgcn_s_setprio(1); _Pragma("unroll") for (int m = 0; m < 4; ++m) _Pragma("unroll") for (int n = 0; n < 2; ++n) _Pragma("unroll") for (int k = 0; k < 2; ++k) \
        acc[ai][bj][m][n] = __builtin_amdgcn_mfma_f32_16x16x32_bf16(Bt[n][k], At[m][k], acc[ai][bj][m][n], 0, 0, 0); __builtin_amdgcn_s_setprio(0); } while (0)
#define PG8_WAIT_V(n) asm volatile("s_waitcnt vmcnt(" #n ")" ::: "memory")
#define PG8_WAIT_L(n) asm volatile("s_waitcnt lgkmcnt(" #n ")" ::: "memory")
#define PG8_BAR __builtin_amdgcn_s_barrier()
#define PG8_SCHED __builtin_amdgcn_sched_barrier(0)
    Unit cur, nxt; int ui = 0;
    if (!S.next(0, cur)) return;
    f32x4 acc[2][2][4][2];
#pragma unroll
    for (int a = 0; a < 2; ++a)
#pragma unroll
        for (int b = 0; b < 2; ++b)
#pragma unroll
            for (int m = 0; m < 4; ++m)
#pragma unroll
                for (int n = 0; n < 2; ++n) acc[a][b][m][n] = (f32x4){0.f, 0.f, 0.f, 0.f};
    bf16x8 At[4][2], B0[2][2], B1[2][2];
    const char* cA = (const char*)g.A + (size_t)cur.pm * tstep; const char* cB = (const char*)g.Bt + (size_t)cur.pn * tstep;
    S.a_ready(cur);
    if constexpr (SP2) {
        PG8_STAGE(PG8_SB(0, 0), cB, voffB); PG8_STAGE(PG8_SB(0, 1), cB + hstep, voffB); PG8_STAGE(PG8_SA(0, 0), cA, voffA); PG8_STAGE(PG8_SA(0, 1), cA + hstep, voffA);
        if (wr == 1) PG8_BAR;
        PG8_WAIT_V(2); PG8_BAR;
        PG8_STAGE(PG8_SB(1, 0), cB + kstep, voffB); PG8_STAGE(PG8_SA(1, 0), cA + kstep, voffA); PG8_STAGE(PG8_SB(1, 1), cB + hstep + kstep, voffB);
        PG8_WAIT_V(6); PG8_BAR;
    } else {
        PG8_STAGE(PG8_SB(0, 0), cB, voffB); PG8_STAGE(PG8_SA(0, 0), cA, voffA); PG8_STAGE(PG8_SB(0, 1), cB + hstep, voffB); PG8_STAGE(PG8_SA(0, 1), cA + hstep, voffA);
        if (wr == 1) PG8_BAR;
        PG8_WAIT_V(4); PG8_BAR;
        PG8_STAGE(PG8_SB(1, 0), cB + kstep, voffB); PG8_STAGE(PG8_SA(1, 0), cA + kstep, voffA); PG8_STAGE(PG8_SB(1, 1), cB + hstep + kstep, voffB);
        PG8_WAIT_V(6); PG8_BAR;
    }
    for (;;) {
        const bool has_next = S.next(ui + 1, nxt);
        const char* nA = has_next ? (const char*)g.A + (size_t)nxt.pm * tstep : cA; const char* nB = has_next ? (const char*)g.Bt + (size_t)nxt.pn * tstep : cB;
        for (int t = 0; t < nt; t += 2) {
            const bool last = (t == nt - 2);
            const char* a1 = cA + (size_t)(t + 1) * kstep;
            const char* a2 = last ? nA : cA + (size_t)(t + 2) * kstep; const char* b2 = last ? nB : cB + (size_t)(t + 2) * kstep;
            const char* a3 = a2 + kstep; const char* b3 = b2 + kstep;
            if (last && has_next) S.a_ready(nxt);
            if constexpr (SP2) {
            PG8_LDB(B0, 0, 0); PG8_LDB(B1, 0, 1); PG8_SCHED; PG8_LDA(At, 0, 0); PG8_STAGE(PG8_SA(1, 1), a1 + hstep, voffA);
            PG8_WAIT_V(8); PG8_WAIT_L(0); PG8_BAR; PG8_MMA(0, 0, At, B0); PG8_MMA(0, 1, At, B1); PG8_BAR; PG8_SCHED;
            PG8_LDA(At, 0, 1); PG8_STAGE(PG8_SB(0, 0), b2, voffB); PG8_STAGE(PG8_SB(0, 1), b2 + hstep, voffB); PG8_STAGE(PG8_SA(0, 0), a2, voffA);
            PG8_WAIT_V(8); PG8_WAIT_L(0); PG8_BAR; PG8_MMA(1, 0, At, B0); PG8_MMA(1, 1, At, B1); PG8_BAR; PG8_SCHED;
            PG8_LDB(B0, 1, 0); PG8_LDB(B1, 1, 1); PG8_SCHED; PG8_LDA(At, 1, 0); PG8_STAGE(PG8_SA(0, 1), a2 + hstep, voffA);
            PG8_WAIT_V(8); PG8_WAIT_L(0); PG8_BAR; PG8_MMA(0, 0, At, B0); PG8_MMA(0, 1, At, B1); PG8_BAR; PG8_SCHED;
            PG8_LDA(At, 1, 1); PG8_STAGE(PG8_SB(1, 0), b3, voffB); PG8_STAGE(PG8_SB(1, 1), b3 + hstep, voffB); PG8_STAGE(PG8_SA(1, 0), a3, voffA);
            PG8_WAIT_V(8); PG8_WAIT_L(0); PG8_BAR; PG8_MMA(1, 0, At, B0); PG8_MMA(1, 1, At, B1); PG8_BAR; PG8_SCHED;
            } else {
            PG8_LDB(B0, 0, 0); PG8_SCHED; PG8_LDA(At, 0, 0); PG8_STAGE(PG8_SA(1, 1), a1 + hstep, voffA);
            PG8_WAIT_L(8); PG8_BAR; PG8_WAIT_L(0); PG8_MMA(0, 0, At, B0); PG8_BAR; PG8_SCHED;
            PG8_LDB(B1, 0, 1); PG8_STAGE(PG8_SB(0, 0), b2, voffB);
            PG8_BAR; PG8_WAIT_L(0); PG8_MMA(0, 1, At, B1); PG8_BAR;
            PG8_LDA(At, 0, 1); PG8_STAGE(PG8_SA(0, 0), a2, voffA);
            PG8_BAR; PG8_WAIT_L(0); PG8_MMA(1, 0, At, B0); PG8_BAR; PG8_SCHED;
            PG8_STAGE(PG8_SB(0, 1), b2 + hstep, voffB);
            PG8_WAIT_V(6); PG8_BAR; PG8_MMA(1, 1, At, B1); PG8_BAR;
            PG8_LDB(B0, 1, 0); PG8_SCHED; PG8_LDA(At, 1, 0); PG8_STAGE(PG8_SA(0, 1), a2 + hstep, voffA);
            PG8_WAIT_L(8); PG8_BAR; PG8_WAIT_L(0); PG8_MMA(0, 0, At, B0); PG8_BAR; PG8_SCHED;
            PG8_LDB(B1, 1, 1); PG8_STAGE(PG8_SB(1, 0), b3, voffB);
            PG8_BAR; PG8_WAIT_L(0); PG8_MMA(0, 1, At, B1); PG8_BAR;
            PG8_LDA(At, 1, 1); PG8_STAGE(PG8_SA(1, 0), a3, voffA);
            PG8_BAR; PG8_WAIT_L(0); PG8_MMA(1, 0, At, B0); PG8_BAR; PG8_SCHED;
            PG8_STAGE(PG8_SB(1, 1), b3 + hstep, voffB);
            PG8_WAIT_V(6); PG8_BAR; PG8_MMA(1, 1, At, B1); PG8_BAR;
            }
        }
        if constexpr (ALIGN_EPI) { if (wr == 0) PG8_BAR; }
        if constexpr (!Epi::AFTER_DRAIN) { E(acc, cur, wr, wc, fr, fq); S.done(cur); }
        if (!has_next) break;
#pragma unroll
        for (int a = 0; a < 2; ++a)
#pragma unroll
            for (int b = 0; b < 2; ++b)
#pragma unroll
                for (int m = 0; m < 4; ++m)
#pragma unroll
                    for (int n = 0; n < 2; ++n) acc[a][b][m][n] = (f32x4){0.f, 0.f, 0.f, 0.f};
        cur = nxt; cA = nA; cB = nB; ++ui;
        if constexpr (ALIGN_EPI) { if (wr == 1) PG8_BAR; }
    }
    PG8_WAIT_V(0);
    if constexpr (!ALIGN_EPI) { if (wr == 0) PG8_BAR; }
    PG8_BAR;
    if constexpr (Epi::AFTER_DRAIN) { E.fused(acc, cur, wr, wc, fr, fq, lds, wid, lane); S.done(cur); }
#undef PG8_SA
#undef PG8_SB
#undef PG8_STAGE
#undef PG8_LDA
#undef PG8_LDB
#undef PG8_MMA
#undef PG8_WAIT_V
#undef PG8_WAIT_L
#undef PG8_BAR
#undef PG8_SCHED
}
}

#ifndef PG8_SP2
#define PG8_SP2 true
#endif
#ifndef PG8_ALIGN
#define PG8_ALIGN true
#endif
namespace pg8 {
__device__ __forceinline__ float sigmoidf_fast(float x) { return __builtin_amdgcn_rcpf(1.0f + __builtin_amdgcn_exp2f(-1.4426950408889634f * x)); }
__device__ __forceinline__ float bflo(unsigned w) { return __uint_as_float(w << 16); }
__device__ __forceinline__ float bfhi(unsigned w) { return __uint_as_float(w & 0xffff0000u); }

struct EpiIn {
    static constexpr bool PERM = true, AFTER_DRAIN = false;
    bf16_t* seg; bf16_t* gates; float qscale; int Mrows; float* ksum;
    __device__ __forceinline__ void operator()(const f32x4 (&acc)[2][2][4][2], const Unit& u, int wr, int wc, int fr, int fq) const {
        const int pn = u.pn;
        if (pn >= 2 && pn < 6) {
            const bool isk = pn < 4; bf16_t* base = seg + (size_t)(isk ? 1 : 2) * Mrows * 512; const int j = u.pm;
            float cs[2][8];
#pragma unroll
            for (int bj = 0; bj < 2; ++bj)
#pragma unroll
                for (int e = 0; e < 8; ++e) cs[bj][e] = 0.f;
#pragma unroll
            for (int bj = 0; bj < 2; ++bj) { const int cc = (pn & 1) * 256 + bj * HALF + wc * 32, h = cc >> 6;
                bf16_t* tb = base + (size_t)(h * 64 + j) * 16384 + (isk ? (4 * (wc & 1) + fq) * 2048 : (wc & 1) * 8192 + 8 * fq);
#pragma unroll
                for (int ai = 0; ai < 2; ++ai)
#pragma unroll
                    for (int m = 0; m < 4; ++m) { const int key = ai * HALF + wr * 64 + m * 16 + fr; const f32x4 v0 = acc[ai][bj][m][0], v1 = acc[ai][bj][m][1];
                        u32x4 w; w.x = cvt_pk_bf16(v0[0], v0[1]); w.y = cvt_pk_bf16(v0[2], v0[3]); w.z = cvt_pk_bf16(v1[0], v1[1]); w.w = cvt_pk_bf16(v1[2], v1[3]);
                        *(u32x4*)(tb + (size_t)key * (isk ? 8 : 32)) = w;
                        if (isk) {
#pragma unroll
                            for (int e = 0; e < 4; ++e) { cs[bj][e] += v0[e]; cs[bj][4 + e] += v1[e]; } } } }
            if (isk) {
#pragma unroll
                for (int bj = 0; bj < 2; ++bj)
#pragma unroll
                    for (int e = 0; e < 8; ++e) { float v = cs[bj][e]; v += __shfl_xor(v, 1); v += __shfl_xor(v, 2); v += __shfl_xor(v, 4); v += __shfl_xor(v, 8); cs[bj][e] = v; }
                if (fr == 0) {
#pragma unroll
                    for (int bj = 0; bj < 2; ++bj) { const int cc = (pn & 1) * 256 + bj * HALF + wc * 32 + 8 * fq;
#pragma unroll
                        for (int e = 0; e < 8; ++e) atomicAdd(ksum + ((size_t)((cc >> 6) * 64 + j)) * 64 + (cc & 63) + e, cs[bj][e]); } }
            }
            return;
        }
        bf16_t* base; int ldc, colt, mode;
        if (pn < 14) { const int s = pn >> 1; base = seg + (size_t)s * Mrows * 512; ldc = 512; colt = (pn & 1) * 256; mode = (s == 0) ? 1 : 0; }
        else { const int g = (pn - 14) >> 2; base = gates + (size_t)g * Mrows * 1024; ldc = 1024; colt = ((pn - 14) & 3) * 256; mode = 2; }
        const int row0 = u.pm * BM + wr * 64 + fr, col0 = colt + wc * 32 + 8 * fq;
#pragma unroll
        for (int ai = 0; ai < 2; ++ai)
#pragma unroll
            for (int m = 0; m < 4; ++m) { bf16_t* rowp = base + (size_t)(row0 + ai * HALF + m * 16) * ldc + col0;
#pragma unroll
                for (int bj = 0; bj < 2; ++bj) { f32x4 v0 = acc[ai][bj][m][0], v1 = acc[ai][bj][m][1];
                    if (mode == 1) { v0 = v0 * qscale; v1 = v1 * qscale; }
                    else if (mode == 2) {
#pragma unroll
                        for (int e = 0; e < 4; ++e) { v0[e] = sigmoidf_fast(v0[e]); v1[e] = sigmoidf_fast(v1[e]); } }
                    u32x4 w; w.x = cvt_pk_bf16(v0[0], v0[1]); w.y = cvt_pk_bf16(v0[2], v0[3]); w.z = cvt_pk_bf16(v1[0], v1[1]); w.w = cvt_pk_bf16(v1[2], v1[3]);
                    *(u32x4*)(rowp + bj * HALF) = w; } }
    }
};
template <int MODE> struct EpiGate {
    static constexpr bool PERM = true, AFTER_DRAIN = false;
    const bf16_t* G; const bf16_t* P; bf16_t* O;
    __device__ __forceinline__ void operator()(const f32x4 (&acc)[2][2][4][2], const Unit& u, int wr, int wc, int fr, int fq) const {
        const int row0 = u.pm * BM + wr * 64 + fr, col0 = u.pn * BM + wc * 32 + 8 * fq;
#pragma unroll
        for (int ai = 0; ai < 2; ++ai)
#pragma unroll
            for (int m = 0; m < 4; ++m) { const size_t off = (size_t)(row0 + ai * HALF + m * 16) * 1024 + col0;
#pragma unroll
                for (int bj = 0; bj < 2; ++bj) { const f32x4 v0 = acc[ai][bj][m][0], v1 = acc[ai][bj][m][1];
                    const u32x4 g = *(const u32x4*)(G + off + bj * HALF);
                    float r[8] = { bflo(g.x) * v0[0], bfhi(g.x) * v0[1], bflo(g.y) * v0[2], bfhi(g.y) * v0[3], bflo(g.z) * v1[0], bfhi(g.z) * v1[1], bflo(g.w) * v1[2], bfhi(g.w) * v1[3] };
                    if (MODE == 1) { const u32x4 p = *(const u32x4*)(P + off + bj * HALF);
                        r[0] += bflo(p.x); r[1] += bfhi(p.x); r[2] += bflo(p.y); r[3] += bfhi(p.y); r[4] += bflo(p.z); r[5] += bfhi(p.z); r[6] += bflo(p.w); r[7] += bfhi(p.w); }
                    u32x4 w; w.x = cvt_pk_bf16(r[0], r[1]); w.y = cvt_pk_bf16(r[2], r[3]); w.z = cvt_pk_bf16(r[4], r[5]); w.w = cvt_pk_bf16(r[6], r[7]);
                    *(u32x4*)(O + off + bj * HALF) = w; } }
    }
};
template <bool WITH_BF> struct EpiRes {
    static constexpr bool PERM = false, AFTER_DRAIN = false;
    const float* base; float* out; bf16_t* xb; float* ssq;
    __device__ __forceinline__ void operator()(const f32x4 (&acc)[2][2][4][2], const Unit& u, int wr, int wc, int fr, int fq) const {
        typedef unsigned u32x2v __attribute__((ext_vector_type(2)));
        const int row0 = u.pm * BM + wr * 64 + fr, col0 = u.pn * BM + wc * 32 + 4 * fq;
#pragma unroll
        for (int ai = 0; ai < 2; ++ai)
#pragma unroll
            for (int m = 0; m < 4; ++m) { const int row = row0 + ai * HALF + m * 16; const size_t off = (size_t)row * 1024 + col0; float ss = 0.f;
#pragma unroll
                for (int bj = 0; bj < 2; ++bj)
#pragma unroll
                    for (int n = 0; n < 2; ++n) { const size_t o2 = off + bj * HALF + n * 16; const f32x4 o = *(const f32x4*)(base + o2) + acc[ai][bj][m][n];
                        *(f32x4*)(out + o2) = o; ss += (o[0] * o[0] + o[1] * o[1]) + (o[2] * o[2] + o[3] * o[3]);
                        if (WITH_BF) { u32x2v w; w.x = cvt_pk_bf16(o[0], o[1]); w.y = cvt_pk_bf16(o[2], o[3]); *(u32x2v*)(xb + o2) = w; } }
                ss += __shfl_xor(ss, 16); ss += __shfl_xor(ss, 32);
                if (fq == 0) ssq[(size_t)row * 16 + u.pn * 4 + wc] = ss; }
    }
};
struct EpiSwiGLU {
    static constexpr bool PERM = true, AFTER_DRAIN = false;
    const float* ssq; bf16_t* Hd; int ldh; float eps;
    __device__ __forceinline__ void operator()(const f32x4 (&acc)[2][2][4][2], const Unit& u, int wr, int wc, int fr, int fq) const {
        const int row0 = u.pm * BM + wr * 64 + fr, col0 = u.pn * HALF + wc * 32 + 8 * fq;
#pragma unroll
        for (int ai = 0; ai < 2; ++ai)
#pragma unroll
            for (int m = 0; m < 4; ++m) { const int row = row0 + ai * HALF + m * 16; const f32x4* sp = (const f32x4*)(ssq + (size_t)row * 16);
                const f32x4 s0 = sp[0], s1 = sp[1], s2 = sp[2], s3 = sp[3];
                const float tot = ((s0[0] + s0[1]) + (s0[2] + s0[3])) + ((s1[0] + s1[1]) + (s1[2] + s1[3])) + ((s2[0] + s2[1]) + (s2[2] + s2[3])) + ((s3[0] + s3[1]) + (s3[2] + s3[3]));
                const float rs = 1.0f / sqrtf(tot * (1.0f / 1024.0f) + eps);
                float r[8];
#pragma unroll
                for (int n = 0; n < 2; ++n)
#pragma unroll
                    for (int e = 0; e < 4; ++e) { const float g = acc[ai][0][m][n][e] * rs, up = acc[ai][1][m][n][e] * rs; r[n * 4 + e] = g * sigmoidf_fast(g) * up; }
                u32x4 w; w.x = cvt_pk_bf16(r[0], r[1]); w.y = cvt_pk_bf16(r[2], r[3]); w.z = cvt_pk_bf16(r[4], r[5]); w.w = cvt_pk_bf16(r[6], r[7]);
                *(u32x4*)(Hd + (size_t)row * ldh + col0) = w; }
    }
};
}
#define GAS __attribute__((address_space(1)))
#define LAS __attribute__((address_space(3)))
typedef unsigned short bf16;
typedef unsigned v4u __attribute__((ext_vector_type(4)));
typedef float f32x4 __attribute__((ext_vector_type(4)));
typedef short bf16x8 __attribute__((ext_vector_type(8)));
typedef GAS unsigned gu32;
typedef GAS unsigned long long gu64;
#define RLX_AGENT __ATOMIC_RELAXED, __HIP_MEMORY_SCOPE_AGENT
#define LDS_WAIT() asm volatile("s_waitcnt lgkmcnt(0)" ::: "memory")
#define VM_WAIT() asm volatile("s_waitcnt vmcnt(0)" ::: "memory")
__device__ __forceinline__ unsigned long long rt() { return __builtin_amdgcn_s_memrealtime(); }
__device__ __forceinline__ unsigned f2bf(float f) { unsigned u = __builtin_bit_cast(unsigned, f); return (u + 0x7fffu + ((u >> 16) & 1u)) >> 16; }
__device__ __forceinline__ unsigned pk2(float lo, float hi) { return f2bf(lo) | (f2bf(hi) << 16); }

#define XB_TMO      128
#define XB_XCNT(j)  (256  + 64 * (j))
#define XB_XSUB(j)  (1280 + 64 * (j))
#define XB_XGEN(j)  (2304 + 64 * (j))
#define XB_TOP      3328
#define XB_TOPGEN   3392
#define XCD_BAR_WORDS 3456
#define XB_SPIN_CAP (1u << 18)

__device__ __forceinline__ unsigned xb_ld(unsigned* p)              { return __hip_atomic_load(p, __ATOMIC_RELAXED, __HIP_MEMORY_SCOPE_AGENT); }
__device__ __forceinline__ unsigned xb_add(unsigned* p, unsigned v) { return __hip_atomic_fetch_add(p, v, __ATOMIC_RELAXED, __HIP_MEMORY_SCOPE_AGENT); }
__device__ __forceinline__ unsigned xb_xcc_id() { return (unsigned)__builtin_amdgcn_s_getreg((3 << 11) | 20) & 0xFu; }
#define XB_SPIN(cond, bar) do { unsigned _sp = 0; while (cond) { __builtin_amdgcn_s_sleep(1); \
    if ((++_sp & 255u) == 0u) { if (xb_ld(&(bar)[XB_TMO])) break; if (_sp > XB_SPIN_CAP) { atomicAdd(&(bar)[XB_TMO], 1u); break; } } } } while (0)

struct XcdBarrier {
    unsigned* bar; unsigned x;
    volatile LAS unsigned* st;
};

__device__ __forceinline__ XcdBarrier xcd_barrier_post(unsigned* bar, volatile LAS unsigned* st, const int tid_) {
    XcdBarrier b; b.bar = bar; b.x = xb_xcc_id(); b.st = st;
    if (tid_ == 0) (void)xb_add(&bar[XB_XCNT(b.x)], 1u);
    return b;
}
__device__ __forceinline__ void xcd_barrier_complete(unsigned* bar, unsigned x, unsigned& nloc, unsigned& nx) {
    const unsigned G = gridDim.x * gridDim.y * gridDim.z;
    unsigned sum, cnt, mine, sp = 0u;
    for (;;) {
        sum = 0u; cnt = 0u; mine = 0u;
#pragma unroll
        for (unsigned j = 0; j < 16; ++j) { const unsigned c = xb_ld(&bar[XB_XCNT(j)]); sum += c; cnt += (c > 0u) ? 1u : 0u; mine = (j == x) ? c : mine; }
        if (sum == G) break;
        __builtin_amdgcn_s_sleep(1);
        if ((++sp & 255u) == 0u) { if (xb_ld(&bar[XB_TMO])) break; if (sp > XB_SPIN_CAP) { atomicAdd(&bar[XB_TMO], 1u); break; } }
    }
    nloc = mine > 0u ? mine : 1u; nx = cnt > 0u ? cnt : 1u;
}

__device__ __forceinline__ void xcd_barrier(const XcdBarrier& b, const int tid_) {
    asm volatile("s_waitcnt vmcnt(0)" ::: "memory");
    __syncthreads();
    if (tid_ == 0) {
        unsigned* bar = b.bar;
        __builtin_amdgcn_s_waitcnt(0);
        unsigned nloc = b.st[0], nx = b.st[1];
        if (nloc == 0u) { xcd_barrier_complete(bar, b.x, nloc, nx); b.st[0] = nloc; b.st[1] = nx; }
        const unsigned old = xb_add(&bar[XB_XSUB(b.x)], 1u);
        const unsigned gen = old / nloc;
        if (old + 1u == (gen + 1u) * nloc) {
            __builtin_amdgcn_fence(__ATOMIC_RELEASE, "agent");
            asm volatile("s_waitcnt vmcnt(0)" ::: "memory");
            const unsigned og = xb_add(&bar[XB_TOP], 1u);
            const unsigned tg = og / nx;
            if (og + 1u == (tg + 1u) * nx) xb_add(&bar[XB_TOPGEN], 1u);
            else XB_SPIN(xb_ld(&bar[XB_TOPGEN]) == tg, bar);
            __builtin_amdgcn_fence(__ATOMIC_ACQUIRE, "agent");
            xb_add(&bar[XB_XGEN(b.x)], 1u);
            asm volatile("s_waitcnt vmcnt(0)" ::: "memory");
        } else {
            XB_SPIN(xb_ld(&bar[XB_XGEN(b.x)]) == gen, bar);
            __builtin_amdgcn_fence(__ATOMIC_ACQUIRE, "agent");
            asm volatile("s_waitcnt vmcnt(0)" ::: "memory");
        }
    }
    __syncthreads();
}
constexpr int NWAVES = 8;
constexpr int N_PHASES = 11;
#ifndef MK_N_LAUNCHES
#define MK_N_LAUNCHES 1
#endif
constexpr int N_LAUNCHES = MK_N_LAUNCHES;

constexpr int M = 16384, D = 1024, NIN = 5632, FF = 2816, INW = 5640;
constexpr int AH = 8, AD = 64, AW = 512, MH = 4, MD = 128, MW = 512, NBLK = 64, NCH = 128, CL = 128;
constexpr float EPS = 1e-6f;
constexpr float LOG2E = 1.4426950408889634f;
constexpr float C2 = 0.125f * LOG2E;

constexpr size_t MiB = 1u << 20;
constexpr size_t WS_CTL = 0, CTL_ZERO_BYTES = 1 * MiB;
constexpr size_t WS_WIN = 1 * MiB;
constexpr size_t WS_WGU = 12 * MiB;
constexpr size_t WS_WD = 23 * MiB;
constexpr size_t WS_WO = 29 * MiB;
constexpr size_t WS_WA = 31 * MiB;
constexpr size_t WS_WM = 32 * MiB;
constexpr size_t WS_MISC = 33 * MiB;
constexpr size_t MS_LOGI = WS_MISC;
constexpr size_t MS_LOGF = MS_LOGI + 256 * 1024;
constexpr size_t MS_BCUM = MS_LOGF + 256 * 1024;
constexpr size_t MS_KMEAN = MS_BCUM + 256 * 1024;
constexpr size_t MS_SEL = MS_KMEAN + 128 * 1024;
constexpr size_t MS_CHS = MS_SEL + 512 * 1024;
constexpr size_t MS_NST = MS_CHS + 64 * 1024;
constexpr size_t MS_SSQ1 = MS_NST + 256 * 1024;
constexpr size_t MS_SSQ2 = MS_SSQ1 + 1024 * 1024;
constexpr size_t MS_MASK = MS_SSQ2 + 1024 * 1024;
static_assert(MS_MASK + 1024 * 1024 <= 40 * MiB, "misc");
constexpr size_t WS_A = 40 * MiB;
constexpr size_t WS_B = 72 * MiB;
constexpr size_t WS_C = 120 * MiB;
constexpr size_t WS_D = 184 * MiB;
constexpr size_t WS_HID = 120 * MiB;
constexpr size_t WS_END = 256 * MiB;
static_assert(WS_HID + (size_t)M * FF * 2 <= WS_END, "hidden overlay");

constexpr int CW_TMO = 0, CW_CODE = 1, CW_TOT = 2048  , CW_BAR = 4096, CW_KSUM = 65536  ;

constexpr int RING_OFF = 0, RING_BYTES = 131072;
constexpr int LDS_BYTES = 147456;
constexpr int LDSCTL_OFF = LDS_BYTES - 512, MISC_OFF = LDSCTL_OFF + 320;


__device__ __forceinline__ float bf2f(unsigned short v) { return __uint_as_float((unsigned)v << 16); }
__device__ __forceinline__ float blo(unsigned w) { return __uint_as_float(w << 16); }
__device__ __forceinline__ float bhi(unsigned w) { return __uint_as_float(w & 0xffff0000u); }
__device__ __forceinline__ float wave_sum(float v) {
#pragma unroll
    for (int o = 1; o < 64; o <<= 1) v += __shfl_xor(v, o);
    return v;
}
__device__ __forceinline__ float wave_max(float v) {
#pragma unroll
    for (int o = 1; o < 64; o <<= 1) v = fmaxf(v, __shfl_xor(v, o));
    return v;
}
__device__ __forceinline__ float sigm(float x) { return 1.0f / (1.0f + __expf(-x)); }

struct Frame {
    LAS unsigned char* lds;
    volatile LAS unsigned* MISC;
    gu32* ctl;
    int tid, lane, wave, vcu, G;
    float* out; unsigned char* ws;
};
typedef const float* cfptr;
#define INP(k) (((LAS cfptr*)(F.lds + LDSCTL_OFF))[k])
#define IN_X INP(0)
#define IN_MIXG INP(1)
#define IN_WIN INP(2)
#define IN_CONV INP(3)
#define IN_BIG INP(4)
#define IN_BFG INP(5)
#define IN_MNG INP(6)
#define IN_WOA INP(7)
#define IN_WOM INP(8)
#define IN_WO INP(9)
#define IN_FFNG INP(10)
#define IN_WFG INP(11)
#define IN_WFU INP(12)
#define IN_WFD INP(13)
#define IN_FING INP(14)
#define WSP(T, off) ((T*)(F.ws + (off)))

__device__ __forceinline__ void tr_item(const float* W, int ldw, int k0, int n_src0, bf16* WT, int ldt, int dst_row0, const float* kscale, LAS float* scr, int lane) {
#pragma unroll 8
    for (int i = 0; i < 32; ++i) { const int kk = 2 * i + (lane >> 5); float v = W[(size_t)(k0 + kk) * ldw + n_src0 + (lane & 31)]; if (kscale) v *= kscale[k0 + kk]; scr[kk * 33 + (lane & 31)] = v; }
    LDS_WAIT(); asm volatile("" ::: "memory");
    const int c = lane & 7;
#pragma unroll
    for (int j = 0; j < 4; ++j) { const int n = (lane >> 3) + 8 * j; const LAS float* s = scr + (8 * c) * 33 + n;
        v4u o; o.x = pk2(s[0 * 33], s[1 * 33]); o.y = pk2(s[2 * 33], s[3 * 33]); o.z = pk2(s[4 * 33], s[5 * 33]); o.w = pk2(s[6 * 33], s[7 * 33]);
        *(GAS v4u*)(WT + (size_t)(dst_row0 + n) * ldt + k0 + 8 * c) = o; }
    LDS_WAIT(); asm volatile("" ::: "memory");
}
__device__ __forceinline__ float log_sigmoid(float z) { return fminf(z, 0.f) - log1pf(__expf(-fabsf(z))); }

__device__ __forceinline__ void p0_prologue(Frame& F) {
    const int gw = F.vcu * NWAVES + F.wave, NGW = F.G * NWAVES, lane = F.lane;
    LAS float* gt = (LAS float*)(F.lds + RING_OFF);
    for (int i = F.tid; i < 8192; i += NWAVES * 64) { const int k = i >> 3, c = i & 7; gt[c * 1024 + k] = IN_WIN[(size_t)k * INW + 3584 + c]; }
    __syncthreads();
    LAS float* scr = (LAS float*)(F.lds + RING_OFF + 32768 + F.wave * 8704);
    constexpr int I_IN = 16 * 176, I_GU = 16 * 88, I_D = 44 * 32, I_O = 16 * 32, I_A = 8 * 32;
    constexpr int NITEMS = I_IN + 2 * I_GU + I_D + I_O + 2 * I_A;
    bf16* Win = WSP(bf16, WS_WIN); bf16* Wgu = WSP(bf16, WS_WGU); bf16* Wd = WSP(bf16, WS_WD); bf16* Wo = WSP(bf16, WS_WO); bf16* Wa = WSP(bf16, WS_WA); bf16* Wm = WSP(bf16, WS_WM);
    for (int it = gw; it < NITEMS; it += NGW) {
        int r = it;
        if (r < I_IN) { const int kb = r / 176, nb = r % 176; const int ns = nb < 112 ? 32 * nb : 3592 + 32 * (nb - 112), nd = nb < 112 ? 32 * nb : 3584 + 32 * (nb - 112);
            tr_item(IN_WIN, INW, 64 * kb, ns, Win, D, nd, nullptr, scr, lane); continue; } r -= I_IN;
        if (r < I_GU) { const int kb = r / 88, nb = r % 88; tr_item(IN_WFG, FF, 64 * kb, 32 * nb, Wgu, D, 256 * (nb >> 2) + 32 * (nb & 3), IN_FFNG, scr, lane); continue; } r -= I_GU;
        if (r < I_GU) { const int kb = r / 88, nb = r % 88; tr_item(IN_WFU, FF, 64 * kb, 32 * nb, Wgu, D, 256 * (nb >> 2) + 128 + 32 * (nb & 3), IN_FFNG, scr, lane); continue; } r -= I_GU;
        if (r < I_D) { const int kb = r / 32, nb = r % 32; tr_item(IN_WFD, D, 64 * kb, 32 * nb, Wd, FF, 32 * nb, nullptr, scr, lane); continue; } r -= I_D;
        if (r < I_O) { const int kb = r / 32, nb = r % 32; tr_item(IN_WO, D, 64 * kb, 32 * nb, Wo, D, 32 * nb, nullptr, scr, lane); continue; } r -= I_O;
        if (r < I_A) { const int kb = r / 32, nb = r % 32; tr_item(IN_WOA, D, 64 * kb, 32 * nb, Wa, AW, 32 * nb, nullptr, scr, lane); continue; } r -= I_A;
        { const int kb = r / 32, nb = r % 32; tr_item(IN_WOM, D, 64 * kb, 32 * nb, Wm, MW, 32 * nb, nullptr, scr, lane); }
    }
    bf16* Hn = WSP(bf16, WS_A); float* logi = WSP(float, MS_LOGI); float* logf = WSP(float, MS_LOGF);
    f32x4 gv[4];
#pragma unroll
    for (int j = 0; j < 4; ++j) gv[j] = ((const GAS f32x4*)IN_MIXG)[lane + 64 * j];
    for (int m = gw; m < M; m += NGW) {
        const GAS f32x4* xr = (const GAS f32x4*)(IN_X + (size_t)m * D) + lane;
        f32x4 v[4]; float s = 0.f;
#pragma unroll
        for (int j = 0; j < 4; ++j) { v[j] = xr[64 * j]; s += (v[j].x * v[j].x + v[j].y * v[j].y) + (v[j].z * v[j].z + v[j].w * v[j].w); }
        const float rstd = 1.0f / sqrtf(wave_sum(s) * (1.f / D) + EPS);
#pragma unroll
        for (int j = 0; j < 4; ++j) v[j] = v[j] * rstd * gv[j];
        GAS unsigned long long* o8 = (GAS unsigned long long*)(Hn + (size_t)m * D) + lane;
#pragma unroll
        for (int j = 0; j < 4; ++j) o8[64 * j] = (unsigned long long)pk2(v[j].x, v[j].y) | ((unsigned long long)pk2(v[j].z, v[j].w) << 32);
        float ga[8];
#pragma unroll
        for (int c = 0; c < 8; ++c) { float a = 0.f;
#pragma unroll
            for (int j = 0; j < 4; ++j) { const f32x4 w = *(const LAS f32x4*)(gt + c * 1024 + 4 * lane + 256 * j); a += (v[j].x * w.x + v[j].y * w.y) + (v[j].z * w.z + v[j].w * w.w); }
            ga[c] = wave_sum(a); }
#pragma unroll
        for (int c = 0; c < 4; ++c) { if (lane == c) logi[(size_t)m * 4 + c] = ga[c] + IN_BIG[c]; if (lane == 4 + c) logf[(size_t)m * 4 + c] = log_sigmoid(ga[4 + c] + IN_BFG[c]); }
    }
}

__device__ __forceinline__ float wave_incl_scan(float v, int lane) {
#pragma unroll
    for (int o = 1; o < 64; o <<= 1) { const float t = __shfl_up(v, o); if (lane >= o) v += t; }
    return v;
}
__device__ __forceinline__ void gate_prep(Frame& F) {
    const int gw = F.vcu * NWAVES + F.wave, NGW = F.G * NWAVES, lane = F.lane;
    const float* logi = WSP(float, MS_LOGI); const float* logf = WSP(float, MS_LOGF); float* bcum = WSP(float, MS_BCUM); float* chs = WSP(float, MS_CHS);
    for (int it = gw; it < MH * NCH; it += NGW) { const int h = it >> 7, c = it & 127, t0 = c * CL;
        float v0 = logf[(size_t)(t0 + lane) * 4 + h], v1 = logf[(size_t)(t0 + 64 + lane) * 4 + h];
        v0 = wave_incl_scan(v0, lane); const float tot0 = __shfl(v0, 63); v1 = wave_incl_scan(v1, lane) + tot0; const float bl = __shfl(v1, 63);
        bcum[(size_t)h * M + t0 + lane] = v0; bcum[(size_t)h * M + t0 + 64 + lane] = v1;
        const float g0 = bl - v0 + logi[(size_t)(t0 + lane) * 4 + h], g1 = bl - v1 + logi[(size_t)(t0 + 64 + lane) * 4 + h];
        const float gm = wave_max(fmaxf(g0, g1));
        if (lane == 0) { chs[0 * 512 + it] = bl; chs[1 * 512 + it] = gm; } }
}
__device__ __forceinline__ void conv8(const bf16* src, int t, int c0, const float* cw, float scale, float (&acc)[8]) {
#pragma unroll
    for (int e = 0; e < 8; ++e) acc[e] = 0.f;
#pragma unroll
    for (int j = 0; j < 4; ++j) { const int tt = t - 3 + j; if (tt >= 0) { const v4u w = *(const GAS v4u*)(src + (size_t)tt * 512 + c0); const f32x4 w0 = *(const GAS f32x4*)(cw + (size_t)j * 1024), w1 = *(const GAS f32x4*)(cw + (size_t)j * 1024 + 4);
            acc[0] += blo(w.x) * w0.x; acc[1] += bhi(w.x) * w0.y; acc[2] += blo(w.y) * w0.z; acc[3] += bhi(w.y) * w0.w; acc[4] += blo(w.z) * w1.x; acc[5] += bhi(w.z) * w1.y; acc[6] += blo(w.w) * w1.z; acc[7] += bhi(w.w) * w1.w; } }
#pragma unroll
    for (int e = 0; e < 8; ++e) acc[e] = acc[e] * sigm(acc[e]) * scale;
}

__device__ __forceinline__ void p2_gating(Frame& F, bool count) {
    const int lane = F.lane, tid = F.tid;
    {
        const bf16* qa = WSP(bf16, WS_B); const float* kmean = (const float*)(F.ctl + CW_KSUM); unsigned* sel = WSP(unsigned, MS_SEL); unsigned long long* mask3 = WSP(unsigned long long, MS_MASK); unsigned* tot = (unsigned*)(F.ctl + CW_TOT);
        LAS float* kl = (LAS float*)(F.lds + RING_OFF);
        for (int qg = F.vcu; qg < M / 64; qg += F.G) {
            const int b = (qg * 64) >> 8;
            __syncthreads();
            for (int i = tid; i < 8 * 64 * 16; i += NWAVES * 64) { const int h = i >> 10, rem = i & 1023; if ((rem >> 4) < b) *(LAS f32x4*)(kl + h * 4096 + rem * 4) = *(const GAS f32x4*)(kmean + h * 4096 + rem * 4); }
            __syncthreads();
            const int h = F.wave, q = qg * 64 + lane;
            float qf[64];
            { const GAS v4u* qp = (const GAS v4u*)(qa + (size_t)q * 512 + h * 64);
#pragma unroll
              for (int i = 0; i < 8; ++i) { const v4u w = qp[i]; qf[8 * i + 0] = blo(w.x); qf[8 * i + 1] = bhi(w.x); qf[8 * i + 2] = blo(w.y); qf[8 * i + 3] = bhi(w.y); qf[8 * i + 4] = blo(w.z); qf[8 * i + 5] = bhi(w.z); qf[8 * i + 6] = blo(w.w); qf[8 * i + 7] = bhi(w.w); } }
            float v0 = -INFINITY, v1 = -INFINITY, v2 = -INFINITY; int j0 = 0, j1 = 0, j2 = 0;
            for (int j = 0; j < b; ++j) { const LAS f32x4* kp = (const LAS f32x4*)(kl + h * 4096 + j * 64); float s = 0.f;
#pragma unroll
                for (int i = 0; i < 16; ++i) { const f32x4 k4 = kp[i]; s += (qf[4 * i] * k4.x + qf[4 * i + 1] * k4.y) + (qf[4 * i + 2] * k4.z + qf[4 * i + 3] * k4.w); }
                if (s > v2) { if (s > v1) { v2 = v1; j2 = j1; if (s > v0) { v1 = v0; j1 = j0; v0 = s; j0 = j; } else { v1 = s; j1 = j; } } else { v2 = s; j2 = j; } } }
            const int n = b < 3 ? b : 3;
            sel[(size_t)h * M + q] = (unsigned)j0 | ((unsigned)j1 << 8) | ((unsigned)j2 << 16) | ((unsigned)n << 24);
            unsigned long long mymask = 0ull;
            for (int j = 0; j < b; ++j) { const unsigned long long mk = __ballot((n > 0 && j0 == j) || (n > 1 && j1 == j) || (n > 2 && j2 == j)); if (lane == j) mymask = mk; }
            if (lane < b) { mask3[((size_t)h * 256 + qg) * 64 + lane] = mymask; const int pc = __popcll(mymask); if (pc && count) atomicAdd(tot + h * 64 + lane, (unsigned)pc); }
        }
        __syncthreads();
    }
}

__device__ __forceinline__ void p3_scan(Frame& F) {
    const int tid = F.tid;
    float* Cl = WSP(float, WS_A); float* nst = WSP(float, MS_NST); const float* chs = WSP(float, MS_CHS);
    const int gt = F.vcu * (NWAVES * 64) + tid, NGT = F.G * NWAVES * 64;
    for (int idx = gt; idx < MH * 16384 + MH * 128; idx += NGT) {
        const bool isc = idx < MH * 16384; const int i2 = isc ? idx : idx - MH * 16384;
        const int h = isc ? (i2 >> 14) : (i2 >> 7), el = isc ? (i2 & 16383) : (i2 & 127);
        float* base = isc ? (Cl + ((size_t)(h * 128) << 14) + el) : (nst + (size_t)(h * 128) * 128 + el);
        const size_t stride = isc ? 16384 : 128; float a = 0.f;
        for (int c0 = 0; c0 < NCH; c0 += 16) { float v[16];
#pragma unroll
            for (int i = 0; i < 16; ++i) v[i] = base[(size_t)(c0 + i) * stride];
#pragma unroll
            for (int i = 0; i < 16; ++i) { a = chs[4 * 512 + h * 128 + c0 + i] * a + v[i]; v[i] = a; }
#pragma unroll
            for (int i = 0; i < 16; ++i) base[(size_t)(c0 + i) * stride] = v[i]; }
    }
}
typedef float f32x16 __attribute__((ext_vector_type(16)));
typedef short s16x4 __attribute__((ext_vector_type(4)));
typedef short v4i16_t __attribute__((ext_vector_type(4)));
typedef unsigned u32x4a __attribute__((ext_vector_type(4)));
__device__ __forceinline__ int crow(int r, int hi) { return (r & 3) + 8 * (r >> 2) + 4 * hi; }
__device__ __forceinline__ unsigned cvtpk(float lo, float hi) { unsigned r; asm("v_cvt_pk_bf16_f32 %0, %1, %2" : "=v"(r) : "v"(lo), "v"(hi)); return r; }
__device__ __forceinline__ s16x4 vtr(const LAS unsigned char* p) { return __builtin_bit_cast(s16x4, __builtin_amdgcn_ds_read_tr16_b64_v4i16((LAS v4i16_t*)p)); }
__device__ __forceinline__ float swapmax(float m) { auto rr = __builtin_amdgcn_permlane32_swap(__float_as_uint(m), __float_as_uint(m), false, false); return fmaxf(__uint_as_float(rr[0]), __uint_as_float(rr[1])); }
__device__ __forceinline__ float swapsum(float m) { auto rr = __builtin_amdgcn_permlane32_swap(__float_as_uint(m), __float_as_uint(m), false, false); return __uint_as_float(rr[0]) + __uint_as_float(rr[1]); }

__device__ __forceinline__ void attn_tile(const LAS unsigned char* Kl, const LAS unsigned char* Vl, const bf16x8 (&qr)[4], int nkb, bool diag, int qrel, float ch, int lane,
                                          f32x16& o0, f32x16& o1, float& mxo, float& lo_) {
    const int r32 = lane & 31, hi = lane >> 5;
    f32x16 p[8];
    const float base = ch * (float)(4 * hi - qrel);
    const LAS unsigned char* kb0 = Kl + hi * 4096 + r32 * 16;
#pragma unroll
    for (int kb = 0; kb < 8; ++kb) {
        if (kb < nkb) {
            f32x16 c;
#pragma unroll
            for (int r = 0; r < 16; ++r) c[r] = __builtin_fmaf(ch, (float)(32 * kb + (r & 3) + 8 * (r >> 2)), base);
#pragma unroll
            for (int d0 = 0; d0 < 4; ++d0) { const bf16x8 ka = *(const LAS bf16x8*)(kb0 + d0 * 8192 + kb * 512); c = __builtin_amdgcn_mfma_f32_32x32x16_bf16(ka, qr[d0], c, 0, 0, 0); }
            if (diag && kb == nkb - 1) {
#pragma unroll
                for (int r = 0; r < 16; ++r) if (32 * kb + crow(r, hi) > qrel) c[r] = -INFINITY;
            }
            p[kb] = c;
        }
    }
    float mx = -INFINITY;
#pragma unroll
    for (int kb = 0; kb < 8; ++kb) if (kb < nkb) {
#pragma unroll
        for (int r = 0; r < 16; ++r) mx = fmaxf(mx, p[kb][r]);
    }
    mx = swapmax(mx);
    float l = 0.f;
    u32x4a pw[8][2];
#pragma unroll
    for (int kb = 0; kb < 8; ++kb) {
        if (kb < nkb) {
            f32x16 e;
#pragma unroll
            for (int r = 0; r < 16; ++r) { e[r] = __builtin_amdgcn_exp2f(p[kb][r] - mx); l += e[r]; }
            pw[kb][0] = (u32x4a){cvtpk(e[0], e[1]), cvtpk(e[2], e[3]), cvtpk(e[4], e[5]), cvtpk(e[6], e[7])};
            pw[kb][1] = (u32x4a){cvtpk(e[8], e[9]), cvtpk(e[10], e[11]), cvtpk(e[12], e[13]), cvtpk(e[14], e[15])};
        } else { pw[kb][0] = (u32x4a){0u, 0u, 0u, 0u}; pw[kb][1] = (u32x4a){0u, 0u, 0u, 0u}; }
    }
    l = swapsum(l);
    f32x16 a0, a1;
#pragma unroll
    for (int r = 0; r < 16; ++r) { a0[r] = 0.f; a1[r] = 0.f; }
    const LAS unsigned char* vb = Vl + ((lane >> 4) & 1) * 32 + (lane & 3) * 8 + (4 * hi + ((lane & 15) >> 2)) * 64;
#pragma unroll
    for (int kb = 0; kb < 8; ++kb) {
        if ((kb & ~1) < nkb) {
#pragma unroll
            for (int k2 = 0; k2 < 2; ++k2) {
                const bf16x8 pa = __builtin_bit_cast(bf16x8, pw[kb][k2]);
                const LAS unsigned char* vp = vb + (kb * 2 + k2) * 1024;
                const s16x4 l0 = vtr(vp), h0 = vtr(vp + 512), l1 = vtr(vp + 16384), h1 = vtr(vp + 16384 + 512);
                const bf16x8 v0 = (bf16x8){l0[0], l0[1], l0[2], l0[3], h0[0], h0[1], h0[2], h0[3]};
                const bf16x8 v1 = (bf16x8){l1[0], l1[1], l1[2], l1[3], h1[0], h1[1], h1[2], h1[3]};
                a0 = __builtin_amdgcn_mfma_f32_32x32x16_bf16(pa, v0, a0, 0, 0, 0);
                a1 = __builtin_amdgcn_mfma_f32_32x32x16_bf16(pa, v1, a1, 0, 0, 0);
            }
        }
    }
    o0 = a0; o1 = a1; mxo = mx; lo_ = l;
}

__device__ __forceinline__ void load_kv_tile(const bf16* Kt, const bf16* Vt, int h, int j, LAS unsigned char* Kl, LAS unsigned char* Vl, int tid) {
    const GAS unsigned char* ks = (const GAS unsigned char*)Kt + (size_t)(h * 64 + j) * 32768; const GAS unsigned char* vs = (const GAS unsigned char*)Vt + (size_t)(h * 64 + j) * 32768;
#pragma unroll
    for (int i = 0; i < 4; ++i) { const unsigned off = (unsigned)(tid + 512 * i) * 16u; *(LAS v4u*)(Kl + off) = *(const GAS v4u*)(ks + off); *(LAS v4u*)(Vl + off) = *(const GAS v4u*)(vs + off); }
}
__device__ __forceinline__ int select_bit(unsigned long long m, int k) {
    int pos = 0; unsigned x = (unsigned)m; int c = __popc(x);
    if (k >= c) { k -= c; pos = 32; x = (unsigned)(m >> 32); }
    c = __popc(x & 0xffffu); if (k >= c) { k -= c; pos += 16; x >>= 16; }
    c = __popc(x & 0xffu); if (k >= c) { k -= c; pos += 8; x >>= 8; }
    c = __popc(x & 0xfu); if (k >= c) { k -= c; pos += 4; x >>= 4; }
    c = __popc(x & 0x3u); if (k >= c) { k -= c; pos += 2; x >>= 2; }
    c = (int)(x & 1u); if (k >= c) pos += 1;
    return pos;
}
__device__ __forceinline__ int block_incl_scan(int v, LAS int* scr, int tid, int lane, int wave) {
#pragma unroll
    for (int o = 1; o < 64; o <<= 1) { const int t = __shfl_up(v, o); if (lane >= o) v += t; }
    __syncthreads();
    if (lane == 63) scr[wave] = v;
    __syncthreads();
    int add = 0;
#pragma unroll
    for (int w = 0; w < 8; ++w) { const int t = scr[w]; if (w < wave) add += t; }
    return v + add;
}

__device__ __forceinline__ void p3_attn_selected(Frame& F) {
    const int tid = F.tid, lane = F.lane, wave = F.wave, r32 = lane & 31, hi = lane >> 5;
    const bf16* Qa = WSP(bf16, WS_B); const bf16* Kt = Qa + (size_t)M * 512; const bf16* Vt = Kt + (size_t)M * 512;
    const unsigned* sel = WSP(unsigned, MS_SEL); const unsigned long long* mask3 = WSP(unsigned long long, MS_MASK); const unsigned* tot = (const unsigned*)(F.ctl + CW_TOT);
    bf16* Op = (bf16*)F.out; float* Lp = (float*)((unsigned char*)F.out + 48 * MiB);
    LAS unsigned char* Kl = F.lds + RING_OFF; LAS unsigned char* Vl = F.lds + RING_OFF + 32768;
    LAS int* pre = (LAS int*)(F.lds + RING_OFF + 65536); LAS int* gpx = pre + 520; LAS unsigned long long* lmask = (LAS unsigned long long*)(gpx + 264);
    LAS int* rowq = (LAS int*)(lmask + 256); LAS int* rowslot = rowq + 256; LAS int* scr = rowslot + 256; LAS float* wsf = (LAS float*)(scr + 16) + wave * 64;
    { const int n = (int)tot[tid]; const int rounds = (n + 255) >> 8; const int inc = block_incl_scan(rounds, scr, tid, lane, wave); pre[tid + 1] = inc; if (tid == 0) pre[0] = 0; }
    __syncthreads();
    const int TOTAL = pre[512];
    const int s_lo = (int)(((long)TOTAL * F.vcu) / F.G), s_hi = (int)(((long)TOTAL * (F.vcu + 1)) / F.G);
    int cur_item = -1, n_item = 0;
    for (int sidx = s_lo; sidx < s_hi; ++sidx) {
        int a = 0, b = 512;
        while (b - a > 1) { const int mid = (a + b) >> 1; if (pre[mid] <= sidx) a = mid; else b = mid; }
        const int item = a, h = item >> 6, j = item & 63, r0 = (sidx - pre[item]) * 256;
        __syncthreads();
        if (item != cur_item) {
            cur_item = item; n_item = (int)tot[item];
            load_kv_tile(Kt, Vt, h, j, Kl, Vl, tid);
            int pc = 0;
            if (tid < 256) { unsigned long long mk = 0ull; if (tid >= 4 * (j + 1)) mk = mask3[((size_t)h * 256 + tid) * 64 + j]; lmask[tid] = mk; pc = __popcll(mk); }
            const int inc = block_incl_scan(pc, scr, tid, lane, wave);
            if (tid < 256) gpx[tid + 1] = inc; if (tid == 0) gpx[0] = 0;
        }
        __syncthreads();
        if (tid < 256) { const int row = r0 + tid; int q = -1, slot = 0;
            if (row < n_item) { int a2 = 0, b2 = 256; while (b2 - a2 > 1) { const int mid = (a2 + b2) >> 1; if (gpx[mid] <= row) a2 = mid; else b2 = mid; }
                const int pos = select_bit(lmask[a2], row - gpx[a2]); q = a2 * 64 + pos;
                const unsigned sl = sel[(size_t)h * M + q]; slot = ((int)(sl & 0xffu) == j) ? 0 : (((int)((sl >> 8) & 0xffu) == j) ? 1 : 2); }
            rowq[tid] = q; rowslot[tid] = slot; }
        __syncthreads();
        const int q_first = rowq[wave * 32];
        if (q_first >= 0) {
            int q = rowq[wave * 32 + r32]; const bool valid = q >= 0; if (!valid) q = q_first;
            bf16x8 qr[4];
#pragma unroll
            for (int d0 = 0; d0 < 4; ++d0) qr[d0] = *(const GAS bf16x8*)(Qa + (size_t)q * 512 + h * 64 + d0 * 16 + hi * 8);
            const float ch = exp2f(-(float)(h + 1)) * LOG2E;
            f32x16 o0, o1; float mx, l;
            attn_tile(Kl, Vl, qr, 8, false, q - j * 256, ch, lane, o0, o1, mx, l);
            if (hi == 0) { wsf[r32] = 1.0f / l; if (valid) Lp[((size_t)q * 8 + h) * 3 + rowslot[wave * 32 + r32]] = mx + __log2f(l); }
            asm volatile("s_waitcnt lgkmcnt(0)" ::: "memory");
#pragma unroll
            for (int r = 0; r < 16; ++r) { const int rr = crow(r, hi); const int qq = rowq[wave * 32 + rr];
                if (qq >= 0) { const float rl = wsf[rr]; bf16* dst = Op + (((size_t)qq * 8 + h) * 3 + rowslot[wave * 32 + rr]) * 64 + r32;
                    dst[0] = (bf16)f2bf(o0[r] * rl); dst[32] = (bf16)f2bf(o1[r] * rl); } }
        }
    }
    __syncthreads();
}

__device__ __forceinline__ void p4_attn_own(Frame& F, bf16* Ydst, int qmask) {
    const int tid = F.tid, lane = F.lane, wave = F.wave, r32 = lane & 31, hi = lane >> 5;
    bf16* Qa = WSP(bf16, WS_B); const bf16* Kt = Qa + (size_t)M * 512; const bf16* Vt = Kt + (size_t)M * 512;
    const bf16* Op = (const bf16*)F.out; const float* Lp = (const float*)((const unsigned char*)F.out + 48 * MiB);
    LAS float* tab = (LAS float*)(F.lds + RING_OFF + 131072) + wave * 128;
    for (int pr = F.vcu; pr < 256; pr += F.G) {
        const int b = pr & 63;
        __syncthreads();
        load_kv_tile(Kt, Vt, pr >> 6, b, F.lds + RING_OFF, F.lds + RING_OFF + 32768, tid);
        load_kv_tile(Kt, Vt, 4 + (pr >> 6), b, F.lds + RING_OFF + 65536, F.lds + RING_OFF + 98304, tid);
        __syncthreads();
#pragma unroll 1
        for (int half = 0; half < 2; ++half) {
            const int h = half * 4 + (pr >> 6), qt = half ? 7 - wave : wave;
            const LAS unsigned char* Kl = F.lds + RING_OFF + half * 65536; const LAS unsigned char* Vl = Kl + 32768;
            const int q = b * 256 + qt * 32 + r32;
            bf16x8 qr[4];
#pragma unroll
            for (int d0 = 0; d0 < 4; ++d0) qr[d0] = *(const GAS bf16x8*)(Qa + (size_t)q * 512 + h * 64 + d0 * 16 + hi * 8);
            const float ch = exp2f(-(float)(h + 1)) * LOG2E;
            f32x16 o0, o1; float mx, l;
            attn_tile(Kl, Vl, qr, qt + 1, true, qt * 32 + r32, ch, lane, o0, o1, mx, l);
            const int n = b < 3 ? b : 3;
            if (hi == 0) { const float lse = mx + __log2f(l); float ls[3]; float big = lse;
#pragma unroll
                for (int s = 0; s < 3; ++s) { ls[s] = (s < n) ? Lp[((size_t)q * 8 + h) * 3 + s] : -INFINITY; big = fmaxf(big, ls[s]); }
                const float wo = __builtin_amdgcn_exp2f(lse - big); float w[3]; float den = wo;
#pragma unroll
                for (int s = 0; s < 3; ++s) { w[s] = __builtin_amdgcn_exp2f(ls[s] - big); den += w[s]; }
                const float rd = 1.0f / den; tab[r32] = wo * rd / l; tab[32 + r32] = w[0] * rd; tab[64 + r32] = w[1] * rd; tab[96 + r32] = w[2] * rd; }
            asm volatile("s_waitcnt lgkmcnt(0)" ::: "memory");
#pragma unroll
            for (int r = 0; r < 16; ++r) { const int rr = crow(r, hi); const int qq = b * 256 + qt * 32 + rr;
                float y0 = o0[r] * tab[rr], y1 = o1[r] * tab[rr];
                const bf16* src = Op + ((size_t)qq * 8 + h) * 3 * 64 + r32;
#pragma unroll
                for (int s = 0; s < 3; ++s) if (s < n) { const float w = tab[32 + 32 * s + rr]; y0 += w * bf2f(src[s * 64]); y1 += w * bf2f(src[s * 64 + 32]); }
                bf16* dst = Ydst + (size_t)(qq & qmask) * 512 + h * 64 + r32; dst[0] = (bf16)f2bf(y0); dst[32] = (bf16)f2bf(y1); }
            asm volatile("s_waitcnt lgkmcnt(0)" ::: "memory");
        }
    }
    __syncthreads();
}
__device__ __forceinline__ void mscan_wave(const float* chs, int h, int c, int lane, float& mprev, float& mnew) {
    const float b0 = chs[0 * 512 + h * 128 + 2 * lane], b1 = chs[0 * 512 + h * 128 + 2 * lane + 1], g0 = chs[1 * 512 + h * 128 + 2 * lane], g1 = chs[1 * 512 + h * 128 + 2 * lane + 1];
    float A = b0 + b1, G = fmaxf(b1 + g0, g1);
#pragma unroll
    for (int o = 1; o < 64; o <<= 1) { const float Ap = __shfl_up(A, o), Gp = __shfl_up(G, o); if (lane >= o) { G = fmaxf(A + Gp, G); A = A + Ap; } }
    const float m_odd = fmaxf(A, G);
    float m_before = __shfl_up(m_odd, 1); if (lane == 0) m_before = 0.f;
    const float m_even = fmaxf(b0 + m_before, g0);
    const int src = c >> 1;
    const float me = __shfl(m_even, src), mo = __shfl(m_odd, src), mb = __shfl(m_before, src);
    if (c & 1) { mprev = me; mnew = mo; } else { mprev = mb; mnew = me; }
}
__device__ __forceinline__ int panel_off(int r, int ci  ) { return (ci >> 2) * 8192 + r * 64 + (ci & 3) * 16; }
__device__ __forceinline__ int chunk_off(int r, int ci) { return ci * 2048 + r * 16; }
__device__ __forceinline__ bf16x8 tr8(const LAS unsigned char* p, int second) { const s16x4 a = vtr(p), b = vtr(p + second); return (bf16x8){a[0], a[1], a[2], a[3], b[0], b[1], b[2], b[3]}; }

__device__ __forceinline__ void p2_cloc(Frame& F) {
    const int tid = F.tid, lane = F.lane, wave = F.wave, r32 = lane & 31, hi = lane >> 5;
    const bf16* km = WSP(bf16, WS_C) + (size_t)M * 512; const bf16* vm = WSP(bf16, WS_C) + (size_t)2 * M * 512;
    const float* logi = WSP(float, MS_LOGI); const float* bcum = WSP(float, MS_BCUM); float* chs = WSP(float, MS_CHS);
    float* Cl = WSP(float, WS_A); float* nst = WSP(float, MS_NST);
    LAS unsigned char* KW = F.lds + RING_OFF; LAS unsigned char* VV = F.lds + RING_OFF + 32768; LAS float* sh = (LAS float*)(F.lds + RING_OFF + 65536);
    const float* cwk = IN_CONV + 512;
    for (int it = F.vcu; it < MH * NCH; it += F.G) { const int h = it >> 7, c = it & 127, t0 = c * CL;
        __syncthreads();
        if (wave == 0) { float mp, mn; mscan_wave(chs, h, c, lane, mp, mn);
            if (lane == 0) { sh[0] = mp; sh[1] = mn; const float bl = chs[0 * 512 + it]; chs[2 * 512 + it] = mp; chs[3 * 512 + it] = mn; chs[4 * 512 + it] = __expf(bl + mp - mn); } }
        __syncthreads();
        if (tid < 128) { const float bl = chs[0 * 512 + it]; sh[8 + tid] = __expf(bl - bcum[(size_t)h * M + t0 + tid] + logi[(size_t)(t0 + tid) * 4 + h] - sh[1]); }
        __syncthreads();
#pragma unroll
        for (int i = 0; i < 4; ++i) { const int idx = tid + 512 * i, r = idx >> 4, ci = idx & 15; const float w = sh[8 + r];
            float kk[8]; conv8(km, t0 + r, h * 128 + ci * 8, cwk + h * 128 + ci * 8, 0.08838834764831845f, kk);
            v4u o;
            { const float k0 = bf2f((bf16)f2bf(kk[0])), k1 = bf2f((bf16)f2bf(kk[1])), k2 = bf2f((bf16)f2bf(kk[2])), k3 = bf2f((bf16)f2bf(kk[3])), k4 = bf2f((bf16)f2bf(kk[4])), k5 = bf2f((bf16)f2bf(kk[5])), k6 = bf2f((bf16)f2bf(kk[6])), k7 = bf2f((bf16)f2bf(kk[7]));
              o.x = pk2(k0 * w, k1 * w); o.y = pk2(k2 * w, k3 * w); o.z = pk2(k4 * w, k5 * w); o.w = pk2(k6 * w, k7 * w); }
            *(LAS v4u*)(KW + panel_off(r, ci)) = o;
            *(LAS v4u*)(VV + panel_off(r, ci)) = *(const GAS v4u*)(vm + (size_t)(t0 + r) * 512 + h * 128 + ci * 8); }
        __syncthreads();
        {
            const int db = wave >> 1, eb0 = 2 * (wave & 1);
            const int toff = (4 * hi + ((lane & 15) >> 2)) * 64 + ((lane >> 4) & 1) * 32 + (lane & 3) * 8;
            f32x16 a0, a1;
#pragma unroll
            for (int r = 0; r < 16; ++r) { a0[r] = 0.f; a1[r] = 0.f; }
#pragma unroll
            for (int ks = 0; ks < 8; ++ks) {
                const bf16x8 A = tr8(KW + db * 8192 + ks * 1024 + toff, 512);
                const bf16x8 B0 = tr8(VV + eb0 * 8192 + ks * 1024 + toff, 512), B1 = tr8(VV + (eb0 + 1) * 8192 + ks * 1024 + toff, 512);
                a0 = __builtin_amdgcn_mfma_f32_32x32x16_bf16(A, B0, a0, 0, 0, 0);
                a1 = __builtin_amdgcn_mfma_f32_32x32x16_bf16(A, B1, a1, 0, 0, 0);
            }
            float* dst = Cl + ((size_t)it * 128 + 32 * db) * 128 + 32 * eb0 + r32;
#pragma unroll
            for (int r = 0; r < 16; ++r) { const int d = crow(r, hi); dst[(size_t)d * 128] = a0[r]; dst[(size_t)d * 128 + 32] = a1[r]; }
        }
        {
            const int d = tid >> 2, part = tid & 3; float ns = 0.f;
            const LAS bf16* col = (const LAS bf16*)(KW + (d >> 5) * 8192 + (d & 31) * 2);
#pragma unroll 8
            for (int s = 0; s < 32; ++s) ns += bf2f(col[(part * 32 + s) * 32]);
            ns += __shfl_xor(ns, 1); ns += __shfl_xor(ns, 2);
            if (part == 0) nst[(size_t)it * 128 + d] = ns;
        }
    }
    __syncthreads();
}

__device__ __forceinline__ void p4_mlstm_out(Frame& F, bf16* Ydst, int tmask) {
    const int wave = F.wave;
    const bf16* qm = WSP(bf16, WS_C); const bf16* km = qm + (size_t)M * 512; const bf16* vm = WSP(bf16, WS_C) + (size_t)2 * M * 512; bf16* om = WSP(bf16, WS_C) + (size_t)3 * M * 512;
    const float* logi = WSP(float, MS_LOGI); const float* bcum = WSP(float, MS_BCUM); const float* chs = WSP(float, MS_CHS);
    const float* Cst = WSP(float, WS_A); const float* nst = WSP(float, MS_NST);
    LAS unsigned char* Qc = F.lds + RING_OFF; LAS unsigned char* Kc = F.lds + RING_OFF + 32768; LAS unsigned char* Vp = F.lds + RING_OFF + 65536; LAS unsigned char* Cp = F.lds + RING_OFF + 98304;
    LAS float* sh = (LAS float*)(F.lds + RING_OFF + 131072);
    LAS float* bvec = sh, *ivb = sh + 128, *pm = sh + 256, *nprev = sh + 384, *stat = sh + 512;
    const float* cwq = IN_CONV; const float* cwk = IN_CONV + 512; const float* lng = IN_MNG;
    for (int it = F.vcu; it < MH * NCH; it += F.G) { const int h = it >> 7, c = it & 127, t0 = c * CL;
        int tid = F.tid; asm volatile("" : "+v"(tid));
        const int lane = tid & 63, r32 = lane & 31, hi = lane >> 5; LAS float* wt = sh + 1024 + wave * 64;
        __syncthreads();
#pragma unroll 1
        for (int i = 0; i < 4; ++i) { const int idx = tid + 512 * i, r = idx >> 4, ci = idx & 15; const size_t go = (size_t)(t0 + r) * 512 + h * 128 + ci * 8;
            float cq[8], ck[8]; conv8(qm, t0 + r, h * 128 + ci * 8, cwq + h * 128 + ci * 8, 1.0f, cq); conv8(km, t0 + r, h * 128 + ci * 8, cwk + h * 128 + ci * 8, 0.08838834764831845f, ck);
            *(LAS v4u*)(Qc + chunk_off(r, ci)) = (v4u){pk2(cq[0], cq[1]), pk2(cq[2], cq[3]), pk2(cq[4], cq[5]), pk2(cq[6], cq[7])};
            *(LAS v4u*)(Kc + chunk_off(r, ci)) = (v4u){pk2(ck[0], ck[1]), pk2(ck[2], ck[3]), pk2(ck[4], ck[5]), pk2(ck[6], ck[7])};
            *(LAS v4u*)(Vp + panel_off(r, ci)) = *(const GAS v4u*)(vm + go);
            v4u o = (v4u){0u, 0u, 0u, 0u};
            if (c > 0) { const float* cp = Cst + ((size_t)(it - 1) * 128 + r) * 128 + ci * 8; const f32x4 a = *(const GAS f32x4*)cp, b = *(const GAS f32x4*)(cp + 4); o.x = pk2(a.x, a.y); o.y = pk2(a.z, a.w); o.z = pk2(b.x, b.y); o.w = pk2(b.z, b.w); }
            *(LAS v4u*)(Cp + panel_off(r, ci)) = o; }
        if (tid < 128) { const float bt = bcum[(size_t)h * M + t0 + tid]; bvec[tid] = bt; ivb[tid] = logi[(size_t)(t0 + tid) * 4 + h] - bt; nprev[tid] = (c > 0) ? nst[(size_t)(it - 1) * 128 + tid] : 0.f; }
        __syncthreads();
        if (wave == 0) { float v0 = ivb[lane], v1 = ivb[64 + lane];
#pragma unroll
            for (int o = 1; o < 64; o <<= 1) { const float a = __shfl_up(v0, o), b = __shfl_up(v1, o); if (lane >= o) { v0 = fmaxf(v0, a); v1 = fmaxf(v1, b); } }
            v1 = fmaxf(v1, __shfl(v0, 63)); pm[lane] = v0; pm[64 + lane] = v1; }
        __syncthreads();
        const float mprev = chs[2 * 512 + it];
        const int tb = wave & 3, eh = wave >> 2, t = 32 * tb + r32;
        bf16x8 qr[8];
#pragma unroll
        for (int k0 = 0; k0 < 8; ++k0) qr[k0] = *(const LAS bf16x8*)(Qc + (2 * k0 + hi) * 2048 + t * 16);
        const float bt = bvec[t], mt = bt + fmaxf(mprev, pm[t]), winter = __expf(bt + mprev - mt), cst = bt - mt;
        float rs = 0.f; u32x4a pw[4][2];
#pragma unroll
        for (int sb = 0; sb < 4; ++sb) {
            if (sb <= tb) {
                f32x16 cc;
#pragma unroll
                for (int r = 0; r < 16; ++r) cc[r] = 0.f;
#pragma unroll
                for (int k0 = 0; k0 < 8; ++k0) { const bf16x8 ka = *(const LAS bf16x8*)(Kc + (2 * k0 + hi) * 2048 + (32 * sb + r32) * 16); cc = __builtin_amdgcn_mfma_f32_32x32x16_bf16(ka, qr[k0], cc, 0, 0, 0); }
                float e[16];
#pragma unroll
                for (int r = 0; r < 16; ++r) { const int s = 32 * sb + crow(r, hi); const float w = (s <= t) ? __expf(ivb[s] + cst) : 0.f; e[r] = cc[r] * w; rs += e[r]; }
                pw[sb][0] = (u32x4a){cvtpk(e[0], e[1]), cvtpk(e[2], e[3]), cvtpk(e[4], e[5]), cvtpk(e[6], e[7])};
                pw[sb][1] = (u32x4a){cvtpk(e[8], e[9]), cvtpk(e[10], e[11]), cvtpk(e[12], e[13]), cvtpk(e[14], e[15])};
            } else { pw[sb][0] = (u32x4a){0u, 0u, 0u, 0u}; pw[sb][1] = (u32x4a){0u, 0u, 0u, 0u}; }
        }
        rs = swapsum(rs);
        float qn = 0.f;
#pragma unroll
        for (int k0 = 0; k0 < 8; ++k0) { const u32x4a qq = __builtin_bit_cast(u32x4a, qr[k0]); const LAS float* np = nprev + 16 * k0 + 8 * hi;
            qn += (blo(qq.x) * np[0] + bhi(qq.x) * np[1]) + (blo(qq.y) * np[2] + bhi(qq.y) * np[3]) + (blo(qq.z) * np[4] + bhi(qq.z) * np[5]) + (blo(qq.w) * np[6] + bhi(qq.w) * np[7]); }
        qn = swapsum(qn);
        const float den = winter * qn + rs, scl = 1.0f / fmaxf(fabsf(den), __expf(-mt));
        if (hi == 0) { wt[r32] = winter; wt[32 + r32] = scl; }
        f32x16 acc[2];
#pragma unroll
        for (int r = 0; r < 16; ++r) { acc[0][r] = 0.f; acc[1][r] = 0.f; }
        const int coff = (8 * hi + ((lane & 15) >> 2)) * 64 + ((lane >> 4) & 1) * 32 + (lane & 3) * 8;
#pragma unroll
        for (int k0 = 0; k0 < 8; ++k0) {
#pragma unroll
            for (int eb = 0; eb < 2; ++eb) { const bf16x8 B = tr8(Cp + (2 * eh + eb) * 8192 + k0 * 1024 + coff, 256); acc[eb] = __builtin_amdgcn_mfma_f32_32x32x16_bf16(qr[k0], B, acc[eb], 0, 0, 0); } }
        asm volatile("s_waitcnt lgkmcnt(0)" ::: "memory");
#pragma unroll
        for (int r = 0; r < 16; ++r) { const float wi = wt[crow(r, hi)]; acc[0][r] *= wi; acc[1][r] *= wi; }
        const int voff = (4 * hi + ((lane & 15) >> 2)) * 64 + ((lane >> 4) & 1) * 32 + (lane & 3) * 8;
#pragma unroll
        for (int sb = 0; sb < 4; ++sb) {
            if (sb <= tb) {
#pragma unroll
                for (int k2 = 0; k2 < 2; ++k2) { const bf16x8 pa = __builtin_bit_cast(bf16x8, pw[sb][k2]);
#pragma unroll
                    for (int eb = 0; eb < 2; ++eb) { const bf16x8 B = tr8(Vp + (2 * eh + eb) * 8192 + (2 * sb + k2) * 1024 + voff, 512); acc[eb] = __builtin_amdgcn_mfma_f32_32x32x16_bf16(pa, B, acc[eb], 0, 0, 0); } }
            }
        }
        const size_t gbase = (size_t)(t0 + 32 * tb) * 512 + h * 128 + 64 * eh + r32;
        float s1[16], s2[16];
#pragma unroll
        for (int r = 0; r < 16; ++r) { const int tr_ = crow(r, hi); const float sc = wt[32 + tr_]; const bf16* op = om + gbase + (size_t)tr_ * 512;
            const float x0 = acc[0][r] * sc * sigm(bf2f(op[0])), x1 = acc[1][r] * sc * sigm(bf2f(op[32])); acc[0][r] = x0; acc[1][r] = x1; s1[r] = x0 + x1; s2[r] = x0 * x0 + x1 * x1; }
#pragma unroll
        for (int o = 1; o < 32; o <<= 1) {
#pragma unroll
            for (int r = 0; r < 16; ++r) { s1[r] += __shfl_xor(s1[r], o); s2[r] += __shfl_xor(s2[r], o); } }
        if (r32 == 0) {
#pragma unroll
            for (int r = 0; r < 16; ++r) { const int tt = 32 * tb + crow(r, hi); stat[(tt * 2 + eh) * 2] = s1[r]; stat[(tt * 2 + eh) * 2 + 1] = s2[r]; } }
        __syncthreads();
        const float g0 = lng[h * 128 + 64 * eh + r32], g1 = lng[h * 128 + 64 * eh + 32 + r32];
#pragma unroll
        for (int r = 0; r < 16; ++r) { const int tr_ = crow(r, hi), tt = 32 * tb + tr_;
            const float sum = stat[tt * 4] + stat[tt * 4 + 2], sq = stat[tt * 4 + 1] + stat[tt * 4 + 3];
            const float mu = sum * (1.0f / 128.0f), var = fmaxf(sq * (1.0f / 128.0f) - mu * mu, 0.f), rstd = 1.0f / sqrtf(var + EPS);
            bf16* yp = Ydst + (size_t)((t0 + 32 * tb + tr_) & tmask) * 512 + h * 128 + 64 * eh + r32;
            yp[0] = (bf16)f2bf((acc[0][r] - mu) * rstd * g0); yp[32] = (bf16)f2bf((acc[1][r] - mu) * rstd * g1); }
    }
    __syncthreads();
}

__device__ __forceinline__ void p10_final_norm(Frame& F) {
    const int gw = F.vcu * NWAVES + F.wave, NGW = F.G * NWAVES, lane = F.lane;
    f32x4 gv[4];
#pragma unroll
    for (int j = 0; j < 4; ++j) gv[j] = ((const GAS f32x4*)IN_FING)[lane + 64 * j];
    for (int m = gw; m < M; m += NGW) {
        GAS f32x4* xr = (GAS f32x4*)(F.out + (size_t)m * D) + lane;
        f32x4 v[4]; float s = 0.f;
#pragma unroll
        for (int j = 0; j < 4; ++j) { v[j] = xr[64 * j]; s += (v[j].x * v[j].x + v[j].y * v[j].y) + (v[j].z * v[j].z + v[j].w * v[j].w); }
        const float rstd = 1.0f / sqrtf(wave_sum(s) * (1.f / D) + EPS);
#pragma unroll
        for (int j = 0; j < 4; ++j) xr[64 * j] = v[j] * rstd * gv[j];
    }
}

struct Args { const float* in[15]; float* out; unsigned char* ws; int ph_lo, ph_hi, li, pad; };
__global__ void __launch_bounds__(NWAVES * 64, 2) mk_fwd(Args args) {
    extern __shared__ __attribute__((aligned(16))) unsigned char lds[];
    Frame F;
    F.lds = (LAS unsigned char*)lds;
    F.MISC = (volatile LAS unsigned*)(F.lds + MISC_OFF);
    F.tid = threadIdx.x; F.lane = F.tid & 63; F.wave = __builtin_amdgcn_readfirstlane(F.tid >> 6);
    F.G = gridDim.x; { const int bx = blockIdx.x; F.vcu = (F.G % 8 == 0) ? (bx % 8) * (F.G / 8) + bx / 8 : bx; }
    F.ws = args.ws; F.ctl = (gu32*)(args.ws + WS_CTL); F.out = args.out;
    for (int u = F.tid; u < (LDS_BYTES - LDSCTL_OFF) / 4; u += NWAVES * 64) ((LAS unsigned*)(F.lds + LDSCTL_OFF))[u] = 0u;
    __syncthreads();
    if (F.tid < 15) ((LAS cfptr*)(F.lds + LDSCTL_OFF))[F.tid] = args.in[F.tid];
    __syncthreads();
#define REFRESH() do { int l_; asm volatile("v_mbcnt_lo_u32_b32 %0, -1, 0\n\tv_mbcnt_hi_u32_b32 %0, -1, %0" : "=v"(l_)); F.lane = l_; F.tid = F.wave * 64 + l_; } while (0)
    XcdBarrier bar; bar.bar = (unsigned*)(F.ctl + CW_BAR); bar.x = 0; bar.st = nullptr;
    if (N_LAUNCHES == 1) bar = xcd_barrier_post((unsigned*)(F.ctl + CW_BAR), F.MISC + 8, F.tid);
#define GRID_BAR() do { if (N_LAUNCHES == 1) { REFRESH(); xcd_barrier(bar, F.tid); } } while (0)
    const int lo = args.ph_lo, hi = args.ph_hi;
#define IN(k) (lo <= (k) && (k) < hi)
#define SEAM(k) do { if (IN(k) && IN((k) + 1)) GRID_BAR(); } while (0)
    bf16* segs = WSP(bf16, WS_B);
    static_assert(WS_C == WS_B + (size_t)3 * M * 512 * 2, "segments contiguous");
    bf16* ga = WSP(bf16, WS_D); bf16* gm = ga + (size_t)M * 1024;
    bf16* ya = WSP(bf16, WS_B); bf16* ym = WSP(bf16, WS_C) + (size_t)3 * M * 512;
    bf16* P1 = WSP(bf16, WS_C); bf16* merged = WSP(bf16, WS_A);
    bf16* x1b = WSP(bf16, WS_B + 16 * MiB); bf16* hid = WSP(bf16, WS_HID);

#ifndef PROBE_DUP
#define PROBE_DUP -1
#endif
#define DUP(k) (PROBE_DUP == (k))
    bf16* dummy = (bf16*)((unsigned char*)F.out + 50 * MiB);
    if (IN(0)) { p0_prologue(F); if (DUP(0)) { __syncthreads(); p0_prologue(F); } } SEAM(0);
    REFRESH(); if (IN(1)) { gate_prep(F);
        pg8::Gemm g{WSP(bf16, WS_A), WSP(bf16, WS_WIN), M, NIN, D}; pg8::StaticOrder S; S.init(M, NIN, F.G, (int)blockIdx.x);
        pg8::EpiIn E{segs, ga, C2, M, (float*)(F.ctl + CW_KSUM)};
        pg8::gemm_phase<pg8::EpiIn, pg8::StaticOrder, PG8_ALIGN, PG8_SP2>(F.lds + RING_OFF, g, S, E, F.tid);
        if (DUP(1)) pg8::gemm_phase<pg8::EpiIn, pg8::StaticOrder, PG8_ALIGN, PG8_SP2>(F.lds + RING_OFF, g, S, E, F.tid); } SEAM(1);
    REFRESH(); if (IN(2)) { p2_gating(F, true); if (DUP(20)) p2_gating(F, false); REFRESH(); p2_cloc(F); if (DUP(21)) p2_cloc(F); } SEAM(2);
    REFRESH(); if (IN(3)) { p3_scan(F); REFRESH(); p3_attn_selected(F); if (DUP(31)) p3_attn_selected(F); } SEAM(3);
    REFRESH(); if (IN(4)) { if (DUP(40)) p4_attn_own(F, dummy, 8191); p4_attn_own(F, WSP(bf16, WS_B), M - 1); REFRESH(); if (DUP(41)) p4_mlstm_out(F, dummy, 8191); p4_mlstm_out(F, ym, M - 1); } SEAM(4);
    REFRESH(); if (IN(5)) { pg8::Gemm g{ya, WSP(bf16, WS_WA), M, D, AW}; pg8::StaticOrder S; S.init(M, D, F.G, (int)blockIdx.x);
        pg8::EpiGate<0> E{ga, nullptr, P1};
        pg8::gemm_phase<pg8::EpiGate<0>, pg8::StaticOrder, PG8_ALIGN, PG8_SP2>(F.lds + RING_OFF, g, S, E, F.tid);
        if (DUP(5)) pg8::gemm_phase<pg8::EpiGate<0>, pg8::StaticOrder, PG8_ALIGN, PG8_SP2>(F.lds + RING_OFF, g, S, E, F.tid); } SEAM(5);
    REFRESH(); if (IN(6)) { pg8::Gemm g{ym, WSP(bf16, WS_WM), M, D, MW}; pg8::StaticOrder S; S.init(M, D, F.G, (int)blockIdx.x);
        pg8::EpiGate<1> E{gm, P1, merged};
        pg8::gemm_phase<pg8::EpiGate<1>, pg8::StaticOrder, PG8_ALIGN, PG8_SP2>(F.lds + RING_OFF, g, S, E, F.tid); } SEAM(6);
    REFRESH(); if (IN(7)) { pg8::Gemm g{merged, WSP(bf16, WS_WO), M, D, D}; pg8::StaticOrder S; S.init(M, D, F.G, (int)blockIdx.x);
        pg8::EpiRes<true> E{IN_X, F.out, x1b, WSP(float, MS_SSQ1)};
        pg8::gemm_phase<pg8::EpiRes<true>, pg8::StaticOrder, PG8_ALIGN, PG8_SP2>(F.lds + RING_OFF, g, S, E, F.tid);
        if (DUP(7)) pg8::gemm_phase<pg8::EpiRes<true>, pg8::StaticOrder, PG8_ALIGN, PG8_SP2>(F.lds + RING_OFF, g, S, E, F.tid); } SEAM(7);
    REFRESH(); if (IN(8)) { pg8::Gemm g{x1b, WSP(bf16, WS_WGU), M, NIN, D}; pg8::StaticOrder S; S.init(M, NIN, F.G, (int)blockIdx.x);
        pg8::EpiSwiGLU E{WSP(float, MS_SSQ1), hid, FF, EPS};
        pg8::gemm_phase<pg8::EpiSwiGLU, pg8::StaticOrder, PG8_ALIGN, PG8_SP2>(F.lds + RING_OFF, g, S, E, F.tid);
        if (DUP(8)) pg8::gemm_phase<pg8::EpiSwiGLU, pg8::StaticOrder, PG8_ALIGN, PG8_SP2>(F.lds + RING_OFF, g, S, E, F.tid); } SEAM(8);
    REFRESH(); if (IN(9)) { pg8::Gemm g{hid, WSP(bf16, WS_WD), M, D, FF}; pg8::StaticOrder S; S.init(M, D, F.G, (int)blockIdx.x);
        if (DUP(9)) { pg8::EpiRes<false> E0{F.out, (float*)WSP(bf16, WS_A), nullptr, WSP(float, MS_SSQ2)}; pg8::gemm_phase<pg8::EpiRes<false>, pg8::StaticOrder, PG8_ALIGN, PG8_SP2>(F.lds + RING_OFF, g, S, E0, F.tid); }
        pg8::EpiRes<false> E{F.out, F.out, nullptr, WSP(float, MS_SSQ2)};
        pg8::gemm_phase<pg8::EpiRes<false>, pg8::StaticOrder, PG8_ALIGN, PG8_SP2>(F.lds + RING_OFF, g, S, E, F.tid); } SEAM(9);
    REFRESH(); if (IN(10)) { p10_final_norm(F); }
#undef IN
#undef SEAM
}

extern "C" void kernel_launch(void* const* d_in, const int* in_sizes, int n_in, void* d_out, int out_size, void* d_ws, size_t ws_size, hipStream_t stream) {
    static int grid = 0;
    if (grid == 0) {
        if (n_in != 15 || in_sizes[0] != M * D || out_size != M * D || ws_size < WS_END) { fprintf(stderr, "kernel_launch: unexpected shapes: n_in %d in0 %d out %d ws %zu\n", n_in, n_in > 0 ? in_sizes[0] : -1, out_size, ws_size); grid = -1; return; }
        int dev = 0, cus = 0, per_cu = 0;
        if (hipGetDevice(&dev) != hipSuccess || hipDeviceGetAttribute(&cus, hipDeviceAttributeMultiprocessorCount, dev) != hipSuccess) { grid = -1; return; }
        if (hipFuncSetAttribute((const void*)mk_fwd, hipFuncAttributeMaxDynamicSharedMemorySize, LDS_BYTES) != hipSuccess) { fprintf(stderr, "kernel_launch: hipFuncSetAttribute failed\n"); grid = -1; return; }
        if (hipOccupancyMaxActiveBlocksPerMultiprocessor(&per_cu, (const void*)mk_fwd, NWAVES * 64, LDS_BYTES) != hipSuccess || per_cu < 1) { fprintf(stderr, "kernel_launch: occupancy query says %d blocks per CU\n", per_cu); per_cu = 1; }
        (void)hipGetLastError();
        grid = cus;
    }
    if (grid < 0) return;
    if (hipMemsetAsync((char*)d_ws + WS_CTL, 0, CTL_ZERO_BYTES, stream) != hipSuccess) { fprintf(stderr, "kernel_launch: memset failed\n"); return; }
    Args a{};
    for (int i = 0; i < 15; ++i) a.in[i] = (const float*)d_in[i];
    a.out = (float*)d_out; a.ws = (unsigned char*)d_ws;
    for (int li = 0; li < N_LAUNCHES; ++li) {
        a.ph_lo = (N_LAUNCHES == 1) ? 0 : li; a.ph_hi = (N_LAUNCHES == 1) ? N_PHASES : li + 1; a.li = li;
        hipLaunchKernelGGL(mk_fwd, dim3(grid), dim3(NWAVES * 64), LDS_BYTES, stream, a);
        const hipError_t le = hipPeekAtLastError();
        if (le != hipSuccess) { fprintf(stderr, "kernel_launch: launch %d failed: %s\n", li, hipGetErrorName(le)); break; }
    }
}
```

```cpp
#include <hip/hip_runtime.h>
#include <cstdio>
#include <cstdint>
namespace pg8 {
#define PG8_LAS __attribute__((address_space(3)))
typedef unsigned short bf16_t;
typedef short bf16x8 __attribute__((ext_vector_type(8)));
typedef float f32x4 __attribute__((ext_vector_type(4)));
typedef unsigned u32x4 __attribute__((ext_vector_type(4)));
constexpr int BM = 256, BK = 64, HALF = 128, HTB = HALF * BK * 2  , STAGE_BYTES = 8 * HTB, NXCD = 8, WGM = 8;

__host__ __device__ __forceinline__ int lds_byte(int r, int c) { const int st = (r >> 4) * 2 + (c >> 5), rr = r & 15, cc = c & 31, ob = rr * 64 + cc * 2; return st * 1024 + (ob ^ (((ob >> 9) & 1) << 5)); }
__host__ __device__ __forceinline__ void stage_rc(int b, int& R, int& C) { const int st = b / 1024, sb = b % 1024, swz = sb ^ (((sb >> 9) & 1) << 5); R = (st >> 1) * 16 + swz / 64; C = (st & 1) * 32 + (swz % 64) / 2; }
__host__ __device__ __forceinline__ int perm32(int rho) { const int n = rho >> 4, i = rho & 15; return 8 * (i >> 2) + 4 * n + (i & 3); }

struct Unit { int pm, pn; };
struct Gemm { const bf16_t* A; const bf16_t* Bt; int M, N, K; };

struct StaticOrder {
    int nM, nN, nwg, G, c;
    __host__ __device__ void init(int M, int N, int G_, int c_) { nM = M / BM; nN = N / BM; nwg = nM * nN; G = G_; c = c_; }
    __host__ __device__ bool next(int i, Unit& u) const {
        const long L = (long)i * G + c; if (L >= nwg) return false;
        int wgid = (int)L; { const int q = nwg / NXCD, r = nwg % NXCD, xcd = wgid % NXCD, off = wgid / NXCD; wgid = (xcd < r ? xcd * (q + 1) : r * (q + 1) + (xcd - r) * q) + off; }
        const int nig = WGM * nN, gid = wgid / nig, fm = gid * WGM, gsz = (nM - fm) < WGM ? (nM - fm) : WGM;
        u.pm = fm + ((wgid % nig) % gsz); u.pn = (wgid % nig) / gsz; return true;
    }
    __device__ __forceinline__ void a_ready(const Unit&) const {}
    __device__ __forceinline__ void done(const Unit&) const {}
};

__device__ __forceinline__ unsigned cvt_pk_bf16(float lo, float hi) { unsigned r; asm volatile("v_cvt_pk_bf16_f32 %0, %1, %2" : "=v"(r) : "v"(lo), "v"(hi)); return r; }
typedef float f32x2 __attribute__((ext_vector_type(2)));
template <class Epi, class Sched, bool ALIGN_EPI = false, bool SP2 = false>
__device__ __forceinline__ void gemm_phase(PG8_LAS unsigned char* lds, const Gemm g, const Sched& S, const Epi& E, const int tid) {
    const int wid = __builtin_amdgcn_readfirstlane(tid >> 6), lane = tid & 63, wr = wid >> 2, wc = wid & 3, fr = lane & 15, fq = lane >> 4;
    const int K = g.K, nt = K / BK;
    unsigned voffA[2], voffB[2];
#pragma unroll
    for (int i = 0; i < 2; ++i) { int R, C; stage_rc(tid * 16 + i * 8192, R, C); const int Rb = Epi::PERM ? ((R & ~31) + perm32(R & 31)) : R;
        voffA[i] = (unsigned)(R * K + C) * 2u; voffB[i] = (unsigned)(Rb * K + C) * 2u; }
    const size_t kstep = (size_t)(BK * 2);
    const size_t hstep = (size_t)HALF * K * 2;
    const size_t tstep = 2 * hstep;
    const unsigned ldsw = (unsigned)wid * 1024u;
    const int aoff = lds_byte(wr * 64 + fr, fq * 8), boff = lds_byte(wc * 32 + fr, fq * 8);
#define PG8_SA(b, h) (((b) * 2 + (h)) * HTB)
#define PG8_SB(b, h) ((4 + (b) * 2 + (h)) * HTB)
#define PG8_STAGE(bufoff, gbase, voff) do { _Pragma("unroll") for (int _i = 0; _i < 2; ++_i) \
        __builtin_amdgcn_global_load_lds((const unsigned*)((const char*)(gbase) + (voff)[_i]), (PG8_LAS unsigned*)(lds + (bufoff) + ldsw + _i * 8192), 16, 0, 0); } while (0)
#define PG8_LDA(dst, b, h) do { _Pragma("unroll") for (int m = 0; m < 4; ++m) _Pragma("unroll") for (int k = 0; k < 2; ++k) dst[m][k] = *(const PG8_LAS bf16x8*)(lds + PG8_SA(b, h) + aoff + m * 2048 + k * 1024); } while (0)
#define PG8_LDB(dst, b, h) do { _Pragma("unroll") for (int n = 0; n < 2; ++n) _Pragma("unroll") for (int k = 0; k < 2; ++k) dst[n][k] = *(const PG8_LAS bf16x8*)(lds + PG8_SB(b, h) + boff + n * 2048 + k * 1024); } while (0)
#define PG8_MMA(ai, bj, At, Bt) do { __builtin_amdgcn_s_setprio(1); _Pragma("unroll") for (int m = 0; m < 4; ++m) _Pragma("unroll") for (int n = 0; n < 2; ++n) _Pragma("unroll") for (int k = 0; k < 2; ++k) \
        acc[ai][bj][m][n] = __builtin_amdgcn_mfma_f32_16x16x32_bf16(Bt[n][k], At[m][k], acc[ai][bj][m][n], 0, 0, 0); __builtin_amdgcn_s_setprio(0); } while (0)
#define PG8_WAIT_V(n) asm volatile("s_waitcnt vmcnt(" #n ")" ::: "memory")
#define PG8_WAIT_L(n) asm volatile("s_waitcnt lgkmcnt(" #n ")" ::: "memory")
#define PG8_BAR __builtin_amdgcn_s_barrier()
#define PG8_SCHED __builtin_amdgcn_sched_barrier(0)
    Unit cur, nxt; int ui = 0;
    if (!S.next(0, cur)) return;
    f32x4 acc[2][2][4][2];
#pragma unroll
    for (int a = 0; a < 2; ++a)
#pragma unroll
        for (int b = 0; b < 2; ++b)
#pragma unroll
            for (int m = 0; m < 4; ++m)
#pragma unroll
                for (int n = 0; n < 2; ++n) acc[a][b][m][n] = (f32x4){0.f, 0.f, 0.f, 0.f};
    bf16x8 At[4][2], B0[2][2], B1[2][2];
    const char* cA = (const char*)g.A + (size_t)cur.pm * tstep; const char* cB = (const char*)g.Bt + (size_t)cur.pn * tstep;
    S.a_ready(cur);
    if constexpr (SP2) {
        PG8_STAGE(PG8_SB(0, 0), cB, voffB); PG8_STAGE(PG8_SB(0, 1), cB + hstep, voffB); PG8_STAGE(PG8_SA(0, 0), cA, voffA); PG8_STAGE(PG8_SA(0, 1), cA + hstep, voffA);
        if (wr == 1) PG8_BAR;
        PG8_WAIT_V(2); PG8_BAR;
        PG8_STAGE(PG8_SB(1, 0), cB + kstep, voffB); PG8_STAGE(PG8_SA(1, 0), cA + kstep, voffA); PG8_STAGE(PG8_SB(1, 1), cB + hstep + kstep, voffB);
        PG8_WAIT_V(6); PG8_BAR;
    } else {
        PG8_STAGE(PG8_SB(0, 0), cB, voffB); PG8_STAGE(PG8_SA(0, 0), cA, voffA); PG8_STAGE(PG8_SB(0, 1), cB + hstep, voffB); PG8_STAGE(PG8_SA(0, 1), cA + hstep, voffA);
        if (wr == 1) PG8_BAR;
        PG8_WAIT_V(4); PG8_BAR;
        PG8_STAGE(PG8_SB(1, 0), cB + kstep, voffB); PG8_STAGE(PG8_SA(1, 0), cA + kstep, voffA); PG8_STAGE(PG8_SB(1, 1), cB + hstep + kstep, voffB);
        PG8_WAIT_V(6); PG8_BAR;
    }
    for (;;) {
        const bool has_next = S.next(ui + 1, nxt);
        const char* nA = has_next ? (const char*)g.A + (size_t)nxt.pm * tstep : cA; const char* nB = has_next ? (const char*)g.Bt + (size_t)nxt.pn * tstep : cB;
        for (int t = 0; t < nt; t += 2) {
            const bool last = (t == nt - 2);
            const char* a1 = cA + (size_t)(t + 1) * kstep;
            const char* a2 = last ? nA : cA + (size_t)(t + 2) * kstep; const char* b2 = last ? nB : cB + (size_t)(t + 2) * kstep;
            const char* a3 = a2 + kstep; const char* b3 = b2 + kstep;
            if (last && has_next) S.a_ready(nxt);
            if constexpr (SP2) {
            PG8_LDB(B0, 0, 0); PG8_LDB(B1, 0, 1); PG8_SCHED; PG8_LDA(At, 0, 0); PG8_STAGE(PG8_SA(1, 1), a1 + hstep, voffA);
            PG8_WAIT_V(8); PG8_WAIT_L(0); PG8_BAR; PG8_MMA(0, 0, At, B0); PG8_MMA(0, 1, At, B1); PG8_BAR; PG8_SCHED;
            PG8_LDA(At, 0, 1); PG8_STAGE(PG8_SB(0, 0), b2, voffB); PG8_STAGE(PG8_SB(0, 1), b2 + hstep, voffB); PG8_STAGE(PG8_SA(0, 0), a2, voffA);
            PG8_WAIT_V(8); PG8_WAIT_L(0); PG8_BAR; PG8_MMA(1, 0, At, B0); PG8_MMA(1, 1, At, B1); PG8_BAR; PG8_SCHED;
            PG8_LDB(B0, 1, 0); PG8_LDB(B1, 1, 1); PG8_SCHED; PG8_LDA(At, 1, 0); PG8_STAGE(PG8_SA(0, 1), a2 + hstep, voffA);
            PG8_WAIT_V(8); PG8_WAIT_L(0); PG8_BAR; PG8_MMA(0, 0, At, B0); PG8_MMA(0, 1, At, B1); PG8_BAR; PG8_SCHED;
            PG8_LDA(At, 1, 1); PG8_STAGE(PG8_SB(1, 0), b3, voffB); PG8_STAGE(PG8_SB(1, 1), b3 + hstep, voffB); PG8_STAGE(PG8_SA(1, 0), a3, voffA);
            PG8_WAIT_V(8); PG8_WAIT_L(0); PG8_BAR; PG8_MMA(1, 0, At, B0); PG8_MMA(1, 1, At, B1); PG8_BAR; PG8_SCHED;
            } else {
            PG8_LDB(B0, 0, 0); PG8_SCHED; PG8_LDA(At, 0, 0); PG8_STAGE(PG8_SA(1, 1), a1 + hstep, voffA);
            PG8_WAIT_L(8); PG8_BAR; PG8_WAIT_L(0); PG8_MMA(0, 0, At, B0); PG8_BAR; PG8_SCHED;
            PG8_LDB(B1, 0, 1); PG8_STAGE(PG8_SB(0, 0), b2, voffB);
            PG8_BAR; PG8_WAIT_L(0); PG8_MMA(0, 1, At, B1); PG8_BAR;
            PG8_LDA(At, 0, 1); PG8_STAGE(PG8_SA(0, 0), a2, voffA);
            PG8_BAR; PG8_WAIT_L(0); PG8_MMA(1, 0, At, B0); PG8_BAR; PG8_SCHED;
            PG8_STAGE(PG8_SB(0, 1), b2 + hstep, voffB);
            PG8_WAIT_V(6); PG8_BAR; PG8_MMA(1, 1, At, B1); PG8_BAR;
            PG8_LDB(B0, 1, 0); PG8_SCHED; PG8_LDA(At, 1, 0); PG8_STAGE(PG8_SA(0, 1), a2 + hstep, voffA);
            PG8_WAIT_L(8); PG8_BAR; PG8_WAIT_L(0); PG8_MMA(0, 0, At, B0); PG8_BAR; PG8_SCHED;
            PG8_LDB(B1, 1, 1); PG8_STAGE(PG8_SB(1, 0), b3, voffB);
            PG8_BAR; PG8_WAIT_L(0); PG8_MMA(0, 1, At, B1); PG8_BAR;
            PG8_LDA(At, 1, 1); PG8_STAGE(PG8_SA(1, 0), a3, voffA);
            PG8_BAR; PG8_WAIT_L(0); PG8_MMA(1, 0, At, B0); PG8_BAR; PG8_SCHED;
            PG8_STAGE(PG8_SB(1, 1), b3 + hstep, voffB);
            PG8_WAIT_V(6); PG8_BAR; PG8_MMA(1, 1, At, B1); PG8_BAR;
            }
        }
        if constexpr (ALIGN_EPI) { if (wr == 0) PG8_BAR; }
        if constexpr (!Epi::AFTER_DRAIN) { E(acc, cur, wr, wc, fr, fq); S.done(cur); }
        if (!has_next) break;
#pragma unroll
        for (int a = 0; a < 2; ++a)
#pragma unroll
            for (int b = 0; b < 2; ++b)
#pragma unroll
                for (int m = 0; m < 4; ++m)
#pragma unroll
                    for (int n = 0; n < 2; ++n) acc[a][b][m][n] = (f32x4){0.f, 0.f, 0.f, 0.f};
        cur = nxt; cA = nA; cB = nB; ++ui;
        if constexpr (ALIGN_EPI) { if (wr == 1) PG8_BAR; }
    }
    PG8_WAIT_V(0);
    if constexpr (!ALIGN_EPI) { if (wr == 0) PG8_BAR; }
    PG8_BAR;
    if constexpr (Epi::AFTER_DRAIN) { E.fused(acc, cur, wr, wc, fr, fq, lds, wid, lane); S.done(cur); }
#undef PG8_SA
#undef PG8_SB
#undef PG8_STAGE
#undef PG8_LDA
#undef PG8_LDB
#undef PG8_MMA
#undef PG8_WAIT_V
#undef PG8_WAIT_L
#undef PG8_BAR
#undef PG8_SCHED
}
}

#ifndef PG8_SP2
#define PG8_SP2 true
#endif
#ifndef PG8_ALIGN
#define PG8_ALIGN true
#endif
namespace pg8 {
__device__ __forceinline__ float sigmoidf_fast(float x) { return __builtin_amdgcn_rcpf(1.0f + __builtin_amdgcn_exp2f(-1.4426950408889634f * x)); }
__device__ __forceinline__ float bflo(unsigned w) { return __uint_as_float(w << 16); }
__device__ __forceinline__ float bfhi(unsigned w) { return __uint_as_float(w & 0xffff0000u); }

struct EpiIn {
    static constexpr bool PERM = true, AFTER_DRAIN = false;
    bf16_t* seg; bf16_t* gates; float qscale; int Mrows; float* ksum;
    __device__ __forceinline__ void operator()(const f32x4 (&acc)[2][2][4][2], const Unit& u, int wr, int wc, int fr, int fq) const {
        const int pn = u.pn;
        if (pn >= 2 && pn < 6) {
            const bool isk = pn < 4; bf16_t* base = seg + (size_t)(isk ? 1 : 2) * Mrows * 512; const int j = u.pm;
            float cs[2][8];
#pragma unroll
            for (int bj = 0; bj < 2; ++bj)
#pragma unroll
                for (int e = 0; e < 8; ++e) cs[bj][e] = 0.f;
#pragma unroll
            for (int bj = 0; bj < 2; ++bj) { const int cc = (pn & 1) * 256 + bj * HALF + wc * 32, h = cc >> 6;
                bf16_t* tb = base + (size_t)(h * 64 + j) * 16384 + (isk ? (4 * (wc & 1) + fq) * 2048 : (wc & 1) * 8192 + 8 * fq);
#pragma unroll
                for (int ai = 0; ai < 2; ++ai)
#pragma unroll
                    for (int m = 0; m < 4; ++m) { const int key = ai * HALF + wr * 64 + m * 16 + fr; const f32x4 v0 = acc[ai][bj][m][0], v1 = acc[ai][bj][m][1];
                        u32x4 w; w.x = cvt_pk_bf16(v0[0], v0[1]); w.y = cvt_pk_bf16(v0[2], v0[3]); w.z = cvt_pk_bf16(v1[0], v1[1]); w.w = cvt_pk_bf16(v1[2], v1[3]);
                        *(u32x4*)(tb + (size_t)key * (isk ? 8 : 32)) = w;
                        if (isk) {
#pragma unroll
                            for (int e = 0; e < 4; ++e) { cs[bj][e] += v0[e]; cs[bj][4 + e] += v1[e]; } } } }
            if (isk) {
#pragma unroll
                for (int bj = 0; bj < 2; ++bj)
#pragma unroll
                    for (int e = 0; e < 8; ++e) { float v = cs[bj][e]; v += __shfl_xor(v, 1); v += __shfl_xor(v, 2); v += __shfl_xor(v, 4); v += __shfl_xor(v, 8); cs[bj][e] = v; }
                if (fr == 0) {
#pragma unroll
                    for (int bj = 0; bj < 2; ++bj) { const int cc = (pn & 1) * 256 + bj * HALF + wc * 32 + 8 * fq;
#pragma unroll
                        for (int e = 0; e < 8; ++e) atomicAdd(ksum + ((size_t)((cc >> 6) * 64 + j)) * 64 + (cc & 63) + e, cs[bj][e]); } }
            }
            return;
        }
        bf16_t* base; int ldc, colt, mode;
        if (pn < 14) { const int s = pn >> 1; base = seg + (size_t)s * Mrows * 512; ldc = 512; colt = (pn & 1) * 256; mode = (s == 0) ? 1 : 0; }
        else { const int g = (pn - 14) >> 2; base = gates + (size_t)g * Mrows * 1024; ldc = 1024; colt = ((pn - 14) & 3) * 256; mode = 2; }
        const int row0 = u.pm * BM + wr * 64 + fr, col0 = colt + wc * 32 + 8 * fq;
#pragma unroll
        for (int ai = 0; ai < 2; ++ai)
#pragma unroll
            for (int m = 0; m < 4; ++m) { bf16_t* rowp = base + (size_t)(row0 + ai * HALF + m * 16) * ldc + col0;
#pragma unroll
                for (int bj = 0; bj < 2; ++bj) { f32x4 v0 = acc[ai][bj][m][0], v1 = acc[ai][bj][m][1];
                    if (mode == 1) { v0 = v0 * qscale; v1 = v1 * qscale; }
                    else if (mode == 2) {
#pragma unroll
                        for (int e = 0; e < 4; ++e) { v0[e] = sigmoidf_fast(v0[e]); v1[e] = sigmoidf_fast(v1[e]); } }
                    u32x4 w; w.x = cvt_pk_bf16(v0[0], v0[1]); w.y = cvt_pk_bf16(v0[2], v0[3]); w.z = cvt_pk_bf16(v1[0], v1[1]); w.w = cvt_pk_bf16(v1[2], v1[3]);
                    *(u32x4*)(rowp + bj * HALF) = w; } }
    }
};
template <int MODE> struct EpiGate {
    static constexpr bool PERM = true, AFTER_DRAIN = false;
    const bf16_t* G; const bf16_t* P; bf16_t* O;
    __device__ __forceinline__ void operator()(const f32x4 (&acc)[2][2][4][2], const Unit& u, int wr, int wc, int fr, int fq) const {
        const int row0 = u.pm * BM + wr * 64 + fr, col0 = u.pn * BM + wc * 32 + 8 * fq;
#pragma unroll
        for (int ai = 0; ai < 2; ++ai)
#pragma unroll
            for (int m = 0; m < 4; ++m) { const size_t off = (size_t)(row0 + ai * HALF + m * 16) * 1024 + col0;
#pragma unroll
                for (int bj = 0; bj < 2; ++bj) { const f32x4 v0 = acc[ai][bj][m][0], v1 = acc[ai][bj][m][1];
                    const u32x4 g = *(const u32x4*)(G + off + bj * HALF);
                    float r[8] = { bflo(g.x) * v0[0], bfhi(g.x) * v0[1], bflo(g.y) * v0[2], bfhi(g.y) * v0[3], bflo(g.z) * v1[0], bfhi(g.z) * v1[1], bflo(g.w) * v1[2], bfhi(g.w) * v1[3] };
                    if (MODE == 1) { const u32x4 p = *(const u32x4*)(P + off + bj * HALF);
                        r[0] += bflo(p.x); r[1] += bfhi(p.x); r[2] += bflo(p.y); r[3] += bfhi(p.y); r[4] += bflo(p.z); r[5] += bfhi(p.z); r[6] += bflo(p.w); r[7] += bfhi(p.w); }
                    u32x4 w; w.x = cvt_pk_bf16(r[0], r[1]); w.y = cvt_pk_bf16(r[2], r[3]); w.z = cvt_pk_bf16(r[4], r[5]); w.w = cvt_pk_bf16(r[6], r[7]);
                    *(u32x4*)(O + off + bj * HALF) = w; } }
    }
};
template <bool WITH_BF> struct EpiRes {
    static constexpr bool PERM = false, AFTER_DRAIN = false;
    const float* base; float* out; bf16_t* xb; float* ssq;
    __device__ __forceinline__ void operator()(const f32x4 (&acc)[2][2][4][2], const Unit& u, int wr, int wc, int fr, int fq) const {
        typedef unsigned u32x2v __attribute__((ext_vector_type(2)));
        const int row0 = u.pm * BM + wr * 64 + fr, col0 = u.pn * BM + wc * 32 + 4 * fq;
#pragma unroll
        for (int ai = 0; ai < 2; ++ai)
#pragma unroll
            for (int m = 0; m < 4; ++m) { const int row = row0 + ai * HALF + m * 16; const size_t off = (size_t)row * 1024 + col0; float ss = 0.f;
#pragma unroll
                for (int bj = 0; bj < 2; ++bj)
#pragma unroll
                    for (int n = 0; n < 2; ++n) { const size_t o2 = off + bj * HALF + n * 16; const f32x4 o = *(const f32x4*)(base + o2) + acc[ai][bj][m][n];
                        *(f32x4*)(out + o2) = o; ss += (o[0] * o[0] + o[1] * o[1]) + (o[2] * o[2] + o[3] * o[3]);
                        if (WITH_BF) { u32x2v w; w.x = cvt_pk_bf16(o[0], o[1]); w.y = cvt_pk_bf16(o[2], o[3]); *(u32x2v*)(xb + o2) = w; } }
                ss += __shfl_xor(ss, 16); ss += __shfl_xor(ss, 32);
                if (fq == 0) ssq[(size_t)row * 16 + u.pn * 4 + wc] = ss; }
    }
};
struct EpiSwiGLU {
    static constexpr bool PERM = true, AFTER_DRAIN = false;
    const float* ssq; bf16_t* Hd; int ldh; float eps;
    __device__ __forceinline__ void operator()(const f32x4 (&acc)[2][2][4][2], const Unit& u, int wr, int wc, int fr, int fq) const {
        const int row0 = u.pm * BM + wr * 64 + fr, col0 = u.pn * HALF + wc * 32 + 8 * fq;
#pragma unroll
        for (int ai = 0; ai < 2; ++ai)
#pragma unroll
            for (int m = 0; m < 4; ++m) { const int row = row0 + ai * HALF + m * 16; const f32x4* sp = (const f32x4*)(ssq + (size_t)row * 16);
                const f32x4 s0 = sp[0], s1 = sp[1], s2 = sp[2], s3 = sp[3];
                const float tot = ((s0[0] + s0[1]) + (s0[2] + s0[3])) + ((s1[0] + s1[1]) + (s1[2] + s1[3])) + ((s2[0] + s2[1]) + (s2[2] + s2[3])) + ((s3[0] + s3[1]) + (s3[2] + s3[3]));
                const float rs = 1.0f / sqrtf(tot * (1.0f / 1024.0f) + eps);
                float r[8];
#pragma unroll
                for (int n = 0; n < 2; ++n)
#pragma unroll
                    for (int e = 0; e < 4; ++e) { const float g = acc[ai][0][m][n][e] * rs, up = acc[ai][1][m][n][e] * rs; r[n * 4 + e] = g * sigmoidf_fast(g) * up; }
                u32x4 w; w.x = cvt_pk_bf16(r[0], r[1]); w.y = cvt_pk_bf16(r[2], r[3]); w.z = cvt_pk_bf16(r[4], r[5]); w.w = cvt_pk_bf16(r[6], r[7]);
                *(u32x4*)(Hd + (size_t)row * ldh + col0) = w; }
    }
};
}
#define GAS __attribute__((address_space(1)))
#define LAS __attribute__((address_space(3)))
typedef unsigned short bf16;
typedef unsigned v4u __attribute__((ext_vector_type(4)));
typedef float f32x4 __attribute__((ext_vector_type(4)));
typedef short bf16x8 __attribute__((ext_vector_type(8)));
typedef GAS unsigned gu32;
typedef GAS unsigned long long gu64;
#define RLX_AGENT __ATOMIC_RELAXED, __HIP_MEMORY_SCOPE_AGENT
#define LDS_WAIT() asm volatile("s_waitcnt lgkmcnt(0)" ::: "memory")
#define VM_WAIT() asm volatile("s_waitcnt vmcnt(0)" ::: "memory")
__device__ __forceinline__ unsigned long long rt() { return __builtin_amdgcn_s_memrealtime(); }
__device__ __forceinline__ unsigned f2bf(float f) { unsigned u = __builtin_bit_cast(unsigned, f); return (u + 0x7fffu + ((u >> 16) & 1u)) >> 16; }
__device__ __forceinline__ unsigned pk2(float lo, float hi) { return f2bf(lo) | (f2bf(hi) << 16); }

#define XB_TMO      128
#define XB_XCNT(j)  (256  + 64 * (j))
#define XB_XSUB(j)  (1280 + 64 * (j))
#define XB_XGEN(j)  (2304 + 64 * (j))
#define XB_TOP      3328
#define XB_TOPGEN   3392
#define XCD_BAR_WORDS 3456
#define XB_SPIN_CAP (1u << 18)

__device__ __forceinline__ unsigned xb_ld(unsigned* p)              { return __hip_atomic_load(p, __ATOMIC_RELAXED, __HIP_MEMORY_SCOPE_AGENT); }
__device__ __forceinline__ unsigned xb_add(unsigned* p, unsigned v) { return __hip_atomic_fetch_add(p, v, __ATOMIC_RELAXED, __HIP_MEMORY_SCOPE_AGENT); }
__device__ __forceinline__ unsigned xb_xcc_id() { return (unsigned)__builtin_amdgcn_s_getreg((3 << 11) | 20) & 0xFu; }
#define XB_SPIN(cond, bar) do { unsigned _sp = 0; while (cond) { __builtin_amdgcn_s_sleep(1); \
    if ((++_sp & 255u) == 0u) { if (xb_ld(&(bar)[XB_TMO])) break; if (_sp > XB_SPIN_CAP) { atomicAdd(&(bar)[XB_TMO], 1u); break; } } } } while (0)

struct XcdBarrier {
    unsigned* bar; unsigned x;
    volatile LAS unsigned* st;
};

__device__ __forceinline__ XcdBarrier xcd_barrier_post(unsigned* bar, volatile LAS unsigned* st, const int tid_) {
    XcdBarrier b; b.bar = bar; b.x = xb_xcc_id(); b.st = st;
    if (tid_ == 0) (void)xb_add(&bar[XB_XCNT(b.x)], 1u);
    return b;
}
__device__ __forceinline__ void xcd_barrier_complete(unsigned* bar, unsigned x, unsigned& nloc, unsigned& nx) {
    const unsigned G = gridDim.x * gridDim.y * gridDim.z;
    unsigned sum, cnt, mine, sp = 0u;
    for (;;) {
        sum = 0u; cnt = 0u; mine = 0u;
#pragma unroll
        for (unsigned j = 0; j < 16; ++j) { const unsigned c = xb_ld(&bar[XB_XCNT(j)]); sum += c; cnt += (c > 0u) ? 1u : 0u; mine = (j == x) ? c : mine; }
        if (sum == G) break;
        __builtin_amdgcn_s_sleep(1);
        if ((++sp & 255u) == 0u) { if (xb_ld(&bar[XB_TMO])) break; if (sp > XB_SPIN_CAP) { atomicAdd(&bar[XB_TMO], 1u); break; } }
    }
    nloc = mine > 0u ? mine : 1u; nx = cnt > 0u ? cnt : 1u;
}

__device__ __forceinline__ void xcd_barrier(const XcdBarrier& b, const int tid_) {
    asm volatile("s_waitcnt vmcnt(0)" ::: "memory");
    __syncthreads();
    if (tid_ == 0) {
        unsigned* bar = b.bar;
        __builtin_amdgcn_s_waitcnt(0);
        unsigned nloc = b.st[0], nx = b.st[1];
        if (nloc == 0u) { xcd_barrier_complete(bar, b.x, nloc, nx); b.st[0] = nloc; b.st[1] = nx; }
        const unsigned old = xb_add(&bar[XB_XSUB(b.x)], 1u);
        const unsigned gen = old / nloc;
        if (old + 1u == (gen + 1u) * nloc) {
            __builtin_amdgcn_fence(__ATOMIC_RELEASE, "agent");
            asm volatile("s_waitcnt vmcnt(0)" ::: "memory");
            const unsigned og = xb_add(&bar[XB_TOP], 1u);
            const unsigned tg = og / nx;
            if (og + 1u == (tg + 1u) * nx) xb_add(&bar[XB_TOPGEN], 1u);
            else XB_SPIN(xb_ld(&bar[XB_TOPGEN]) == tg, bar);
            __builtin_amdgcn_fence(__ATOMIC_ACQUIRE, "agent");
            xb_add(&bar[XB_XGEN(b.x)], 1u);
            asm volatile("s_waitcnt vmcnt(0)" ::: "memory");
        } else {
            XB_SPIN(xb_ld(&bar[XB_XGEN(b.x)]) == gen, bar);
            __builtin_amdgcn_fence(__ATOMIC_ACQUIRE, "agent");
            asm volatile("s_waitcnt vmcnt(0)" ::: "memory");
        }
    }
    __syncthreads();
}
constexpr int NWAVES = 8;
constexpr int N_PHASES = 11;
#ifndef MK_N_LAUNCHES
#define MK_N_LAUNCHES 1
#endif
constexpr int N_LAUNCHES = MK_N_LAUNCHES;

constexpr int M = 16384, D = 1024, NIN = 5632, FF = 2816, INW = 5640;
constexpr int AH = 8, AD = 64, AW = 512, MH = 4, MD = 128, MW = 512, NBLK = 64, NCH = 128, CL = 128;
constexpr float EPS = 1e-6f;
constexpr float LOG2E = 1.4426950408889634f;
constexpr float C2 = 0.125f * LOG2E;

constexpr size_t MiB = 1u << 20;
constexpr size_t WS_CTL = 0, CTL_ZERO_BYTES = 1 * MiB;
constexpr size_t WS_WIN = 1 * MiB;
constexpr size_t WS_WGU = 12 * MiB;
constexpr size_t WS_WD = 23 * MiB;
constexpr size_t WS_WO = 29 * MiB;
constexpr size_t WS_WA = 31 * MiB;
constexpr size_t WS_WM = 32 * MiB;
constexpr size_t WS_MISC = 33 * MiB;
constexpr size_t MS_LOGI = WS_MISC;
constexpr size_t MS_LOGF = MS_LOGI + 256 * 1024;
constexpr size_t MS_BCUM = MS_LOGF + 256 * 1024;
constexpr size_t MS_KMEAN = MS_BCUM + 256 * 1024;
constexpr size_t MS_SEL = MS_KMEAN + 128 * 1024;
constexpr size_t MS_CHS = MS_SEL + 512 * 1024;
constexpr size_t MS_NST = MS_CHS + 64 * 1024;
constexpr size_t MS_SSQ1 = MS_NST + 256 * 1024;
constexpr size_t MS_SSQ2 = MS_SSQ1 + 1024 * 1024;
constexpr size_t MS_MASK = MS_SSQ2 + 1024 * 1024;
constexpr size_t MASK_STRIDE = (size_t)8 * 256 * 64;
static_assert(MS_MASK + 3 * 1024 * 1024 <= 40 * MiB, "misc");
constexpr size_t WS_A = 40 * MiB;
constexpr size_t WS_B = 72 * MiB;
constexpr size_t WS_C = 120 * MiB;
constexpr size_t WS_D = 184 * MiB;
constexpr size_t WS_HID = 120 * MiB;
constexpr size_t WS_END = 256 * MiB;
static_assert(WS_HID + (size_t)M * FF * 2 <= WS_END, "hidden overlay");

constexpr int CW_TMO = 0, CW_CODE = 1, CW_TOT = 2048  , CW_BAR = 4096, CW_KSUM = 65536  ;

constexpr int RING_OFF = 0, RING_BYTES = 131072;
constexpr int LDS_BYTES = 147456;
constexpr int LDSCTL_OFF = LDS_BYTES - 512, MISC_OFF = LDSCTL_OFF + 320;


__device__ __forceinline__ float bf2f(unsigned short v) { return __uint_as_float((unsigned)v << 16); }
__device__ __forceinline__ float blo(unsigned w) { return __uint_as_float(w << 16); }
__device__ __forceinline__ float bhi(unsigned w) { return __uint_as_float(w & 0xffff0000u); }
__device__ __forceinline__ float wave_sum(float v) {
#pragma unroll
    for (int o = 1; o < 64; o <<= 1) v += __shfl_xor(v, o);
    return v;
}
__device__ __forceinline__ float wave_max(float v) {
#pragma unroll
    for (int o = 1; o < 64; o <<= 1) v = fmaxf(v, __shfl_xor(v, o));
    return v;
}
__device__ __forceinline__ float sigm(float x) { return 1.0f / (1.0f + __expf(-x)); }

struct Frame {
    LAS unsigned char* lds;
    volatile LAS unsigned* MISC;
    gu32* ctl;
    int tid, lane, wave, vcu, G;
    float* out; unsigned char* ws;
};
typedef const float* cfptr;
#define INP(k) (((LAS cfptr*)(F.lds + LDSCTL_OFF))[k])
#define IN_X INP(0)
#define IN_MIXG INP(1)
#define IN_WIN INP(2)
#define IN_CONV INP(3)
#define IN_BIG INP(4)
#define IN_BFG INP(5)
#define IN_MNG INP(6)
#define IN_WOA INP(7)
#define IN_WOM INP(8)
#define IN_WO INP(9)
#define IN_FFNG INP(10)
#define IN_WFG INP(11)
#define IN_WFU INP(12)
#define IN_WFD INP(13)
#define IN_FING INP(14)
#define WSP(T, off) ((T*)(F.ws + (off)))

__device__ __forceinline__ void tr_item(const float* W, int ldw, int k0, int n_src0, bf16* WT, int ldt, int dst_row0, const float* kscale, LAS float* scr, int lane) {
#pragma unroll 8
    for (int i = 0; i < 32; ++i) { const int kk = 2 * i + (lane >> 5); float v = W[(size_t)(k0 + kk) * ldw + n_src0 + (lane & 31)]; if (kscale) v *= kscale[k0 + kk]; scr[kk * 33 + (lane & 31)] = v; }
    LDS_WAIT(); asm volatile("" ::: "memory");
    const int c = lane & 7;
#pragma unroll
    for (int j = 0; j < 4; ++j) { const int n = (lane >> 3) + 8 * j; const LAS float* s = scr + (8 * c) * 33 + n;
        v4u o; o.x = pk2(s[0 * 33], s[1 * 33]); o.y = pk2(s[2 * 33], s[3 * 33]); o.z = pk2(s[4 * 33], s[5 * 33]); o.w = pk2(s[6 * 33], s[7 * 33]);
        *(GAS v4u*)(WT + (size_t)(dst_row0 + n) * ldt + k0 + 8 * c) = o; }
    LDS_WAIT(); asm volatile("" ::: "memory");
}
__device__ __forceinline__ float log_sigmoid(float z) { return fminf(z, 0.f) - log1pf(__expf(-fabsf(z))); }

__device__ __forceinline__ void p0_prologue(Frame& F) {
    const int gw = F.vcu * NWAVES + F.wave, NGW = F.G * NWAVES, lane = F.lane;
    LAS float* gt = (LAS float*)(F.lds + RING_OFF);
    for (int i = F.tid; i < 8192; i += NWAVES * 64) { const int k = i >> 3, c = i & 7; gt[c * 1024 + k] = IN_WIN[(size_t)k * INW + 3584 + c]; }
    __syncthreads();
    LAS float* scr = (LAS float*)(F.lds + RING_OFF + 32768 + F.wave * 8704);
    constexpr int I_IN = 16 * 176, I_GU = 16 * 88, I_D = 44 * 32, I_O = 16 * 32, I_A = 8 * 32;
    constexpr int NITEMS = I_IN + 2 * I_GU + I_D + I_O + 2 * I_A;
    bf16* Win = WSP(bf16, WS_WIN); bf16* Wgu = WSP(bf16, WS_WGU); bf16* Wd = WSP(bf16, WS_WD); bf16* Wo = WSP(bf16, WS_WO); bf16* Wa = WSP(bf16, WS_WA); bf16* Wm = WSP(bf16, WS_WM);
    for (int it = gw; it < NITEMS; it += NGW) {
        int r = it;
        if (r < I_IN) { const int kb = r / 176, nb = r % 176; const int ns = nb < 112 ? 32 * nb : 3592 + 32 * (nb - 112), nd = nb < 112 ? 32 * nb : 3584 + 32 * (nb - 112);
            tr_item(IN_WIN, INW, 64 * kb, ns, Win, D, nd, nullptr, scr, lane); continue; } r -= I_IN;
        if (r < I_GU) { const int kb = r / 88, nb = r % 88; tr_item(IN_WFG, FF, 64 * kb, 32 * nb, Wgu, D, 256 * (nb >> 2) + 32 * (nb & 3), IN_FFNG, scr, lane); continue; } r -= I_GU;
        if (r < I_GU) { const int kb = r / 88, nb = r % 88; tr_item(IN_WFU, FF, 64 * kb, 32 * nb, Wgu, D, 256 * (nb >> 2) + 128 + 32 * (nb & 3), IN_FFNG, scr, lane); continue; } r -= I_GU;
        if (r < I_D) { const int kb = r / 32, nb = r % 32; tr_item(IN_WFD, D, 64 * kb, 32 * nb, Wd, FF, 32 * nb, nullptr, scr, lane); continue; } r -= I_D;
        if (r < I_O) { const int kb = r / 32, nb = r % 32; tr_item(IN_WO, D, 64 * kb, 32 * nb, Wo, D, 32 * nb, nullptr, scr, lane); continue; } r -= I_O;
        if (r < I_A) { const int kb = r / 32, nb = r % 32; tr_item(IN_WOA, D, 64 * kb, 32 * nb, Wa, AW, 32 * nb, nullptr, scr, lane); continue; } r -= I_A;
        { const int kb = r / 32, nb = r % 32; tr_item(IN_WOM, D, 64 * kb, 32 * nb, Wm, MW, 32 * nb, nullptr, scr, lane); }
    }
    bf16* Hn = WSP(bf16, WS_A); float* logi = WSP(float, MS_LOGI); float* logf = WSP(float, MS_LOGF);
    f32x4 gv[4];
#pragma unroll
    for (int j = 0; j < 4; ++j) gv[j] = ((const GAS f32x4*)IN_MIXG)[lane + 64 * j];
    for (int m = gw; m < M; m += NGW) {
        const GAS f32x4* xr = (const GAS f32x4*)(IN_X + (size_t)m * D) + lane;
        f32x4 v[4]; float s = 0.f;
#pragma unroll
        for (int j = 0; j < 4; ++j) { v[j] = xr[64 * j]; s += (v[j].x * v[j].x + v[j].y * v[j].y) + (v[j].z * v[j].z + v[j].w * v[j].w); }
        const float rstd = 1.0f / sqrtf(wave_sum(s) * (1.f / D) + EPS);
#pragma unroll
        for (int j = 0; j < 4; ++j) v[j] = v[j] * rstd * gv[j];
        GAS unsigned long long* o8 = (GAS unsigned long long*)(Hn + (size_t)m * D) + lane;
#pragma unroll
        for (int j = 0; j < 4; ++j) o8[64 * j] = (unsigned long long)pk2(v[j].x, v[j].y) | ((unsigned long long)pk2(v[j].z, v[j].w) << 32);
        float ga[8];
#pragma unroll
        for (int c = 0; c < 8; ++c) { float a = 0.f;
#pragma unroll
            for (int j = 0; j < 4; ++j) { const f32x4 w = *(const LAS f32x4*)(gt + c * 1024 + 4 * lane + 256 * j); a += (v[j].x * w.x + v[j].y * w.y) + (v[j].z * w.z + v[j].w * w.w); }
            ga[c] = wave_sum(a); }
#pragma unroll
        for (int c = 0; c < 4; ++c) { if (lane == c) logi[(size_t)m * 4 + c] = ga[c] + IN_BIG[c]; if (lane == 4 + c) logf[(size_t)m * 4 + c] = log_sigmoid(ga[4 + c] + IN_BFG[c]); }
    }
}

__device__ __forceinline__ float wave_incl_scan(float v, int lane) {
#pragma unroll
    for (int o = 1; o < 64; o <<= 1) { const float t = __shfl_up(v, o); if (lane >= o) v += t; }
    return v;
}
__device__ __forceinline__ void gate_prep(Frame& F) {
    const int gw = F.vcu * NWAVES + F.wave, NGW = F.G * NWAVES, lane = F.lane;
    const float* logi = WSP(float, MS_LOGI); const float* logf = WSP(float, MS_LOGF); float* bcum = WSP(float, MS_BCUM); float* chs = WSP(float, MS_CHS);
    for (int it = gw; it < MH * NCH; it += NGW) { const int h = it >> 7, c = it & 127, t0 = c * CL;
        float v0 = logf[(size_t)(t0 + lane) * 4 + h], v1 = logf[(size_t)(t0 + 64 + lane) * 4 + h];
        v0 = wave_incl_scan(v0, lane); const float tot0 = __shfl(v0, 63); v1 = wave_incl_scan(v1, lane) + tot0; const float bl = __shfl(v1, 63);
        bcum[(size_t)h * M + t0 + lane] = v0; bcum[(size_t)h * M + t0 + 64 + lane] = v1;
        const float g0 = bl - v0 + logi[(size_t)(t0 + lane) * 4 + h], g1 = bl - v1 + logi[(size_t)(t0 + 64 + lane) * 4 + h];
        const float gm = wave_max(fmaxf(g0, g1));
        if (lane == 0) { chs[0 * 512 + it] = bl; chs[1 * 512 + it] = gm; } }
}
__device__ __forceinline__ void conv8(const bf16* src, int t, int c0, const float* cw, float scale, float (&acc)[8]) {
#pragma unroll
    for (int e = 0; e < 8; ++e) acc[e] = 0.f;
#pragma unroll
    for (int j = 0; j < 4; ++j) { const int tt = t - 3 + j; if (tt >= 0) { const v4u w = *(const GAS v4u*)(src + (size_t)tt * 512 + c0); const f32x4 w0 = *(const GAS f32x4*)(cw + (size_t)j * 1024), w1 = *(const GAS f32x4*)(cw + (size_t)j * 1024 + 4);
            acc[0] += blo(w.x) * w0.x; acc[1] += bhi(w.x) * w0.y; acc[2] += blo(w.y) * w0.z; acc[3] += bhi(w.y) * w0.w; acc[4] += blo(w.z) * w1.x; acc[5] += bhi(w.z) * w1.y; acc[6] += blo(w.w) * w1.z; acc[7] += bhi(w.w) * w1.w; } }
#pragma unroll
    for (int e = 0; e < 8; ++e) acc[e] = acc[e] * sigm(acc[e]) * scale;
}

__device__ __forceinline__ void p3_scan(Frame& F, float* Cl) {
    const int tid = F.tid;
    float* nst = WSP(float, MS_NST); const float* chs = WSP(float, MS_CHS);
    const int gt = F.vcu * (NWAVES * 64) + tid, NGT = F.G * NWAVES * 64;
    for (int idx = gt; idx < MH * 16384 + MH * 128; idx += NGT) {
        const bool isc = idx < MH * 16384; const int i2 = isc ? idx : idx - MH * 16384;
        const int h = isc ? (i2 >> 14) : (i2 >> 7), el = isc ? (i2 & 16383) : (i2 & 127);
        float* base = isc ? (Cl + ((size_t)(h * 128) << 14) + el) : (nst + (size_t)(h * 128) * 128 + el);
        const size_t stride = isc ? 16384 : 128; float a = 0.f;
        for (int c0 = 0; c0 < NCH; c0 += 16) { float v[16];
#pragma unroll
            for (int i = 0; i < 16; ++i) v[i] = base[(size_t)(c0 + i) * stride];
#pragma unroll
            for (int i = 0; i < 16; ++i) { a = chs[4 * 512 + h * 128 + c0 + i] * a + v[i]; v[i] = a; }
#pragma unroll
            for (int i = 0; i < 16; ++i) base[(size_t)(c0 + i) * stride] = v[i]; }
    }
}
typedef float f32x16 __attribute__((ext_vector_type(16)));
typedef short s16x4 __attribute__((ext_vector_type(4)));
typedef short v4i16_t __attribute__((ext_vector_type(4)));
typedef unsigned u32x4a __attribute__((ext_vector_type(4)));
__device__ __forceinline__ int crow(int r, int hi) { return (r & 3) + 8 * (r >> 2) + 4 * hi; }
__device__ __forceinline__ unsigned cvtpk(float lo, float hi) { unsigned r; asm("v_cvt_pk_bf16_f32 %0, %1, %2" : "=v"(r) : "v"(lo), "v"(hi)); return r; }
__device__ __forceinline__ s16x4 vtr(const LAS unsigned char* p) { return __builtin_bit_cast(s16x4, __builtin_amdgcn_ds_read_tr16_b64_v4i16((LAS v4i16_t*)p)); }
__device__ __forceinline__ float swapmax(float m) { auto rr = __builtin_amdgcn_permlane32_swap(__float_as_uint(m), __float_as_uint(m), false, false); return fmaxf(__uint_as_float(rr[0]), __uint_as_float(rr[1])); }
__device__ __forceinline__ float swapsum(float m) { auto rr = __builtin_amdgcn_permlane32_swap(__float_as_uint(m), __float_as_uint(m), false, false); return __uint_as_float(rr[0]) + __uint_as_float(rr[1]); }

__device__ __forceinline__ void attn_tile(const LAS unsigned char* Kl, const LAS unsigned char* Vl, const bf16x8 (&qr)[4], int nkb, bool diag, int qrel, float ch, int lane,
                                          f32x16& o0, f32x16& o1, float& mxo, float& lo_) {
    const int r32 = lane & 31, hi = lane >> 5;
    f32x16 p[8];
    const float base = ch * (float)(4 * hi - qrel);
    const LAS unsigned char* kb0 = Kl + hi * 4096 + r32 * 16;
#pragma unroll
    for (int kb = 0; kb < 8; ++kb) {
        if (kb < nkb) {
            f32x16 c;
#pragma unroll
            for (int r = 0; r < 16; ++r) c[r] = __builtin_fmaf(ch, (float)(32 * kb + (r & 3) + 8 * (r >> 2)), base);
#pragma unroll
            for (int d0 = 0; d0 < 4; ++d0) { const bf16x8 ka = *(const LAS bf16x8*)(kb0 + d0 * 8192 + kb * 512); c = __builtin_amdgcn_mfma_f32_32x32x16_bf16(ka, qr[d0], c, 0, 0, 0); }
            if (diag && kb == nkb - 1) {
#pragma unroll
                for (int r = 0; r < 16; ++r) if (32 * kb + crow(r, hi) > qrel) c[r] = -INFINITY;
            }
            p[kb] = c;
        }
    }
    float mx = -INFINITY;
#pragma unroll
    for (int kb = 0; kb < 8; ++kb) if (kb < nkb) {
#pragma unroll
        for (int r = 0; r < 16; ++r) mx = fmaxf(mx, p[kb][r]);
    }
    mx = swapmax(mx);
    float l = 0.f;
    u32x4a pw[8][2];
#pragma unroll
    for (int kb = 0; kb < 8; ++kb) {
        if (kb < nkb) {
            f32x16 e;
#pragma unroll
            for (int r = 0; r < 16; ++r) { e[r] = __builtin_amdgcn_exp2f(p[kb][r] - mx); l += e[r]; }
            pw[kb][0] = (u32x4a){cvtpk(e[0], e[1]), cvtpk(e[2], e[3]), cvtpk(e[4], e[5]), cvtpk(e[6], e[7])};
            pw[kb][1] = (u32x4a){cvtpk(e[8], e[9]), cvtpk(e[10], e[11]), cvtpk(e[12], e[13]), cvtpk(e[14], e[15])};
        } else { pw[kb][0] = (u32x4a){0u, 0u, 0u, 0u}; pw[kb][1] = (u32x4a){0u, 0u, 0u, 0u}; }
    }
    l = swapsum(l);
    f32x16 a0, a1;
#pragma unroll
    for (int r = 0; r < 16; ++r) { a0[r] = 0.f; a1[r] = 0.f; }
    const LAS unsigned char* vb = Vl + ((lane >> 4) & 1) * 32 + (lane & 3) * 8 + (4 * hi + ((lane & 15) >> 2)) * 64;
#pragma unroll
    for (int kb = 0; kb < 8; ++kb) {
        if ((kb & ~1) < nkb) {
#pragma unroll
            for (int k2 = 0; k2 < 2; ++k2) {
                const bf16x8 pa = __builtin_bit_cast(bf16x8, pw[kb][k2]);
                const LAS unsigned char* vp = vb + (kb * 2 + k2) * 1024;
                const s16x4 l0 = vtr(vp), h0 = vtr(vp + 512), l1 = vtr(vp + 16384), h1 = vtr(vp + 16384 + 512);
                const bf16x8 v0 = (bf16x8){l0[0], l0[1], l0[2], l0[3], h0[0], h0[1], h0[2], h0[3]};
                const bf16x8 v1 = (bf16x8){l1[0], l1[1], l1[2], l1[3], h1[0], h1[1], h1[2], h1[3]};
                a0 = __builtin_amdgcn_mfma_f32_32x32x16_bf16(pa, v0, a0, 0, 0, 0);
                a1 = __builtin_amdgcn_mfma_f32_32x32x16_bf16(pa, v1, a1, 0, 0, 0);
            }
        }
    }
    o0 = a0; o1 = a1; mxo = mx; lo_ = l;
}

__device__ __forceinline__ void load_kv_tile(const bf16* Kt, const bf16* Vt, int h, int j, LAS unsigned char* Kl, LAS unsigned char* Vl, int tid) {
    const GAS unsigned char* ks = (const GAS unsigned char*)Kt + (size_t)(h * 64 + j) * 32768; const GAS unsigned char* vs = (const GAS unsigned char*)Vt + (size_t)(h * 64 + j) * 32768;
#pragma unroll
    for (int i = 0; i < 4; ++i) { const unsigned off = (unsigned)(tid + 512 * i) * 16u; *(LAS v4u*)(Kl + off) = *(const GAS v4u*)(ks + off); *(LAS v4u*)(Vl + off) = *(const GAS v4u*)(vs + off); }
}
__device__ __forceinline__ int select_bit(unsigned long long m, int k) {
    int pos = 0; unsigned x = (unsigned)m; int c = __popc(x);
    if (k >= c) { k -= c; pos = 32; x = (unsigned)(m >> 32); }
    c = __popc(x & 0xffffu); if (k >= c) { k -= c; pos += 16; x >>= 16; }
    c = __popc(x & 0xffu); if (k >= c) { k -= c; pos += 8; x >>= 8; }
    c = __popc(x & 0xfu); if (k >= c) { k -= c; pos += 4; x >>= 4; }
    c = __popc(x & 0x3u); if (k >= c) { k -= c; pos += 2; x >>= 2; }
    c = (int)(x & 1u); if (k >= c) pos += 1;
    return pos;
}
__device__ __forceinline__ int block_incl_scan(int v, LAS int* scr, int lane, int wave) {
#pragma unroll
    for (int o = 1; o < 64; o <<= 1) { const int t = __shfl_up(v, o); if (lane >= o) v += t; }
    __syncthreads();
    if (lane == 63) scr[wave] = v;
    __syncthreads();
    int add = 0;
#pragma unroll
    for (int w = 0; w < 8; ++w) { const int t = scr[w]; if (w < wave) add += t; }
    return v + add;
}
__device__ __forceinline__ bool gbetter(float va, int ja, float vb, int jb) { return va > vb || (va == vb && ja < jb); }
__device__ __forceinline__ void top3_insert(float s, int j, float& v0, float& v1, float& v2, int& j0, int& j1, int& j2) {
    const bool b0 = gbetter(s, j, v0, j0), b1 = gbetter(s, j, v1, j1), b2 = gbetter(s, j, v2, j2);
    const float n2 = b1 ? v1 : (b2 ? s : v2), n1 = b0 ? v0 : (b1 ? s : v1), n0 = b0 ? s : v0;
    const int m2 = b1 ? j1 : (b2 ? j : j2), m1 = b0 ? j0 : (b1 ? j : j1), m0 = b0 ? j : j0;
    v0 = n0; v1 = n1; v2 = n2; j0 = m0; j1 = m1; j2 = m2;
}
__device__ __forceinline__ unsigned swapu(unsigned x, int hi) { auto rr = __builtin_amdgcn_permlane32_swap(x, x, false, false); return hi ? rr[0] : rr[1]; }

__device__ __forceinline__ void p2_gating(Frame& F, bool count) {
    const int wave = F.wave;
    const bf16* qa = WSP(bf16, WS_B); const float* ksum = (const float*)(F.ctl + CW_KSUM); unsigned* sel = WSP(unsigned, MS_SEL); unsigned long long* mask3 = WSP(unsigned long long, MS_MASK); unsigned* tot = (unsigned*)(F.ctl + CW_TOT);
    LAS unsigned char* kmb = F.lds + RING_OFF; LAS unsigned long long* wm = (LAS unsigned long long*)(F.lds + RING_OFF + 65536) + wave * 192;
    for (int qg = F.vcu; qg < M / 64; qg += F.G) {
        int tid = F.tid; asm volatile("" : "+v"(tid));
        const int lane = tid & 63, r32 = lane & 31, hi = lane >> 5;
        const int b = qg >> 2, h = wave;
        __syncthreads();
#pragma unroll 2
        for (int i = 0; i < 8; ++i) { const int p = tid + 512 * i, hh = p >> 9, j = (p >> 3) & 63, c = p & 7;
            const f32x4 a = *(const GAS f32x4*)(ksum + ((size_t)(hh * 64 + j)) * 64 + c * 8), bb = *(const GAS f32x4*)(ksum + ((size_t)(hh * 64 + j)) * 64 + c * 8 + 4);
            const float sc = 1.0f / 256.0f;
            *(LAS v4u*)(kmb + hh * 8192 + c * 1024 + j * 16) = (v4u){pk2(a.x * sc, a.y * sc), pk2(a.z * sc, a.w * sc), pk2(bb.x * sc, bb.y * sc), pk2(bb.z * sc, bb.w * sc)}; }
        for (int i = lane; i < 192; i += 64) wm[i] = 0ull;
        __syncthreads();
        const int n = b < 3 ? b : 3;
#pragma unroll 1
        for (int tt = 0; tt < 2; ++tt) {
            const int q = qg * 64 + tt * 32 + r32;
            bf16x8 qr[4];
#pragma unroll
            for (int d0 = 0; d0 < 4; ++d0) qr[d0] = *(const GAS bf16x8*)(qa + (size_t)q * 512 + h * 64 + d0 * 16 + hi * 8);
            f32x16 c0, c1;
#pragma unroll
            for (int r = 0; r < 16; ++r) { c0[r] = 0.f; c1[r] = 0.f; }
            const LAS unsigned char* kb0 = kmb + h * 8192 + hi * 1024 + r32 * 16;
#pragma unroll
            for (int d0 = 0; d0 < 4; ++d0) { const bf16x8 k0 = *(const LAS bf16x8*)(kb0 + d0 * 2048), k1 = *(const LAS bf16x8*)(kb0 + d0 * 2048 + 512);
                c0 = __builtin_amdgcn_mfma_f32_32x32x16_bf16(k0, qr[d0], c0, 0, 0, 0); c1 = __builtin_amdgcn_mfma_f32_32x32x16_bf16(k1, qr[d0], c1, 0, 0, 0); }
            float v0 = -INFINITY, v1 = -INFINITY, v2 = -INFINITY; int j0 = 64, j1 = 64, j2 = 64;
#pragma unroll
            for (int r = 0; r < 16; ++r) { const int j = crow(r, hi); if (j < b) top3_insert(c0[r], j, v0, v1, v2, j0, j1, j2); }
#pragma unroll
            for (int r = 0; r < 16; ++r) { const int j = 32 + crow(r, hi); if (j < b) top3_insert(c1[r], j, v0, v1, v2, j0, j1, j2); }
            { const float pv0 = __uint_as_float(swapu(__float_as_uint(v0), hi)), pv1 = __uint_as_float(swapu(__float_as_uint(v1), hi)), pv2 = __uint_as_float(swapu(__float_as_uint(v2), hi));
              const int pj0 = (int)swapu((unsigned)j0, hi), pj1 = (int)swapu((unsigned)j1, hi), pj2 = (int)swapu((unsigned)j2, hi);
              top3_insert(pv0, pj0, v0, v1, v2, j0, j1, j2); top3_insert(pv1, pj1, v0, v1, v2, j0, j1, j2); top3_insert(pv2, pj2, v0, v1, v2, j0, j1, j2); }
            if (hi == 0) {
                sel[(size_t)h * M + q] = (unsigned)(j0 & 63) | ((unsigned)(j1 & 63) << 8) | ((unsigned)(j2 & 63) << 16) | ((unsigned)n << 24);
                const unsigned long long bit = 1ull << (tt * 32 + r32);
                if (n > 0) __hip_atomic_fetch_or(wm + j0, bit, __ATOMIC_RELAXED, __HIP_MEMORY_SCOPE_WORKGROUP);
                if (n > 1) __hip_atomic_fetch_or(wm + 64 + j1, bit, __ATOMIC_RELAXED, __HIP_MEMORY_SCOPE_WORKGROUP);
                if (n > 2) __hip_atomic_fetch_or(wm + 128 + j2, bit, __ATOMIC_RELAXED, __HIP_MEMORY_SCOPE_WORKGROUP);
            }
        }
        asm volatile("s_waitcnt lgkmcnt(0)" ::: "memory");
        if (lane < b) { const unsigned long long m0 = wm[lane], m1 = wm[64 + lane], m2 = wm[128 + lane], all = m0 | m1 | m2; const size_t mi = ((size_t)h * 256 + qg) * 64 + lane;
            mask3[mi] = all; mask3[MASK_STRIDE + mi] = m0; mask3[2 * MASK_STRIDE + mi] = m1;
            const int pc = __popcll(all); if (pc && count) atomicAdd(tot + h * 64 + lane, (unsigned)pc); }
    }
    __syncthreads();
}

__device__ __forceinline__ void p3_attn_selected(Frame& F) {
    const int wave = F.wave;
    const bf16* Qa = WSP(bf16, WS_B); const bf16* Kt = Qa + (size_t)M * 512; const bf16* Vt = Kt + (size_t)M * 512;
    const unsigned long long* mask3 = WSP(unsigned long long, MS_MASK); const unsigned* tot = (const unsigned*)(F.ctl + CW_TOT);
    bf16* Op = (bf16*)F.out; float* Lp = (float*)((unsigned char*)F.out + 48 * MiB);
    LAS unsigned char* Kl = F.lds + RING_OFF; LAS unsigned char* Vl = F.lds + RING_OFF + 32768;
    LAS int* pre = (LAS int*)(F.lds + RING_OFF + 65536); LAS int* gpx = pre + 520; LAS unsigned long long* lm = (LAS unsigned long long*)(gpx + 264); LAS int* scr = (LAS int*)(lm + 768);
    LAS unsigned char* wbase = F.lds + RING_OFF + 81920 + wave * 4608; LAS bf16* stg = (LAS bf16*)wbase; LAS int* rowq = (LAS int*)(wbase + 4096); LAS int* rowslot = rowq + 32; LAS float* rinv = (LAS float*)(rowslot + 32);
    { const int n = (int)tot[F.tid]; const int inc = block_incl_scan((n + 31) >> 5, scr, F.lane, wave); pre[F.tid + 1] = inc; if (F.tid == 0) pre[0] = 0; }
    __syncthreads();
    const int TOTAL = pre[512];
    const int t_lo = (int)(((long)TOTAL * F.vcu) / F.G), t_hi = (int)(((long)TOTAL * (F.vcu + 1)) / F.G);
    for (int t = t_lo; t < t_hi;) {
        int tid = F.tid; asm volatile("" : "+v"(tid));
        const int lane = tid & 63, r32 = lane & 31, hi = lane >> 5;
        int a = 0, b = 512;
        while (b - a > 1) { const int mid = (a + b) >> 1; if (pre[mid] <= t) a = mid; else b = mid; }
        const int item = a, h = item >> 6, j = item & 63, seg_end = pre[item + 1] < t_hi ? pre[item + 1] : t_hi, tl0 = t - pre[item], nseg = seg_end - t, n_item = (int)tot[item];
        __syncthreads();
        load_kv_tile(Kt, Vt, h, j, Kl, Vl, tid);
        int pc = 0;
        if (tid < 256) { unsigned long long mk = 0ull, m0 = 0ull, m1 = 0ull; if (tid >= 4 * (j + 1)) { const size_t mi = ((size_t)h * 256 + tid) * 64 + j; mk = mask3[mi]; m0 = mask3[MASK_STRIDE + mi]; m1 = mask3[2 * MASK_STRIDE + mi]; }
            lm[tid] = mk; lm[256 + tid] = m0; lm[512 + tid] = m1; pc = __popcll(mk); }
        const int inc = block_incl_scan(pc, scr, lane, wave);
        if (tid < 256) gpx[tid + 1] = inc; if (tid == 0) gpx[0] = 0;
        __syncthreads();
        const float ch = exp2f(-(float)(h + 1)) * LOG2E;
#pragma unroll 1
        for (int k = wave; k < nseg; k += 8) {
            const int row = 32 * (tl0 + k) + r32; const bool valid = row < n_item; const int rowc = valid ? row : 32 * (tl0 + k);
            int a2 = 0, b2 = 256; while (b2 - a2 > 1) { const int mid = (a2 + b2) >> 1; if (gpx[mid] <= rowc) a2 = mid; else b2 = mid; }
            const int pos = select_bit(lm[a2], rowc - gpx[a2]); const int q = a2 * 64 + pos;
            const int slot = ((lm[256 + a2] >> pos) & 1ull) ? 0 : (((lm[512 + a2] >> pos) & 1ull) ? 1 : 2);
            if (hi == 0) { rowq[r32] = valid ? q : -1; rowslot[r32] = slot; }
            bf16x8 qr[4];
#pragma unroll
            for (int d0 = 0; d0 < 4; ++d0) qr[d0] = *(const GAS bf16x8*)(Qa + (size_t)q * 512 + h * 64 + d0 * 16 + hi * 8);
            f32x16 o0, o1; float mx, l;
            attn_tile(Kl, Vl, qr, 8, false, q - j * 256, ch, lane, o0, o1, mx, l);
            if (hi == 0) { rinv[r32] = 1.0f / l; if (valid) Lp[((size_t)q * 8 + h) * 3 + slot] = mx + __log2f(l); }
            asm volatile("s_waitcnt lgkmcnt(0)" ::: "memory");
#pragma unroll
            for (int r = 0; r < 16; ++r) { const int rr = crow(r, hi); const float rl = rinv[rr]; stg[rr * 64 + r32] = (bf16)f2bf(o0[r] * rl); stg[rr * 64 + 32 + r32] = (bf16)f2bf(o1[r] * rl); }
            asm volatile("s_waitcnt lgkmcnt(0)" ::: "memory");
#pragma unroll
            for (int i = 0; i < 4; ++i) { const int idx = i * 64 + lane, rr = idx >> 3, pc8 = idx & 7; const int qq = rowq[rr];
                if (qq >= 0) *(GAS v4u*)(Op + (((size_t)qq * 8 + h) * 3 + rowslot[rr]) * 64 + pc8 * 8) = *(const LAS v4u*)(stg + rr * 64 + pc8 * 8); }
            asm volatile("s_waitcnt lgkmcnt(0)" ::: "memory");
        }
        t = seg_end;
    }
    __syncthreads();
}

__device__ __forceinline__ void p4_attn_own(Frame& F, bf16* Ydst, int qmask) {
    const int wave = F.wave;
    bf16* Qa = WSP(bf16, WS_B); const bf16* Kt = Qa + (size_t)M * 512; const bf16* Vt = Kt + (size_t)M * 512;
    const bf16* Op = (const bf16*)F.out; const float* Lp = (const float*)((const unsigned char*)F.out + 48 * MiB);
    LAS unsigned char* Kl = F.lds + RING_OFF; LAS unsigned char* Vl = F.lds + RING_OFF + 32768;
    LAS unsigned char* wbase = F.lds + RING_OFF + 65536 + wave * 4608; LAS bf16* stg = (LAS bf16*)wbase; LAS float* tab = (LAS float*)(wbase + 4096);
    for (int it = F.vcu; it < AH * NBLK; it += F.G) {
        int tid = F.tid; asm volatile("" : "+v"(tid));
        const int lane = tid & 63, r32 = lane & 31, hi = lane >> 5;
        const int h = it >> 6, b = it & 63, qt = wave;
        __syncthreads();
        load_kv_tile(Kt, Vt, h, b, Kl, Vl, tid);
        __syncthreads();
        const int q0 = b * 256 + qt * 32, q = q0 + r32;
        bf16x8 qr[4];
#pragma unroll
        for (int d0 = 0; d0 < 4; ++d0) qr[d0] = *(const GAS bf16x8*)(Qa + (size_t)q * 512 + h * 64 + d0 * 16 + hi * 8);
        const float ch = exp2f(-(float)(h + 1)) * LOG2E;
        f32x16 o0, o1; float mx, l;
        attn_tile(Kl, Vl, qr, qt + 1, true, qt * 32 + r32, ch, lane, o0, o1, mx, l);
        const int n = b < 3 ? b : 3;
        if (hi == 0) { const float lse = mx + __log2f(l); float ls[3]; float big = lse;
#pragma unroll
            for (int s = 0; s < 3; ++s) { ls[s] = (s < n) ? Lp[((size_t)q * 8 + h) * 3 + s] : -INFINITY; big = fmaxf(big, ls[s]); }
            const float wo = __builtin_amdgcn_exp2f(lse - big); float w[3]; float den = wo;
#pragma unroll
            for (int s = 0; s < 3; ++s) { w[s] = __builtin_amdgcn_exp2f(ls[s] - big); den += w[s]; }
            const float rd = 1.0f / den; tab[r32] = wo * rd / l; tab[32 + r32] = w[0] * rd; tab[64 + r32] = w[1] * rd; tab[96 + r32] = w[2] * rd; }
        asm volatile("s_waitcnt lgkmcnt(0)" ::: "memory");
#pragma unroll
        for (int r = 0; r < 16; ++r) { const float w = tab[crow(r, hi)]; o0[r] *= w; o1[r] *= w; }
#pragma unroll 1
        for (int s = 0; s < n; ++s) {
#pragma unroll
            for (int i = 0; i < 4; ++i) { const int idx = i * 64 + lane, rr = idx >> 3, pc8 = idx & 7;
                *(LAS v4u*)(stg + rr * 64 + pc8 * 8) = *(const GAS v4u*)(Op + (((size_t)(q0 + rr) * 8 + h) * 3 + s) * 64 + pc8 * 8); }
            asm volatile("s_waitcnt vmcnt(0) lgkmcnt(0)" ::: "memory");
#pragma unroll
            for (int r = 0; r < 16; ++r) { const int rr = crow(r, hi); const float w = tab[32 + 32 * s + rr]; o0[r] += w * bf2f(stg[rr * 64 + r32]); o1[r] += w * bf2f(stg[rr * 64 + 32 + r32]); }
            asm volatile("s_waitcnt lgkmcnt(0)" ::: "memory");
        }
#pragma unroll
        for (int r = 0; r < 16; ++r) { const int rr = crow(r, hi); stg[rr * 64 + r32] = (bf16)f2bf(o0[r]); stg[rr * 64 + 32 + r32] = (bf16)f2bf(o1[r]); }
        asm volatile("s_waitcnt lgkmcnt(0)" ::: "memory");
#pragma unroll
        for (int i = 0; i < 4; ++i) { const int idx = i * 64 + lane, rr = idx >> 3, pc8 = idx & 7;
            *(GAS v4u*)(Ydst + (size_t)((q0 + rr) & qmask) * 512 + h * 64 + pc8 * 8) = *(const LAS v4u*)(stg + rr * 64 + pc8 * 8); }
        asm volatile("s_waitcnt lgkmcnt(0)" ::: "memory");
    }
    __syncthreads();
}
__device__ __forceinline__ void mscan_wave(const float* chs, int h, int c, int lane, float& mprev, float& mnew) {
    const float b0 = chs[0 * 512 + h * 128 + 2 * lane], b1 = chs[0 * 512 + h * 128 + 2 * lane + 1], g0 = chs[1 * 512 + h * 128 + 2 * lane], g1 = chs[1 * 512 + h * 128 + 2 * lane + 1];
    float A = b0 + b1, G = fmaxf(b1 + g0, g1);
#pragma unroll
    for (int o = 1; o < 64; o <<= 1) { const float Ap = __shfl_up(A, o), Gp = __shfl_up(G, o); if (lane >= o) { G = fmaxf(A + Gp, G); A = A + Ap; } }
    const float m_odd = fmaxf(A, G);
    float m_before = __shfl_up(m_odd, 1); if (lane == 0) m_before = 0.f;
    const float m_even = fmaxf(b0 + m_before, g0);
    const int src = c >> 1;
    const float me = __shfl(m_even, src), mo = __shfl(m_odd, src), mb = __shfl(m_before, src);
    if (c & 1) { mprev = me; mnew = mo; } else { mprev = mb; mnew = me; }
}
__device__ __forceinline__ int panel_off(int r, int ci  ) { return (ci >> 2) * 8192 + r * 64 + (ci & 3) * 16; }
__device__ __forceinline__ int chunk_off(int r, int ci) { return ci * 2048 + r * 16; }
__device__ __forceinline__ bf16x8 tr8(const LAS unsigned char* p, int second) { const s16x4 a = vtr(p), b = vtr(p + second); return (bf16x8){a[0], a[1], a[2], a[3], b[0], b[1], b[2], b[3]}; }

__device__ __forceinline__ void p2_cloc(Frame& F) {
    const int tid = F.tid, lane = F.lane, wave = F.wave, r32 = lane & 31, hi = lane >> 5;
    const bf16* km = WSP(bf16, WS_C) + (size_t)M * 512; const bf16* vm = WSP(bf16, WS_C) + (size_t)2 * M * 512;
    const float* logi = WSP(float, MS_LOGI); const float* bcum = WSP(float, MS_BCUM); float* chs = WSP(float, MS_CHS);
    float* Cl = WSP(float, WS_A); float* nst = WSP(float, MS_NST);
    LAS unsigned char* KW = F.lds + RING_OFF; LAS unsigned char* VV = F.lds + RING_OFF + 32768; LAS float* sh = (LAS float*)(F.lds + RING_OFF + 65536);
    const float* cwk = IN_CONV + 512;
    for (int it = F.vcu; it < MH * NCH; it += F.G) { const int h = it >> 7, c = it & 127, t0 = c * CL;
        __syncthreads();
        if (wave == 0) { float mp, mn; mscan_wave(chs, h, c, lane, mp, mn);
            if (lane == 0) { sh[0] = mp; sh[1] = mn; const float bl = chs[0 * 512 + it]; chs[2 * 512 + it] = mp; chs[3 * 512 + it] = mn; chs[4 * 512 + it] = __expf(bl + mp - mn); } }
        __syncthreads();
        if (tid < 128) { const float bl = chs[0 * 512 + it]; sh[8 + tid] = __expf(bl - bcum[(size_t)h * M + t0 + tid] + logi[(size_t)(t0 + tid) * 4 + h] - sh[1]); }
        __syncthreads();
#pragma unroll
        for (int i = 0; i < 4; ++i) { const int idx = tid + 512 * i, r = idx >> 4, ci = idx & 15; const float w = sh[8 + r];
            float kk[8]; conv8(km, t0 + r, h * 128 + ci * 8, cwk + h * 128 + ci * 8, 0.08838834764831845f, kk);
            v4u o;
            { const float k0 = bf2f((bf16)f2bf(kk[0])), k1 = bf2f((bf16)f2bf(kk[1])), k2 = bf2f((bf16)f2bf(kk[2])), k3 = bf2f((bf16)f2bf(kk[3])), k4 = bf2f((bf16)f2bf(kk[4])), k5 = bf2f((bf16)f2bf(kk[5])), k6 = bf2f((bf16)f2bf(kk[6])), k7 = bf2f((bf16)f2bf(kk[7]));
              o.x = pk2(k0 * w, k1 * w); o.y = pk2(k2 * w, k3 * w); o.z = pk2(k4 * w, k5 * w); o.w = pk2(k6 * w, k7 * w); }
            *(LAS v4u*)(KW + panel_off(r, ci)) = o;
            *(LAS v4u*)(VV + panel_off(r, ci)) = *(const GAS v4u*)(vm + (size_t)(t0 + r) * 512 + h * 128 + ci * 8); }
        __syncthreads();
        {
            const int db = wave >> 1, eb0 = 2 * (wave & 1);
            const int toff = (4 * hi + ((lane & 15) >> 2)) * 64 + ((lane >> 4) & 1) * 32 + (lane & 3) * 8;
            f32x16 a0, a1;
#pragma unroll
            for (int r = 0; r < 16; ++r) { a0[r] = 0.f; a1[r] = 0.f; }
#pragma unroll
            for (int ks = 0; ks < 8; ++ks) {
                const bf16x8 A = tr8(KW + db * 8192 + ks * 1024 + toff, 512);
                const bf16x8 B0 = tr8(VV + eb0 * 8192 + ks * 1024 + toff, 512), B1 = tr8(VV + (eb0 + 1) * 8192 + ks * 1024 + toff, 512);
                a0 = __builtin_amdgcn_mfma_f32_32x32x16_bf16(A, B0, a0, 0, 0, 0);
                a1 = __builtin_amdgcn_mfma_f32_32x32x16_bf16(A, B1, a1, 0, 0, 0);
            }
            float* dst = Cl + ((size_t)it * 128 + 32 * db) * 128 + 32 * eb0 + r32;
#pragma unroll
            for (int r = 0; r < 16; ++r) { const int d = crow(r, hi); dst[(size_t)d * 128] = a0[r]; dst[(size_t)d * 128 + 32] = a1[r]; }
        }
        {
            const int d = tid >> 2, part = tid & 3; float ns = 0.f;
            const LAS bf16* col = (const LAS bf16*)(KW + (d >> 5) * 8192 + (d & 31) * 2);
#pragma unroll 8
            for (int s = 0; s < 32; ++s) ns += bf2f(col[(part * 32 + s) * 32]);
            ns += __shfl_xor(ns, 1); ns += __shfl_xor(ns, 2);
            if (part == 0) nst[(size_t)it * 128 + d] = ns;
        }
    }
    __syncthreads();
}

__device__ __forceinline__ void p4_mlstm_out(Frame& F, bf16* Ydst, int tmask) {
    const int wave = F.wave;
    const bf16* qm = WSP(bf16, WS_C); const bf16* km = qm + (size_t)M * 512; const bf16* vm = WSP(bf16, WS_C) + (size_t)2 * M * 512; bf16* om = WSP(bf16, WS_C) + (size_t)3 * M * 512;
    const float* logi = WSP(float, MS_LOGI); const float* bcum = WSP(float, MS_BCUM); const float* chs = WSP(float, MS_CHS);
    const float* Cst = WSP(float, WS_A); const float* nst = WSP(float, MS_NST);
    LAS unsigned char* Qc = F.lds + RING_OFF; LAS unsigned char* Kc = F.lds + RING_OFF + 32768; LAS unsigned char* Vp = F.lds + RING_OFF + 65536; LAS unsigned char* Cp = F.lds + RING_OFF + 98304;
    LAS float* sh = (LAS float*)(F.lds + RING_OFF + 131072);
    LAS float* bvec = sh, *ivb = sh + 128, *pm = sh + 256, *nprev = sh + 384, *stat = sh + 512;
    const float* cwq = IN_CONV; const float* cwk = IN_CONV + 512; const float* lng = IN_MNG;
    for (int it = F.vcu; it < MH * NCH; it += F.G) { const int h = it >> 7, c = it & 127, t0 = c * CL;
        int tid = F.tid; asm volatile("" : "+v"(tid));
        const int lane = tid & 63, r32 = lane & 31, hi = lane >> 5; LAS float* wt = sh + 1024 + wave * 64;
        __syncthreads();
#pragma unroll 1
        for (int i = 0; i < 4; ++i) { const int idx = tid + 512 * i, r = idx >> 4, ci = idx & 15; const size_t go = (size_t)(t0 + r) * 512 + h * 128 + ci * 8;
            float cq[8], ck[8]; conv8(qm, t0 + r, h * 128 + ci * 8, cwq + h * 128 + ci * 8, 1.0f, cq); conv8(km, t0 + r, h * 128 + ci * 8, cwk + h * 128 + ci * 8, 0.08838834764831845f, ck);
            *(LAS v4u*)(Qc + chunk_off(r, ci)) = (v4u){pk2(cq[0], cq[1]), pk2(cq[2], cq[3]), pk2(cq[4], cq[5]), pk2(cq[6], cq[7])};
            *(LAS v4u*)(Kc + chunk_off(r, ci)) = (v4u){pk2(ck[0], ck[1]), pk2(ck[2], ck[3]), pk2(ck[4], ck[5]), pk2(ck[6], ck[7])};
            *(LAS v4u*)(Vp + panel_off(r, ci)) = *(const GAS v4u*)(vm + go);
            v4u o = (v4u){0u, 0u, 0u, 0u};
            if (c > 0) { const float* cp = Cst + ((size_t)(it - 1) * 128 + r) * 128 + ci * 8; const f32x4 a = *(const GAS f32x4*)cp, b = *(const GAS f32x4*)(cp + 4); o.x = pk2(a.x, a.y); o.y = pk2(a.z, a.w); o.z = pk2(b.x, b.y); o.w = pk2(b.z, b.w); }
            *(LAS v4u*)(Cp + panel_off(r, ci)) = o; }
        if (tid < 128) { const float bt = bcum[(size_t)h * M + t0 + tid]; bvec[tid] = bt; ivb[tid] = logi[(size_t)(t0 + tid) * 4 + h] - bt; nprev[tid] = (c > 0) ? nst[(size_t)(it - 1) * 128 + tid] : 0.f; }
        __syncthreads();
        if (wave == 0) { float v0 = ivb[lane], v1 = ivb[64 + lane];
#pragma unroll
            for (int o = 1; o < 64; o <<= 1) { const float a = __shfl_up(v0, o), b = __shfl_up(v1, o); if (lane >= o) { v0 = fmaxf(v0, a); v1 = fmaxf(v1, b); } }
            v1 = fmaxf(v1, __shfl(v0, 63)); pm[lane] = v0; pm[64 + lane] = v1; }
        __syncthreads();
        const float mprev = chs[2 * 512 + it];
        const int tb = wave & 3, eh = wave >> 2, t = 32 * tb + r32;
        bf16x8 qr[8];
#pragma unroll
        for (int k0 = 0; k0 < 8; ++k0) qr[k0] = *(const LAS bf16x8*)(Qc + (2 * k0 + hi) * 2048 + t * 16);
        const float bt = bvec[t], mt = bt + fmaxf(mprev, pm[t]), winter = __expf(bt + mprev - mt), cst = bt - mt;
        float rs = 0.f; u32x4a pw[4][2];
#pragma unroll
        for (int sb = 0; sb < 4; ++sb) {
            if (sb <= tb) {
                f32x16 cc;
#pragma unroll
                for (int r = 0; r < 16; ++r) cc[r] = 0.f;
#pragma unroll
                for (int k0 = 0; k0 < 8; ++k0) { const bf16x8 ka = *(const LAS bf16x8*)(Kc + (2 * k0 + hi) * 2048 + (32 * sb + r32) * 16); cc = __builtin_amdgcn_mfma_f32_32x32x16_bf16(ka, qr[k0], cc, 0, 0, 0); }
                float e[16];
#pragma unroll
                for (int r = 0; r < 16; ++r) { const int s = 32 * sb + crow(r, hi); const float w = (s <= t) ? __expf(ivb[s] + cst) : 0.f; e[r] = cc[r] * w; rs += e[r]; }
                pw[sb][0] = (u32x4a){cvtpk(e[0], e[1]), cvtpk(e[2], e[3]), cvtpk(e[4], e[5]), cvtpk(e[6], e[7])};
                pw[sb][1] = (u32x4a){cvtpk(e[8], e[9]), cvtpk(e[10], e[11]), cvtpk(e[12], e[13]), cvtpk(e[14], e[15])};
            } else { pw[sb][0] = (u32x4a){0u, 0u, 0u, 0u}; pw[sb][1] = (u32x4a){0u, 0u, 0u, 0u}; }
        }
        rs = swapsum(rs);
        float qn = 0.f;
#pragma unroll
        for (int k0 = 0; k0 < 8; ++k0) { const u32x4a qq = __builtin_bit_cast(u32x4a, qr[k0]); const LAS float* np = nprev + 16 * k0 + 8 * hi;
            qn += (blo(qq.x) * np[0] + bhi(qq.x) * np[1]) + (blo(qq.y) * np[2] + bhi(qq.y) * np[3]) + (blo(qq.z) * np[4] + bhi(qq.z) * np[5]) + (blo(qq.w) * np[6] + bhi(qq.w) * np[7]); }
        qn = swapsum(qn);
        const float den = winter * qn + rs, scl = 1.0f / fmaxf(fabsf(den), __expf(-mt));
        if (hi == 0) { wt[r32] = winter; wt[32 + r32] = scl; }
        f32x16 acc[2];
#pragma unroll
        for (int r = 0; r < 16; ++r) { acc[0][r] = 0.f; acc[1][r] = 0.f; }
        const int coff = (8 * hi + ((lane & 15) >> 2)) * 64 + ((lane >> 4) & 1) * 32 + (lane & 3) * 8;
#pragma unroll
        for (int k0 = 0; k0 < 8; ++k0) {
#pragma unroll
            for (int eb = 0; eb < 2; ++eb) { const bf16x8 B = tr8(Cp + (2 * eh + eb) * 8192 + k0 * 1024 + coff, 256); acc[eb] = __builtin_amdgcn_mfma_f32_32x32x16_bf16(qr[k0], B, acc[eb], 0, 0, 0); } }
        asm volatile("s_waitcnt lgkmcnt(0)" ::: "memory");
#pragma unroll
        for (int r = 0; r < 16; ++r) { const float wi = wt[crow(r, hi)]; acc[0][r] *= wi; acc[1][r] *= wi; }
        const int voff = (4 * hi + ((lane & 15) >> 2)) * 64 + ((lane >> 4) & 1) * 32 + (lane & 3) * 8;
#pragma unroll
        for (int sb = 0; sb < 4; ++sb) {
            if (sb <= tb) {
#pragma unroll
                for (int k2 = 0; k2 < 2; ++k2) { const bf16x8 pa = __builtin_bit_cast(bf16x8, pw[sb][k2]);
#pragma unroll
                    for (int eb = 0; eb < 2; ++eb) { const bf16x8 B = tr8(Vp + (2 * eh + eb) * 8192 + (2 * sb + k2) * 1024 + voff, 512); acc[eb] = __builtin_amdgcn_mfma_f32_32x32x16_bf16(pa, B, acc[eb], 0, 0, 0); } }
            }
        }
        const size_t gbase = (size_t)(t0 + 32 * tb) * 512 + h * 128 + 64 * eh + r32;
        float s1[16], s2[16];
#pragma unroll
        for (int r = 0; r < 16; ++r) { const int tr_ = crow(r, hi); const float sc = wt[32 + tr_]; const bf16* op = om + gbase + (size_t)tr_ * 512;
            const float x0 = acc[0][r] * sc * sigm(bf2f(op[0])), x1 = acc[1][r] * sc * sigm(bf2f(op[32])); acc[0][r] = x0; acc[1][r] = x1; s1[r] = x0 + x1; s2[r] = x0 * x0 + x1 * x1; }
#pragma unroll
        for (int o = 1; o < 32; o <<= 1) {
#pragma unroll
            for (int r = 0; r < 16; ++r) { s1[r] += __shfl_xor(s1[r], o); s2[r] += __shfl_xor(s2[r], o); } }
        if (r32 == 0) {
#pragma unroll
            for (int r = 0; r < 16; ++r) { const int tt = 32 * tb + crow(r, hi); stat[(tt * 2 + eh) * 2] = s1[r]; stat[(tt * 2 + eh) * 2 + 1] = s2[r]; } }
        __syncthreads();
        const float g0 = lng[h * 128 + 64 * eh + r32], g1 = lng[h * 128 + 64 * eh + 32 + r32];
#pragma unroll
        for (int r = 0; r < 16; ++r) { const int tr_ = crow(r, hi), tt = 32 * tb + tr_;
            const float sum = stat[tt * 4] + stat[tt * 4 + 2], sq = stat[tt * 4 + 1] + stat[tt * 4 + 3];
            const float mu = sum * (1.0f / 128.0f), var = fmaxf(sq * (1.0f / 128.0f) - mu * mu, 0.f), rstd = 1.0f / sqrtf(var + EPS);
            bf16* yp = Ydst + (size_t)((t0 + 32 * tb + tr_) & tmask) * 512 + h * 128 + 64 * eh + r32;
            yp[0] = (bf16)f2bf((acc[0][r] - mu) * rstd * g0); yp[32] = (bf16)f2bf((acc[1][r] - mu) * rstd * g1); }
    }
    __syncthreads();
}

__device__ __forceinline__ void p10_final_norm(Frame& F, float* io) {
    const int gw = F.vcu * NWAVES + F.wave, NGW = F.G * NWAVES, lane = F.lane;
    f32x4 gv[4];
#pragma unroll
    for (int j = 0; j < 4; ++j) gv[j] = ((const GAS f32x4*)IN_FING)[lane + 64 * j];
    for (int m = gw; m < M; m += NGW) {
        GAS f32x4* xr = (GAS f32x4*)(io + (size_t)m * D) + lane;
        f32x4 v[4]; float s = 0.f;
#pragma unroll
        for (int j = 0; j < 4; ++j) { v[j] = xr[64 * j]; s += (v[j].x * v[j].x + v[j].y * v[j].y) + (v[j].z * v[j].z + v[j].w * v[j].w); }
        const float rstd = 1.0f / sqrtf(wave_sum(s) * (1.f / D) + EPS);
#pragma unroll
        for (int j = 0; j < 4; ++j) xr[64 * j] = v[j] * rstd * gv[j];
    }
}

struct Args { const float* in[15]; float* out; unsigned char* ws; int ph_lo, ph_hi, li, pad; };
__global__ void __launch_bounds__(NWAVES * 64, 2) mk_fwd(Args args) {
    extern __shared__ __attribute__((aligned(16))) unsigned char lds[];
    Frame F;
    F.lds = (LAS unsigned char*)lds;
    F.MISC = (volatile LAS unsigned*)(F.lds + MISC_OFF);
    F.tid = threadIdx.x; F.lane = F.tid & 63; F.wave = __builtin_amdgcn_readfirstlane(F.tid >> 6);
    F.G = gridDim.x; { const int bx = blockIdx.x; F.vcu = (F.G % 8 == 0) ? (bx % 8) * (F.G / 8) + bx / 8 : bx; }
    F.ws = args.ws; F.ctl = (gu32*)(args.ws + WS_CTL); F.out = args.out;
    for (int u = F.tid; u < (LDS_BYTES - LDSCTL_OFF) / 4; u += NWAVES * 64) ((LAS unsigned*)(F.lds + LDSCTL_OFF))[u] = 0u;
    __syncthreads();
    if (F.tid < 15) ((LAS cfptr*)(F.lds + LDSCTL_OFF))[F.tid] = args.in[F.tid];
    __syncthreads();
#define REFRESH() do { int l_; asm volatile("v_mbcnt_lo_u32_b32 %0, -1, 0\n\tv_mbcnt_hi_u32_b32 %0, -1, %0" : "=v"(l_)); F.lane = l_; F.tid = F.wave * 64 + l_; } while (0)
    XcdBarrier bar; bar.bar = (unsigned*)(F.ctl + CW_BAR); bar.x = 0; bar.st = nullptr;
    if (N_LAUNCHES == 1) bar = xcd_barrier_post((unsigned*)(F.ctl + CW_BAR), F.MISC + 8, F.tid);
#define GRID_BAR() do { if (N_LAUNCHES == 1) { REFRESH(); xcd_barrier(bar, F.tid); } } while (0)
    const int lo = args.ph_lo, hi = args.ph_hi;
#define IN(k) (lo <= (k) && (k) < hi)
#define SEAM(k) do { if (IN(k) && IN((k) + 1)) GRID_BAR(); } while (0)
    bf16* segs = WSP(bf16, WS_B);
    static_assert(WS_C == WS_B + (size_t)3 * M * 512 * 2, "segments contiguous");
    bf16* ga = WSP(bf16, WS_D); bf16* gm = ga + (size_t)M * 1024;
    bf16* ya = WSP(bf16, WS_B); bf16* ym = WSP(bf16, WS_C) + (size_t)3 * M * 512;
    bf16* P1 = WSP(bf16, WS_C); bf16* merged = WSP(bf16, WS_A);
    bf16* x1b = WSP(bf16, WS_B + 16 * MiB); bf16* hid = WSP(bf16, WS_HID);

#ifndef PROBE_DUP
#define PROBE_DUP -1
#endif
#define DUP(k) (PROBE_DUP == (k))
    bf16* dummy = (bf16*)((unsigned char*)F.out + 50 * MiB);
    if (IN(0)) { p0_prologue(F); if (DUP(0)) { __syncthreads(); p0_prologue(F); } } SEAM(0);
    REFRESH(); if (IN(1)) { gate_prep(F);
        pg8::Gemm g{WSP(bf16, WS_A), WSP(bf16, WS_WIN), M, NIN, D}; pg8::StaticOrder S; S.init(M, NIN, F.G, (int)blockIdx.x);
        pg8::EpiIn E{segs, ga, C2, M, (float*)(F.ctl + CW_KSUM)};
        pg8::gemm_phase<pg8::EpiIn, pg8::StaticOrder, PG8_ALIGN, PG8_SP2>(F.lds + RING_OFF, g, S, E, F.tid);
        if (DUP(1)) pg8::gemm_phase<pg8::EpiIn, pg8::StaticOrder, PG8_ALIGN, PG8_SP2>(F.lds + RING_OFF, g, S, E, F.tid); } SEAM(1);
    REFRESH(); if (IN(2)) { p2_gating(F, true); if (DUP(20)) p2_gating(F, false); REFRESH(); p2_cloc(F); if (DUP(21)) p2_cloc(F); } SEAM(2);
    REFRESH(); if (IN(3)) { p3_scan(F, WSP(float, WS_A)); REFRESH(); p3_attn_selected(F); if (DUP(31)) p3_attn_selected(F); } SEAM(3);
    REFRESH(); if (IN(4)) { if (DUP(40)) p4_attn_own(F, dummy, 8191); p4_attn_own(F, WSP(bf16, WS_B), M - 1); REFRESH(); if (DUP(41)) p4_mlstm_out(F, dummy, 8191); p4_mlstm_out(F, ym, M - 1); } SEAM(4);
    REFRESH(); if (IN(5)) { pg8::Gemm g{ya, WSP(bf16, WS_WA), M, D, AW}; pg8::StaticOrder S; S.init(M, D, F.G, (int)blockIdx.x);
        pg8::EpiGate<0> E{ga, nullptr, P1};
        pg8::gemm_phase<pg8::EpiGate<0>, pg8::StaticOrder, PG8_ALIGN, PG8_SP2>(F.lds + RING_OFF, g, S, E, F.tid);
        if (DUP(5)) pg8::gemm_phase<pg8::EpiGate<0>, pg8::StaticOrder, PG8_ALIGN, PG8_SP2>(F.lds + RING_OFF, g, S, E, F.tid); } SEAM(5);
    if (DUP(50)) { for (int kk = 0; kk < 10; ++kk) GRID_BAR(); }
    REFRESH(); if (IN(6)) { pg8::Gemm g{ym, WSP(bf16, WS_WM), M, D, MW}; pg8::StaticOrder S; S.init(M, D, F.G, (int)blockIdx.x);
        pg8::EpiGate<1> E{gm, P1, merged};
        pg8::gemm_phase<pg8::EpiGate<1>, pg8::StaticOrder, PG8_ALIGN, PG8_SP2>(F.lds + RING_OFF, g, S, E, F.tid); } SEAM(6);
    REFRESH(); if (IN(7)) { pg8::Gemm g{merged, WSP(bf16, WS_WO), M, D, D}; pg8::StaticOrder S; S.init(M, D, F.G, (int)blockIdx.x);
        pg8::EpiRes<true> E{IN_X, F.out, x1b, WSP(float, MS_SSQ1)};
        pg8::gemm_phase<pg8::EpiRes<true>, pg8::StaticOrder, PG8_ALIGN, PG8_SP2>(F.lds + RING_OFF, g, S, E, F.tid);
        if (DUP(7)) pg8::gemm_phase<pg8::EpiRes<true>, pg8::StaticOrder, PG8_ALIGN, PG8_SP2>(F.lds + RING_OFF, g, S, E, F.tid); } SEAM(7);
    REFRESH(); if (IN(8)) { pg8::Gemm g{x1b, WSP(bf16, WS_WGU), M, NIN, D}; pg8::StaticOrder S; S.init(M, NIN, F.G, (int)blockIdx.x);
        pg8::EpiSwiGLU E{WSP(float, MS_SSQ1), hid, FF, EPS};
        pg8::gemm_phase<pg8::EpiSwiGLU, pg8::StaticOrder, PG8_ALIGN, PG8_SP2>(F.lds + RING_OFF, g, S, E, F.tid);
        if (DUP(8)) pg8::gemm_phase<pg8::EpiSwiGLU, pg8::StaticOrder, PG8_ALIGN, PG8_SP2>(F.lds + RING_OFF, g, S, E, F.tid); } SEAM(8);
    REFRESH(); if (IN(9)) { if (DUP(30)) { p3_scan(F, WSP(float, WS_A + 36 * MiB)); REFRESH(); }
        pg8::Gemm g{hid, WSP(bf16, WS_WD), M, D, FF}; pg8::StaticOrder S; S.init(M, D, F.G, (int)blockIdx.x);
        if (DUP(9)) { pg8::EpiRes<false> E0{F.out, (float*)WSP(bf16, WS_A), nullptr, WSP(float, MS_SSQ2)}; pg8::gemm_phase<pg8::EpiRes<false>, pg8::StaticOrder, PG8_ALIGN, PG8_SP2>(F.lds + RING_OFF, g, S, E0, F.tid); }
        pg8::EpiRes<false> E{F.out, F.out, nullptr, WSP(float, MS_SSQ2)};
        pg8::gemm_phase<pg8::EpiRes<false>, pg8::StaticOrder, PG8_ALIGN, PG8_SP2>(F.lds + RING_OFF, g, S, E, F.tid); } SEAM(9);
    REFRESH(); if (IN(10)) { if (DUP(100)) p10_final_norm(F, WSP(float, WS_A)); p10_final_norm(F, F.out); }
#undef IN
#undef SEAM
}

extern "C" void kernel_launch(void* const* d_in, const int* in_sizes, int n_in, void* d_out, int out_size, void* d_ws, size_t ws_size, hipStream_t stream) {
    static int grid = 0;
    if (grid == 0) {
        if (n_in != 15 || in_sizes[0] != M * D || out_size != M * D || ws_size < WS_END) { fprintf(stderr, "kernel_launch: unexpected shapes: n_in %d in0 %d out %d ws %zu\n", n_in, n_in > 0 ? in_sizes[0] : -1, out_size, ws_size); grid = -1; return; }
        int dev = 0, cus = 0, per_cu = 0;
        if (hipGetDevice(&dev) != hipSuccess || hipDeviceGetAttribute(&cus, hipDeviceAttributeMultiprocessorCount, dev) != hipSuccess) { grid = -1; return; }
        if (hipFuncSetAttribute((const void*)mk_fwd, hipFuncAttributeMaxDynamicSharedMemorySize, LDS_BYTES) != hipSuccess) { fprintf(stderr, "kernel_launch: hipFuncSetAttribute failed\n"); grid = -1; return; }
        if (hipOccupancyMaxActiveBlocksPerMultiprocessor(&per_cu, (const void*)mk_fwd, NWAVES * 64, LDS_BYTES) != hipSuccess || per_cu < 1) { fprintf(stderr, "kernel_launch: occupancy query says %d blocks per CU\n", per_cu); per_cu = 1; }
        (void)hipGetLastError();
        grid = cus;
    }
    if (grid < 0) return;
    if (hipMemsetAsync((char*)d_ws + WS_CTL, 0, CTL_ZERO_BYTES, stream) != hipSuccess) { fprintf(stderr, "kernel_launch: memset failed\n"); return; }
    Args a{};
    for (int i = 0; i < 15; ++i) a.in[i] = (const float*)d_in[i];
    a.out = (float*)d_out; a.ws = (unsigned char*)d_ws;
    for (int li = 0; li < N_LAUNCHES; ++li) {
        a.ph_lo = (N_LAUNCHES == 1) ? 0 : li; a.ph_hi = (N_LAUNCHES == 1) ? N_PHASES : li + 1; a.li = li;
        hipLaunchKernelGGL(mk_fwd, dim3(grid), dim3(NWAVES * 64), LDS_BYTES, stream, a);
        const hipError_t le = hipPeekAtLastError();
        if (le != hipSuccess) { fprintf(stderr, "kernel_launch: launch %d failed: %s\n", li, hipGetErrorName(le)); break; }
    }
}
```

```cpp
#include <hip/hip_runtime.h>
#include <cstdio>
#include <cstdint>
namespace pg8 {
#define PG8_LAS __attribute__((address_space(3)))
typedef unsigned short bf16_t;
typedef short bf16x8 __attribute__((ext_vector_type(8)));
typedef float f32x4 __attribute__((ext_vector_type(4)));
typedef unsigned u32x4 __attribute__((ext_vector_type(4)));
constexpr int BM = 256, BK = 64, HALF = 128, HTB = HALF * BK * 2  , STAGE_BYTES = 8 * HTB, NXCD = 8, WGM = 8;

__host__ __device__ __forceinline__ int lds_byte(int r, int c) { const int st = (r >> 4) * 2 + (c >> 5), rr = r & 15, cc = c & 31, ob = rr * 64 + cc * 2; return st * 1024 + (ob ^ (((ob >> 9) & 1) << 5)); }
__host__ __device__ __forceinline__ void stage_rc(int b, int& R, int& C) { const int st = b / 1024, sb = b % 1024, swz = sb ^ (((sb >> 9) & 1) << 5); R = (st >> 1) * 16 + swz / 64; C = (st & 1) * 32 + (swz % 64) / 2; }
__host__ __device__ __forceinline__ int perm32(int rho) { const int n = rho >> 4, i = rho & 15; return 8 * (i >> 2) + 4 * n + (i & 3); }

struct Unit { int pm, pn; };
struct Gemm { const bf16_t* A; const bf16_t* Bt; int M, N, K; };

struct StaticOrder {
    int nM, nN, nwg, G, c;
    __host__ __device__ void init(int M, int N, int G_, int c_) { nM = M / BM; nN = N / BM; nwg = nM * nN; G = G_; c = c_; }
    __host__ __device__ bool next(int i, Unit& u) const {
        const long L = (long)i * G + c; if (L >= nwg) return false;
        int wgid = (int)L; { const int q = nwg / NXCD, r = nwg % NXCD, xcd = wgid % NXCD, off = wgid / NXCD; wgid = (xcd < r ? xcd * (q + 1) : r * (q + 1) + (xcd - r) * q) + off; }
        const int nig = WGM * nN, gid = wgid / nig, fm = gid * WGM, gsz = (nM - fm) < WGM ? (nM - fm) : WGM;
        u.pm = fm + ((wgid % nig) % gsz); u.pn = (wgid % nig) / gsz; return true;
    }
    __device__ __forceinline__ void a_ready(const Unit&) const {}
    __device__ __forceinline__ void done(const Unit&) const {}
};

__device__ __forceinline__ unsigned cvt_pk_bf16(float lo, float hi) { unsigned r; asm volatile("v_cvt_pk_bf16_f32 %0, %1, %2" : "=v"(r) : "v"(lo), "v"(hi)); return r; }
typedef float f32x2 __attribute__((ext_vector_type(2)));
template <class Epi, class Sched, bool ALIGN_EPI = false, bool SP2 = false>
__device__ __forceinline__ void gemm_phase(PG8_LAS unsigned char* lds, const Gemm g, const Sched& S, const Epi& E, const int tid) {
    const int wid = __builtin_amdgcn_readfirstlane(tid >> 6), lane = tid & 63, wr = wid >> 2, wc = wid & 3, fr = lane & 15, fq = lane >> 4;
    const int K = g.K, nt = K / BK;
    unsigned voffA[2], voffB[2];
#pragma unroll
    for (int i = 0; i < 2; ++i) { int R, C; stage_rc(tid * 16 + i * 8192, R, C); const int Rb = Epi::PERM ? ((R & ~31) + perm32(R & 31)) : R;
        voffA[i] = (unsigned)(R * K + C) * 2u; voffB[i] = (unsigned)(Rb * K + C) * 2u; }
    const size_t kstep = (size_t)(BK * 2);
    const size_t hstep = (size_t)HALF * K * 2;
    const size_t tstep = 2 * hstep;
    const unsigned ldsw = (unsigned)wid * 1024u;
    const int aoff = lds_byte(wr * 64 + fr, fq * 8), boff = lds_byte(wc * 32 + fr, fq * 8);
#define PG8_SA(b, h) (((b) * 2 + (h)) * HTB)
#define PG8_SB(b, h) ((4 + (b) * 2 + (h)) * HTB)
#define PG8_STAGE(bufoff, gbase, voff) do { _Pragma("unroll") for (int _i = 0; _i < 2; ++_i) \
        __builtin_amdgcn_global_load_lds((const unsigned*)((const char*)(gbase) + (voff)[_i]), (PG8_LAS unsigned*)(lds + (bufoff) + ldsw + _i * 8192), 16, 0, 0); } while (0)
#define PG8_LDA(dst, b, h) do { _Pragma("unroll") for (int m = 0; m < 4; ++m) _Pragma("unroll") for (int k = 0; k < 2; ++k) dst[m][k] = *(const PG8_LAS bf16x8*)(lds + PG8_SA(b, h) + aoff + m * 2048 + k * 1024); } while (0)
#define PG8_LDB(dst, b, h) do { _Pragma("unroll") for (int n = 0; n < 2; ++n) _Pragma("unroll") for (int k = 0; k < 2; ++k) dst[n][k] = *(const PG8_LAS bf16x8*)(lds + PG8_SB(b, h) + boff + n * 2048 + k * 1024); } while (0)
#define PG8_MMA(ai, bj, At, Bt) do { __builtin_amdgcn_s_setprio(1); _Pragma("unroll") for (int m = 0; m < 4; ++m) _Pragma("unroll") for (int n = 0; n < 2; ++n) _Pragma("unroll") for (int k = 0; k < 2; ++k) \
        acc[ai][bj][m][n] = __builtin_amdgcn_mfma_f32_16x16x32_bf16(Bt[n][k], At[m][k], acc[ai][bj][m][n], 0, 0, 0); __builtin_amdgcn_s_setprio(0); } while (0)
#define PG8_WAIT_V(n) asm volatile("s_waitcnt vmcnt(" #n ")" ::: "memory")
#define PG8_WAIT_L(n) asm volatile("s_waitcnt lgkmcnt(" #n ")" ::: "memory")
#define PG8_BAR __builtin_amdgcn_s_barrier()
#define PG8_SCHED __builtin_amdgcn_sched_barrier(0)
    Unit cur, nxt; int ui = 0;
    if (!S.next(0, cur)) return;
    f32x4 acc[2][2][4][2];
#pragma unroll
    for (int a = 0; a < 2; ++a)
#pragma unroll
        for (int b = 0; b < 2; ++b)
#pragma unroll
            for (int m = 0; m < 4; ++m)
#pragma unroll
                for (int n = 0; n < 2; ++n) acc[a][b][m][n] = (f32x4){0.f, 0.f, 0.f, 0.f};
    bf16x8 At[4][2], B0[2][2], B1[2][2];
    const char* cA = (const char*)g.A + (size_t)cur.pm * tstep; const char* cB = (const char*)g.Bt + (size_t)cur.pn * tstep;
    S.a_ready(cur);
    if constexpr (SP2) {
        PG8_STAGE(PG8_SB(0, 0), cB, voffB); PG8_STAGE(PG8_SB(0, 1), cB + hstep, voffB); PG8_STAGE(PG8_SA(0, 0), cA, voffA); PG8_STAGE(PG8_SA(0, 1), cA + hstep, voffA);
        if (wr == 1) PG8_BAR;
        PG8_WAIT_V(2); PG8_BAR;
        PG8_STAGE(PG8_SB(1, 0), cB + kstep, voffB); PG8_STAGE(PG8_SA(1, 0), cA + kstep, voffA); PG8_STAGE(PG8_SB(1, 1), cB + hstep + kstep, voffB);
        PG8_WAIT_V(6); PG8_BAR;
    } else {
        PG8_STAGE(PG8_SB(0, 0), cB, voffB); PG8_STAGE(PG8_SA(0, 0), cA, voffA); PG8_STAGE(PG8_SB(0, 1), cB + hstep, voffB); PG8_STAGE(PG8_SA(0, 1), cA + hstep, voffA);
        if (wr == 1) PG8_BAR;
        PG8_WAIT_V(4); PG8_BAR;
        PG8_STAGE(PG8_SB(1, 0), cB + kstep, voffB); PG8_STAGE(PG8_SA(1, 0), cA + kstep, voffA); PG8_STAGE(PG8_SB(1, 1), cB + hstep + kstep, voffB);
        PG8_WAIT_V(6); PG8_BAR;
    }
    for (;;) {
        const bool has_next = S.next(ui + 1, nxt);
        const char* nA = has_next ? (const char*)g.A + (size_t)nxt.pm * tstep : cA; const char* nB = has_next ? (const char*)g.Bt + (size_t)nxt.pn * tstep : cB;
        for (int t = 0; t < nt; t += 2) {
            const bool last = (t == nt - 2);
            const char* a1 = cA + (size_t)(t + 1) * kstep;
            const char* a2 = last ? nA : cA + (size_t)(t + 2) * kstep; const char* b2 = last ? nB : cB + (size_t)(t + 2) * kstep;
            const char* a3 = a2 + kstep; const char* b3 = b2 + kstep;
            if (last && has_next) S.a_ready(nxt);
            if constexpr (SP2) {
            PG8_LDB(B0, 0, 0); PG8_LDB(B1, 0, 1); PG8_SCHED; PG8_LDA(At, 0, 0); PG8_STAGE(PG8_SA(1, 1), a1 + hstep, voffA);
            PG8_WAIT_V(8); PG8_WAIT_L(0); PG8_BAR; PG8_MMA(0, 0, At, B0); PG8_MMA(0, 1, At, B1); PG8_BAR; PG8_SCHED;
            PG8_LDA(At, 0, 1); PG8_STAGE(PG8_SB(0, 0), b2, voffB); PG8_STAGE(PG8_SB(0, 1), b2 + hstep, voffB); PG8_STAGE(PG8_SA(0, 0), a2, voffA);
            PG8_WAIT_V(8); PG8_WAIT_L(0); PG8_BAR; PG8_MMA(1, 0, At, B0); PG8_MMA(1, 1, At, B1); PG8_BAR; PG8_SCHED;
            PG8_LDB(B0, 1, 0); PG8_LDB(B1, 1, 1); PG8_SCHED; PG8_LDA(At, 1, 0); PG8_STAGE(PG8_SA(0, 1), a2 + hstep, voffA);
            PG8_WAIT_V(8); PG8_WAIT_L(0); PG8_BAR; PG8_MMA(0, 0, At, B0); PG8_MMA(0, 1, At, B1); PG8_BAR; PG8_SCHED;
            PG8_LDA(At, 1, 1); PG8_STAGE(PG8_SB(1, 0), b3, voffB); PG8_STAGE(PG8_SB(1, 1), b3 + hstep, voffB); PG8_STAGE(PG8_SA(1, 0), a3, voffA);
            PG8_WAIT_V(8); PG8_WAIT_L(0); PG8_BAR; PG8_MMA(1, 0, At, B0); PG8_MMA(1, 1, At, B1); PG8_BAR; PG8_SCHED;
            } else {
            PG8_LDB(B0, 0, 0); PG8_SCHED; PG8_LDA(At, 0, 0); PG8_STAGE(PG8_SA(1, 1), a1 + hstep, voffA);
            PG8_WAIT_L(8); PG8_BAR; PG8_WAIT_L(0); PG8_MMA(0, 0, At, B0); PG8_BAR; PG8_SCHED;
            PG8_LDB(B1, 0, 1); PG8_STAGE(PG8_SB(0, 0), b2, voffB);
            PG8_BAR; PG8_WAIT_L(0); PG8_MMA(0, 1, At, B1); PG8_BAR;
            PG8_LDA(At, 0, 1); PG8_STAGE(PG8_SA(0, 0), a2, voffA);
            PG8_BAR; PG8_WAIT_L(0); PG8_MMA(1, 0, At, B0); PG8_BAR; PG8_SCHED;
            PG8_STAGE(PG8_SB(0, 1), b2 + hstep, voffB);
            PG8_WAIT_V(6); PG8_BAR; PG8_MMA(1, 1, At, B1); PG8_BAR;
            PG8_LDB(B0, 1, 0); PG8_SCHED; PG8_LDA(At, 1, 0); PG8_STAGE(PG8_SA(0, 1), a2 + hstep, voffA);
            PG8_WAIT_L(8); PG8_BAR; PG8_WAIT_L(0); PG8_MMA(0, 0, At, B0); PG8_BAR; PG8_SCHED;
            PG8_LDB(B1, 1, 1); PG8_STAGE(PG8_SB(1, 0), b3, voffB);
            PG8_BAR; PG8_WAIT_L(0); PG8_MMA(0, 1, At, B1); PG8_BAR;
            PG8_LDA(At, 1, 1); PG8_STAGE(PG8_SA(1, 0), a3, voffA);
            PG8_BAR; PG8_WAIT_L(0); PG8_MMA(1, 0, At, B0); PG8_BAR; PG8_SCHED;
            PG8_STAGE(PG8_SB(1, 1), b3 + hstep, voffB);
            PG8_WAIT_V(6); PG8_BAR; PG8_MMA(1, 1, At, B1); PG8_BAR;
            }
        }
        if constexpr (ALIGN_EPI) { if (wr == 0) PG8_BAR; }
        if constexpr (!Epi::AFTER_DRAIN) { E(acc, cur, wr, wc, fr, fq); S.done(cur); }
        if (!has_next) break;
#pragma unroll
        for (int a = 0; a < 2; ++a)
#pragma unroll
            for (int b = 0; b < 2; ++b)
#pragma unroll
                for (int m = 0; m < 4; ++m)
#pragma unroll
                    for (int n = 0; n < 2; ++n) acc[a][b][m][n] = (f32x4){0.f, 0.f, 0.f, 0.f};
        cur = nxt; cA = nA; cB = nB; ++ui;
        if constexpr (ALIGN_EPI) { if (wr == 1) PG8_BAR; }
    }
    PG8_WAIT_V(0);
    if constexpr (!ALIGN_EPI) { if (wr == 0) PG8_BAR; }
    PG8_BAR;
    if constexpr (Epi::AFTER_DRAIN) { E.fused(acc, cur, wr, wc, fr, fq, lds, wid, lane); S.done(cur); }
#undef PG8_SA
#undef PG8_SB
#undef PG8_STAGE
#undef PG8_LDA
#undef PG8_LDB
#undef PG8_MMA
#undef PG8_WAIT_V
#undef PG8_WAIT_L
#undef PG8_BAR
#undef PG8_SCHED
}
}

#ifndef PG8_SP2
#define PG8_SP2 true
#endif
#ifndef PG8_ALIGN
#define PG8_ALIGN true
#endif
namespace pg8 {
__device__ __forceinline__ float sigmoidf_fast(float x) { return __builtin_amdgcn_rcpf(1.0f + __builtin_amdgcn_exp2f(-1.4426950408889634f * x)); }
__device__ __forceinline__ float bflo(unsigned w) { return __uint_as_float(w << 16); }
__device__ __forceinline__ float bfhi(unsigned w) { return __uint_as_float(w & 0xffff0000u); }

struct EpiIn {
    static constexpr bool PERM = true, AFTER_DRAIN = false;
    bf16_t* seg; bf16_t* gates; float qscale; int Mrows; float* ksum;
    __device__ __forceinline__ void operator()(const f32x4 (&acc)[2][2][4][2], const Unit& u, int wr, int wc, int fr, int fq) const {
        const int pn = u.pn;
        if (pn >= 2 && pn < 6) {
            const bool isk = pn < 4; bf16_t* base = seg + (size_t)(isk ? 1 : 2) * Mrows * 512; const int j = u.pm;
            float cs[2][8];
#pragma unroll
            for (int bj = 0; bj < 2; ++bj)
#pragma unroll
                for (int e = 0; e < 8; ++e) cs[bj][e] = 0.f;
#pragma unroll
            for (int bj = 0; bj < 2; ++bj) { const int cc = (pn & 1) * 256 + bj * HALF + wc * 32, h = cc >> 6;
                bf16_t* tb = base + (size_t)(h * 64 + j) * 16384 + (isk ? (4 * (wc & 1) + fq) * 2048 : (wc & 1) * 8192 + 8 * fq);
#pragma unroll
                for (int ai = 0; ai < 2; ++ai)
#pragma unroll
                    for (int m = 0; m < 4; ++m) { const int key = ai * HALF + wr * 64 + m * 16 + fr; const f32x4 v0 = acc[ai][bj][m][0], v1 = acc[ai][bj][m][1];
                        u32x4 w; w.x = cvt_pk_bf16(v0[0], v0[1]); w.y = cvt_pk_bf16(v0[2], v0[3]); w.z = cvt_pk_bf16(v1[0], v1[1]); w.w = cvt_pk_bf16(v1[2], v1[3]);
                        *(u32x4*)(tb + (size_t)key * (isk ? 8 : 32)) = w;
                        if (isk) {
#pragma unroll
                            for (int e = 0; e < 4; ++e) { cs[bj][e] += v0[e]; cs[bj][4 + e] += v1[e]; } } } }
            if (isk) {
#pragma unroll
                for (int bj = 0; bj < 2; ++bj)
#pragma unroll
                    for (int e = 0; e < 8; ++e) { float v = cs[bj][e]; v += __shfl_xor(v, 1); v += __shfl_xor(v, 2); v += __shfl_xor(v, 4); v += __shfl_xor(v, 8); cs[bj][e] = v; }
                if (fr == 0) {
#pragma unroll
                    for (int bj = 0; bj < 2; ++bj) { const int cc = (pn & 1) * 256 + bj * HALF + wc * 32 + 8 * fq;
#pragma unroll
                        for (int e = 0; e < 8; ++e) atomicAdd(ksum + ((size_t)((cc >> 6) * 64 + j)) * 64 + (cc & 63) + e, cs[bj][e]); } }
            }
            return;
        }
        bf16_t* base; int ldc, colt, mode;
        if (pn < 14) { const int s = pn >> 1; base = seg + (size_t)s * Mrows * 512; ldc = 512; colt = (pn & 1) * 256; mode = (s == 0) ? 1 : 0; }
        else { const int g = (pn - 14) >> 2; base = gates + (size_t)g * Mrows * 1024; ldc = 1024; colt = ((pn - 14) & 3) * 256; mode = 2; }
        const int row0 = u.pm * BM + wr * 64 + fr, col0 = colt + wc * 32 + 8 * fq;
#pragma unroll
        for (int ai = 0; ai < 2; ++ai)
#pragma unroll
            for (int m = 0; m < 4; ++m) { bf16_t* rowp = base + (size_t)(row0 + ai * HALF + m * 16) * ldc + col0;
#pragma unroll
                for (int bj = 0; bj < 2; ++bj) { f32x4 v0 = acc[ai][bj][m][0], v1 = acc[ai][bj][m][1];
                    if (mode == 1) { v0 = v0 * qscale; v1 = v1 * qscale; }
                    else if (mode == 2) {
#pragma unroll
                        for (int e = 0; e < 4; ++e) { v0[e] = sigmoidf_fast(v0[e]); v1[e] = sigmoidf_fast(v1[e]); } }
                    u32x4 w; w.x = cvt_pk_bf16(v0[0], v0[1]); w.y = cvt_pk_bf16(v0[2], v0[3]); w.z = cvt_pk_bf16(v1[0], v1[1]); w.w = cvt_pk_bf16(v1[2], v1[3]);
                    *(u32x4*)(rowp + bj * HALF) = w; } }
    }
};
template <int MODE> struct EpiGate {
    static constexpr bool PERM = true, AFTER_DRAIN = false;
    const bf16_t* G; const bf16_t* P; bf16_t* O;
    __device__ __forceinline__ void operator()(const f32x4 (&acc)[2][2][4][2], const Unit& u, int wr, int wc, int fr, int fq) const {
        const int row0 = u.pm * BM + wr * 64 + fr, col0 = u.pn * BM + wc * 32 + 8 * fq;
#pragma unroll
        for (int ai = 0; ai < 2; ++ai)
#pragma unroll
            for (int m = 0; m < 4; ++m) { const size_t off = (size_t)(row0 + ai * HALF + m * 16) * 1024 + col0;
#pragma unroll
                for (int bj = 0; bj < 2; ++bj) { const f32x4 v0 = acc[ai][bj][m][0], v1 = acc[ai][bj][m][1];
                    const u32x4 g = *(const u32x4*)(G + off + bj * HALF);
                    float r[8] = { bflo(g.x) * v0[0], bfhi(g.x) * v0[1], bflo(g.y) * v0[2], bfhi(g.y) * v0[3], bflo(g.z) * v1[0], bfhi(g.z) * v1[1], bflo(g.w) * v1[2], bfhi(g.w) * v1[3] };
                    if (MODE == 1) { const u32x4 p = *(const u32x4*)(P + off + bj * HALF);
                        r[0] += bflo(p.x); r[1] += bfhi(p.x); r[2] += bflo(p.y); r[3] += bfhi(p.y); r[4] += bflo(p.z); r[5] += bfhi(p.z); r[6] += bflo(p.w); r[7] += bfhi(p.w); }
                    u32x4 w; w.x = cvt_pk_bf16(r[0], r[1]); w.y = cvt_pk_bf16(r[2], r[3]); w.z = cvt_pk_bf16(r[4], r[5]); w.w = cvt_pk_bf16(r[6], r[7]);
                    *(u32x4*)(O + off + bj * HALF) = w; } }
    }
};
template <bool WITH_BF> struct EpiRes {
    static constexpr bool PERM = false, AFTER_DRAIN = false;
    const float* base; float* out; bf16_t* xb; float* ssq;
    __device__ __forceinline__ void operator()(const f32x4 (&acc)[2][2][4][2], const Unit& u, int wr, int wc, int fr, int fq) const {
        typedef unsigned u32x2v __attribute__((ext_vector_type(2)));
        const int row0 = u.pm * BM + wr * 64 + fr, col0 = u.pn * BM + wc * 32 + 4 * fq;
#pragma unroll
        for (int ai = 0; ai < 2; ++ai)
#pragma unroll
            for (int m = 0; m < 4; ++m) { const int row = row0 + ai * HALF + m * 16; const size_t off = (size_t)row * 1024 + col0; float ss = 0.f;
#pragma unroll
                for (int bj = 0; bj < 2; ++bj)
#pragma unroll
                    for (int n = 0; n < 2; ++n) { const size_t o2 = off + bj * HALF + n * 16; const f32x4 o = *(const f32x4*)(base + o2) + acc[ai][bj][m][n];
                        *(f32x4*)(out + o2) = o; ss += (o[0] * o[0] + o[1] * o[1]) + (o[2] * o[2] + o[3] * o[3]);
                        if (WITH_BF) { u32x2v w; w.x = cvt_pk_bf16(o[0], o[1]); w.y = cvt_pk_bf16(o[2], o[3]); *(u32x2v*)(xb + o2) = w; } }
                ss += __shfl_xor(ss, 16); ss += __shfl_xor(ss, 32);
                if (fq == 0) ssq[(size_t)row * 16 + u.pn * 4 + wc] = ss; }
    }
};
struct EpiSwiGLU {
    static constexpr bool PERM = true, AFTER_DRAIN = false;
    const float* ssq; bf16_t* Hd; int ldh; float eps;
    __device__ __forceinline__ void operator()(const f32x4 (&acc)[2][2][4][2], const Unit& u, int wr, int wc, int fr, int fq) const {
        const int row0 = u.pm * BM + wr * 64 + fr, col0 = u.pn * HALF + wc * 32 + 8 * fq;
#pragma unroll
        for (int ai = 0; ai < 2; ++ai)
#pragma unroll
            for (int m = 0; m < 4; ++m) { const int row = row0 + ai * HALF + m * 16; const f32x4* sp = (const f32x4*)(ssq + (size_t)row * 16);
                const f32x4 s0 = sp[0], s1 = sp[1], s2 = sp[2], s3 = sp[3];
                const float tot = ((s0[0] + s0[1]) + (s0[2] + s0[3])) + ((s1[0] + s1[1]) + (s1[2] + s1[3])) + ((s2[0] + s2[1]) + (s2[2] + s2[3])) + ((s3[0] + s3[1]) + (s3[2] + s3[3]));
                const float rs = 1.0f / sqrtf(tot * (1.0f / 1024.0f) + eps);
                float r[8];
#pragma unroll
                for (int n = 0; n < 2; ++n)
#pragma unroll
                    for (int e = 0; e < 4; ++e) { const float g = acc[ai][0][m][n][e] * rs, up = acc[ai][1][m][n][e] * rs; r[n * 4 + e] = g * sigmoidf_fast(g) * up; }
                u32x4 w; w.x = cvt_pk_bf16(r[0], r[1]); w.y = cvt_pk_bf16(r[2], r[3]); w.z = cvt_pk_bf16(r[4], r[5]); w.w = cvt_pk_bf16(r[6], r[7]);
                *(u32x4*)(Hd + (size_t)row * ldh + col0) = w; }
    }
};
}
#define GAS __attribute__((address_space(1)))
#define LAS __attribute__((address_space(3)))
typedef unsigned short bf16;
typedef unsigned v4u __attribute__((ext_vector_type(4)));
typedef float f32x4 __attribute__((ext_vector_type(4)));
typedef short bf16x8 __attribute__((ext_vector_type(8)));
typedef GAS unsigned gu32;
typedef GAS unsigned long long gu64;
#define RLX_AGENT __ATOMIC_RELAXED, __HIP_MEMORY_SCOPE_AGENT
#define LDS_WAIT() asm volatile("s_waitcnt lgkmcnt(0)" ::: "memory")
#define VM_WAIT() asm volatile("s_waitcnt vmcnt(0)" ::: "memory")
__device__ __forceinline__ unsigned long long rt() { return __builtin_amdgcn_s_memrealtime(); }
__device__ __forceinline__ unsigned f2bf(float f) { unsigned u = __builtin_bit_cast(unsigned, f); return (u + 0x7fffu + ((u >> 16) & 1u)) >> 16; }
__device__ __forceinline__ unsigned pk2(float lo, float hi) { return f2bf(lo) | (f2bf(hi) << 16); }

#define XB_TMO      128
#define XB_XCNT(j)  (256  + 64 * (j))
#define XB_XSUB(j)  (1280 + 64 * (j))
#define XB_XGEN(j)  (2304 + 64 * (j))
#define XB_TOP      3328
#define XB_TOPGEN   3392
#define XCD_BAR_WORDS 3456
#define XB_SPIN_CAP (1u << 18)

__device__ __forceinline__ unsigned xb_ld(unsigned* p)              { return __hip_atomic_load(p, __ATOMIC_RELAXED, __HIP_MEMORY_SCOPE_AGENT); }
__device__ __forceinline__ unsigned xb_add(unsigned* p, unsigned v) { return __hip_atomic_fetch_add(p, v, __ATOMIC_RELAXED, __HIP_MEMORY_SCOPE_AGENT); }
__device__ __forceinline__ unsigned xb_xcc_id() { return (unsigned)__builtin_amdgcn_s_getreg((3 << 11) | 20) & 0xFu; }
#define XB_SPIN(cond, bar) do { unsigned _sp = 0; while (cond) { __builtin_amdgcn_s_sleep(1); \
    if ((++_sp & 255u) == 0u) { if (xb_ld(&(bar)[XB_TMO])) break; if (_sp > XB_SPIN_CAP) { atomicAdd(&(bar)[XB_TMO], 1u); break; } } } } while (0)

struct XcdBarrier {
    unsigned* bar; unsigned x;
    volatile LAS unsigned* st;
};

__device__ __forceinline__ XcdBarrier xcd_barrier_post(unsigned* bar, volatile LAS unsigned* st, const int tid_) {
    XcdBarrier b; b.bar = bar; b.x = xb_xcc_id(); b.st = st;
    if (tid_ == 0) (void)xb_add(&bar[XB_XCNT(b.x)], 1u);
    return b;
}
__device__ __forceinline__ void xcd_barrier_complete(unsigned* bar, unsigned x, unsigned& nloc, unsigned& nx) {
    const unsigned G = gridDim.x * gridDim.y * gridDim.z;
    unsigned sum, cnt, mine, sp = 0u;
    for (;;) {
        sum = 0u; cnt = 0u; mine = 0u;
#pragma unroll
        for (unsigned j = 0; j < 16; ++j) { const unsigned c = xb_ld(&bar[XB_XCNT(j)]); sum += c; cnt += (c > 0u) ? 1u : 0u; mine = (j == x) ? c : mine; }
        if (sum == G) break;
        __builtin_amdgcn_s_sleep(1);
        if ((++sp & 255u) == 0u) { if (xb_ld(&bar[XB_TMO])) break; if (sp > XB_SPIN_CAP) { atomicAdd(&bar[XB_TMO], 1u); break; } }
    }
    nloc = mine > 0u ? mine : 1u; nx = cnt > 0u ? cnt : 1u;
}

__device__ __forceinline__ void xcd_barrier(const XcdBarrier& b, const int tid_) {
    asm volatile("s_waitcnt vmcnt(0)" ::: "memory");
    __syncthreads();
    if (tid_ == 0) {
        unsigned* bar = b.bar;
        __builtin_amdgcn_s_waitcnt(0);
        unsigned nloc = b.st[0], nx = b.st[1];
        if (nloc == 0u) { xcd_barrier_complete(bar, b.x, nloc, nx); b.st[0] = nloc; b.st[1] = nx; }
        const unsigned old = xb_add(&bar[XB_XSUB(b.x)], 1u);
        const unsigned gen = old / nloc;
        if (old + 1u == (gen + 1u) * nloc) {
            __builtin_amdgcn_fence(__ATOMIC_RELEASE, "agent");
            asm volatile("s_waitcnt vmcnt(0)" ::: "memory");
            const unsigned og = xb_add(&bar[XB_TOP], 1u);
            const unsigned tg = og / nx;
            if (og + 1u == (tg + 1u) * nx) xb_add(&bar[XB_TOPGEN], 1u);
            else XB_SPIN(xb_ld(&bar[XB_TOPGEN]) == tg, bar);
            __builtin_amdgcn_fence(__ATOMIC_ACQUIRE, "agent");
            xb_add(&bar[XB_XGEN(b.x)], 1u);
            asm volatile("s_waitcnt vmcnt(0)" ::: "memory");
        } else {
            XB_SPIN(xb_ld(&bar[XB_XGEN(b.x)]) == gen, bar);
            __builtin_amdgcn_fence(__ATOMIC_ACQUIRE, "agent");
            asm volatile("s_waitcnt vmcnt(0)" ::: "memory");
        }
    }
    __syncthreads();
}
constexpr int NWAVES = 8;
constexpr int N_PHASES = 11;
#ifndef MK_N_LAUNCHES
#define MK_N_LAUNCHES 1
#endif
constexpr int N_LAUNCHES = MK_N_LAUNCHES;

constexpr int M = 16384, D = 1024, NIN = 5632, FF = 2816, INW = 5640;
constexpr int AH = 8, AD = 64, AW = 512, MH = 4, MD = 128, MW = 512, NBLK = 64, NCH = 128, CL = 128;
constexpr float EPS = 1e-6f;
constexpr float LOG2E = 1.4426950408889634f;
constexpr float C2 = 0.125f * LOG2E;

constexpr size_t MiB = 1u << 20;
constexpr size_t WS_CTL = 0, CTL_ZERO_BYTES = 1 * MiB;
constexpr size_t WS_WIN = 1 * MiB;
constexpr size_t WS_WGU = 12 * MiB;
constexpr size_t WS_WD = 23 * MiB;
constexpr size_t WS_WO = 29 * MiB;
constexpr size_t WS_WA = 31 * MiB;
constexpr size_t WS_WM = 32 * MiB;
constexpr size_t WS_MISC = 33 * MiB;
constexpr size_t MS_LOGI = WS_MISC;
constexpr size_t MS_LOGF = MS_LOGI + 256 * 1024;
constexpr size_t MS_BCUM = MS_LOGF + 256 * 1024;
constexpr size_t MS_KMEAN = MS_BCUM + 256 * 1024;
constexpr size_t MS_SEL = MS_KMEAN + 128 * 1024;
constexpr size_t MS_CHS = MS_SEL + 512 * 1024;
constexpr size_t MS_NST = MS_CHS + 64 * 1024;
constexpr size_t MS_SSQ1 = MS_NST + 256 * 1024;
constexpr size_t MS_SSQ2 = MS_SSQ1 + 1024 * 1024;
constexpr size_t MS_MASK = MS_SSQ2 + 1024 * 1024;
constexpr size_t MASK_STRIDE = (size_t)8 * 256 * 64;
static_assert(MS_MASK + 3 * 1024 * 1024 <= 40 * MiB, "misc");
constexpr size_t WS_A = 40 * MiB;
constexpr size_t WS_B = 72 * MiB;
constexpr size_t WS_C = 120 * MiB;
constexpr size_t WS_D = 184 * MiB;
constexpr size_t WS_HID = 120 * MiB;
constexpr size_t WS_END = 256 * MiB;
static_assert(WS_HID + (size_t)M * FF * 2 <= WS_END, "hidden overlay");

constexpr int CW_TMO = 0, CW_CODE = 1, CW_TOT = 2048  , CW_BAR = 4096, CW_KSUM = 65536  ;

constexpr int RING_OFF = 0, RING_BYTES = 131072;
constexpr int LDS_BYTES = 147456;
constexpr int LDSCTL_OFF = LDS_BYTES - 512, MISC_OFF = LDSCTL_OFF + 320;


__device__ __forceinline__ float bf2f(unsigned short v) { return __uint_as_float((unsigned)v << 16); }
__device__ __forceinline__ float blo(unsigned w) { return __uint_as_float(w << 16); }
__device__ __forceinline__ float bhi(unsigned w) { return __uint_as_float(w & 0xffff0000u); }
__device__ __forceinline__ float wave_sum(float v) {
#pragma unroll
    for (int o = 1; o < 64; o <<= 1) v += __shfl_xor(v, o);
    return v;
}
__device__ __forceinline__ float wave_max(float v) {
#pragma unroll
    for (int o = 1; o < 64; o <<= 1) v = fmaxf(v, __shfl_xor(v, o));
    return v;
}
__device__ __forceinline__ float sigm(float x) { return 1.0f / (1.0f + __expf(-x)); }

struct Frame {
    LAS unsigned char* lds;
    volatile LAS unsigned* MISC;
    gu32* ctl;
    int tid, lane, wave, vcu, G;
    float* out; unsigned char* ws;
};
typedef const float* cfptr;
#define INP(k) (((LAS cfptr*)(F.lds + LDSCTL_OFF))[k])
#define IN_X INP(0)
#define IN_MIXG INP(1)
#define IN_WIN INP(2)
#define IN_CONV INP(3)
#define IN_BIG INP(4)
#define IN_BFG INP(5)
#define IN_MNG INP(6)
#define IN_WOA INP(7)
#define IN_WOM INP(8)
#define IN_WO INP(9)
#define IN_FFNG INP(10)
#define IN_WFG INP(11)
#define IN_WFU INP(12)
#define IN_WFD INP(13)
#define IN_FING INP(14)
#define WSP(T, off) ((T*)(F.ws + (off)))

__device__ __forceinline__ void tr_item(const float* W, int ldw, int k0, int n_src0, bf16* WT, int ldt, int dst_row0, const float* kscale, LAS float* scr, int lane) {
#pragma unroll 8
    for (int i = 0; i < 32; ++i) { const int kk = 2 * i + (lane >> 5); float v = W[(size_t)(k0 + kk) * ldw + n_src0 + (lane & 31)]; if (kscale) v *= kscale[k0 + kk]; scr[kk * 33 + (lane & 31)] = v; }
    LDS_WAIT(); asm volatile("" ::: "memory");
    const int c = lane & 7;
#pragma unroll
    for (int j = 0; j < 4; ++j) { const int n = (lane >> 3) + 8 * j; const LAS float* s = scr + (8 * c) * 33 + n;
        v4u o; o.x = pk2(s[0 * 33], s[1 * 33]); o.y = pk2(s[2 * 33], s[3 * 33]); o.z = pk2(s[4 * 33], s[5 * 33]); o.w = pk2(s[6 * 33], s[7 * 33]);
        *(GAS v4u*)(WT + (size_t)(dst_row0 + n) * ldt + k0 + 8 * c) = o; }
    LDS_WAIT(); asm volatile("" ::: "memory");
}
__device__ __forceinline__ float log_sigmoid(float z) { return fminf(z, 0.f) - log1pf(__expf(-fabsf(z))); }

__device__ __forceinline__ void p0_prologue(Frame& F) {
    const int gw = F.vcu * NWAVES + F.wave, NGW = F.G * NWAVES, lane = F.lane;
    LAS float* gt = (LAS float*)(F.lds + RING_OFF);
    for (int i = F.tid; i < 8192; i += NWAVES * 64) { const int k = i >> 3, c = i & 7; gt[c * 1024 + k] = IN_WIN[(size_t)k * INW + 3584 + c]; }
    __syncthreads();
    LAS float* scr = (LAS float*)(F.lds + RING_OFF + 32768 + F.wave * 8704);
    constexpr int I_IN = 16 * 176, I_GU = 16 * 88, I_D = 44 * 32, I_O = 16 * 32, I_A = 8 * 32;
    constexpr int NITEMS = I_IN + 2 * I_GU + I_D + I_O + 2 * I_A;
    bf16* Win = WSP(bf16, WS_WIN); bf16* Wgu = WSP(bf16, WS_WGU); bf16* Wd = WSP(bf16, WS_WD); bf16* Wo = WSP(bf16, WS_WO); bf16* Wa = WSP(bf16, WS_WA); bf16* Wm = WSP(bf16, WS_WM);
    for (int it = gw; it < NITEMS; it += NGW) {
        int r = it;
        if (r < I_IN) { const int kb = r / 176, nb = r % 176; const int ns = nb < 112 ? 32 * nb : 3592 + 32 * (nb - 112), nd = nb < 112 ? 32 * nb : 3584 + 32 * (nb - 112);
            tr_item(IN_WIN, INW, 64 * kb, ns, Win, D, nd, nullptr, scr, lane); continue; } r -= I_IN;
        if (r < I_GU) { const int kb = r / 88, nb = r % 88; tr_item(IN_WFG, FF, 64 * kb, 32 * nb, Wgu, D, 256 * (nb >> 2) + 32 * (nb & 3), IN_FFNG, scr, lane); continue; } r -= I_GU;
        if (r < I_GU) { const int kb = r / 88, nb = r % 88; tr_item(IN_WFU, FF, 64 * kb, 32 * nb, Wgu, D, 256 * (nb >> 2) + 128 + 32 * (nb & 3), IN_FFNG, scr, lane); continue; } r -= I_GU;
        if (r < I_D) { const int kb = r / 32, nb = r % 32; tr_item(IN_WFD, D, 64 * kb, 32 * nb, Wd, FF, 32 * nb, nullptr, scr, lane); continue; } r -= I_D;
        if (r < I_O) { const int kb = r / 32, nb = r % 32; tr_item(IN_WO, D, 64 * kb, 32 * nb, Wo, D, 32 * nb, nullptr, scr, lane); continue; } r -= I_O;
        if (r < I_A) { const int kb = r / 32, nb = r % 32; tr_item(IN_WOA, D, 64 * kb, 32 * nb, Wa, AW, 32 * nb, nullptr, scr, lane); continue; } r -= I_A;
        { const int kb = r / 32, nb = r % 32; tr_item(IN_WOM, D, 64 * kb, 32 * nb, Wm, MW, 32 * nb, nullptr, scr, lane); }
    }
    bf16* Hn = WSP(bf16, WS_A); float* logi = WSP(float, MS_LOGI); float* logf = WSP(float, MS_LOGF);
    f32x4 gv[4];
#pragma unroll
    for (int j = 0; j < 4; ++j) gv[j] = ((const GAS f32x4*)IN_MIXG)[lane + 64 * j];
    for (int m = gw; m < M; m += NGW) {
        const GAS f32x4* xr = (const GAS f32x4*)(IN_X + (size_t)m * D) + lane;
        f32x4 v[4]; float s = 0.f;
#pragma unroll
        for (int j = 0; j < 4; ++j) { v[j] = xr[64 * j]; s += (v[j].x * v[j].x + v[j].y * v[j].y) + (v[j].z * v[j].z + v[j].w * v[j].w); }
        const float rstd = 1.0f / sqrtf(wave_sum(s) * (1.f / D) + EPS);
#pragma unroll
        for (int j = 0; j < 4; ++j) v[j] = v[j] * rstd * gv[j];
        GAS unsigned long long* o8 = (GAS unsigned long long*)(Hn + (size_t)m * D) + lane;
#pragma unroll
        for (int j = 0; j < 4; ++j) o8[64 * j] = (unsigned long long)pk2(v[j].x, v[j].y) | ((unsigned long long)pk2(v[j].z, v[j].w) << 32);
        float ga[8];
#pragma unroll
        for (int c = 0; c < 8; ++c) { float a = 0.f;
#pragma unroll
            for (int j = 0; j < 4; ++j) { const f32x4 w = *(const LAS f32x4*)(gt + c * 1024 + 4 * lane + 256 * j); a += (v[j].x * w.x + v[j].y * w.y) + (v[j].z * w.z + v[j].w * w.w); }
            ga[c] = wave_sum(a); }
#pragma unroll
        for (int c = 0; c < 4; ++c) { if (lane == c) logi[(size_t)m * 4 + c] = ga[c] + IN_BIG[c]; if (lane == 4 + c) logf[(size_t)m * 4 + c] = log_sigmoid(ga[4 + c] + IN_BFG[c]); }
    }
}

__device__ __forceinline__ float wave_incl_scan(float v, int lane) {
#pragma unroll
    for (int o = 1; o < 64; o <<= 1) { const float t = __shfl_up(v, o); if (lane >= o) v += t; }
    return v;
}
__device__ __forceinline__ void gate_prep(Frame& F) {
    const int gw = F.vcu * NWAVES + F.wave, NGW = F.G * NWAVES, lane = F.lane;
    const float* logi = WSP(float, MS_LOGI); const float* logf = WSP(float, MS_LOGF); float* bcum = WSP(float, MS_BCUM); float* chs = WSP(float, MS_CHS);
    for (int it = gw; it < MH * NCH; it += NGW) { const int h = it >> 7, c = it & 127, t0 = c * CL;
        float v0 = logf[(size_t)(t0 + lane) * 4 + h], v1 = logf[(size_t)(t0 + 64 + lane) * 4 + h];
        v0 = wave_incl_scan(v0, lane); const float tot0 = __shfl(v0, 63); v1 = wave_incl_scan(v1, lane) + tot0; const float bl = __shfl(v1, 63);
        bcum[(size_t)h * M + t0 + lane] = v0; bcum[(size_t)h * M + t0 + 64 + lane] = v1;
        const float g0 = bl - v0 + logi[(size_t)(t0 + lane) * 4 + h], g1 = bl - v1 + logi[(size_t)(t0 + 64 + lane) * 4 + h];
        const float gm = wave_max(fmaxf(g0, g1));
        if (lane == 0) { chs[0 * 512 + it] = bl; chs[1 * 512 + it] = gm; } }
}
__device__ __forceinline__ void conv8(const bf16* src, int t, int c0, const float* cw, float scale, float (&acc)[8]) {
#pragma unroll
    for (int e = 0; e < 8; ++e) acc[e] = 0.f;
#pragma unroll
    for (int j = 0; j < 4; ++j) { const int tt = t - 3 + j; if (tt >= 0) { const v4u w = *(const GAS v4u*)(src + (size_t)tt * 512 + c0); const f32x4 w0 = *(const GAS f32x4*)(cw + (size_t)j * 1024), w1 = *(const GAS f32x4*)(cw + (size_t)j * 1024 + 4);
            acc[0] += blo(w.x) * w0.x; acc[1] += bhi(w.x) * w0.y; acc[2] += blo(w.y) * w0.z; acc[3] += bhi(w.y) * w0.w; acc[4] += blo(w.z) * w1.x; acc[5] += bhi(w.z) * w1.y; acc[6] += blo(w.w) * w1.z; acc[7] += bhi(w.w) * w1.w; } }
#pragma unroll
    for (int e = 0; e < 8; ++e) acc[e] = acc[e] * sigm(acc[e]) * scale;
}

__device__ __forceinline__ void p3_scan(Frame& F, float* Cl) {
    const int tid = F.tid;
    float* nst = WSP(float, MS_NST); const float* chs = WSP(float, MS_CHS);
    const int gt = F.vcu * (NWAVES * 64) + tid, NGT = F.G * NWAVES * 64;
    for (int idx = gt; idx < MH * 16384 + MH * 128; idx += NGT) {
        const bool isc = idx < MH * 16384; const int i2 = isc ? idx : idx - MH * 16384;
        const int h = isc ? (i2 >> 14) : (i2 >> 7), el = isc ? (i2 & 16383) : (i2 & 127);
        float* base = isc ? (Cl + ((size_t)(h * 128) << 14) + el) : (nst + (size_t)(h * 128) * 128 + el);
        const size_t stride = isc ? 16384 : 128; float a = 0.f;
        for (int c0 = 0; c0 < NCH; c0 += 16) { float v[16];
#pragma unroll
            for (int i = 0; i < 16; ++i) v[i] = base[(size_t)(c0 + i) * stride];
#pragma unroll
            for (int i = 0; i < 16; ++i) { a = chs[4 * 512 + h * 128 + c0 + i] * a + v[i]; v[i] = a; }
#pragma unroll
            for (int i = 0; i < 16; ++i) base[(size_t)(c0 + i) * stride] = v[i]; }
    }
}
typedef float f32x16 __attribute__((ext_vector_type(16)));
typedef short s16x4 __attribute__((ext_vector_type(4)));
typedef short v4i16_t __attribute__((ext_vector_type(4)));
typedef unsigned u32x4a __attribute__((ext_vector_type(4)));
__device__ __forceinline__ int crow(int r, int hi) { return (r & 3) + 8 * (r >> 2) + 4 * hi; }
__device__ __forceinline__ unsigned cvtpk(float lo, float hi) { unsigned r; asm("v_cvt_pk_bf16_f32 %0, %1, %2" : "=v"(r) : "v"(lo), "v"(hi)); return r; }
__device__ __forceinline__ s16x4 vtr(const LAS unsigned char* p) { return __builtin_bit_cast(s16x4, __builtin_amdgcn_ds_read_tr16_b64_v4i16((LAS v4i16_t*)p)); }
__device__ __forceinline__ float swapmax(float m) { auto rr = __builtin_amdgcn_permlane32_swap(__float_as_uint(m), __float_as_uint(m), false, false); return fmaxf(__uint_as_float(rr[0]), __uint_as_float(rr[1])); }
__device__ __forceinline__ float swapsum(float m) { auto rr = __builtin_amdgcn_permlane32_swap(__float_as_uint(m), __float_as_uint(m), false, false); return __uint_as_float(rr[0]) + __uint_as_float(rr[1]); }

__device__ __forceinline__ void attn_tile(const LAS unsigned char* Kl, const LAS unsigned char* Vl, const bf16x8 (&qr)[4], int nkb, bool diag, int qrel, float ch, int lane,
                                          f32x16& o0, f32x16& o1, float& mxo, float& lo_) {
    const int r32 = lane & 31, hi = lane >> 5;
    f32x16 p[8];
    const float base = ch * (float)(4 * hi - qrel);
    const LAS unsigned char* kb0 = Kl + hi * 4096 + r32 * 16;
#pragma unroll
    for (int kb = 0; kb < 8; ++kb) {
        if (kb < nkb) {
            f32x16 c;
#pragma unroll
            for (int r = 0; r < 16; ++r) c[r] = __builtin_fmaf(ch, (float)(32 * kb + (r & 3) + 8 * (r >> 2)), base);
#pragma unroll
            for (int d0 = 0; d0 < 4; ++d0) { const bf16x8 ka = *(const LAS bf16x8*)(kb0 + d0 * 8192 + kb * 512); c = __builtin_amdgcn_mfma_f32_32x32x16_bf16(ka, qr[d0], c, 0, 0, 0); }
            if (diag && kb == nkb - 1) {
#pragma unroll
                for (int r = 0; r < 16; ++r) if (32 * kb + crow(r, hi) > qrel) c[r] = -INFINITY;
            }
            p[kb] = c;
        }
    }
    float mx = -INFINITY;
#pragma unroll
    for (int kb = 0; kb < 8; ++kb) if (kb < nkb) {
#pragma unroll
        for (int r = 0; r < 16; ++r) mx = fmaxf(mx, p[kb][r]);
    }
    mx = swapmax(mx);
    float l = 0.f;
    u32x4a pw[8][2];
#pragma unroll
    for (int kb = 0; kb < 8; ++kb) {
        if (kb < nkb) {
            f32x16 e;
#pragma unroll
            for (int r = 0; r < 16; ++r) { e[r] = __builtin_amdgcn_exp2f(p[kb][r] - mx); l += e[r]; }
            pw[kb][0] = (u32x4a){cvtpk(e[0], e[1]), cvtpk(e[2], e[3]), cvtpk(e[4], e[5]), cvtpk(e[6], e[7])};
            pw[kb][1] = (u32x4a){cvtpk(e[8], e[9]), cvtpk(e[10], e[11]), cvtpk(e[12], e[13]), cvtpk(e[14], e[15])};
        } else { pw[kb][0] = (u32x4a){0u, 0u, 0u, 0u}; pw[kb][1] = (u32x4a){0u, 0u, 0u, 0u}; }
    }
    l = swapsum(l);
    f32x16 a0, a1;
#pragma unroll
    for (int r = 0; r < 16; ++r) { a0[r] = 0.f; a1[r] = 0.f; }
    const LAS unsigned char* vb = Vl + ((lane >> 4) & 1) * 32 + (lane & 3) * 8 + (4 * hi + ((lane & 15) >> 2)) * 64;
#pragma unroll
    for (int kb = 0; kb < 8; ++kb) {
        if ((kb & ~1) < nkb) {
#pragma unroll
            for (int k2 = 0; k2 < 2; ++k2) {
                const bf16x8 pa = __builtin_bit_cast(bf16x8, pw[kb][k2]);
                const LAS unsigned char* vp = vb + (kb * 2 + k2) * 1024;
                const s16x4 l0 = vtr(vp), h0 = vtr(vp + 512), l1 = vtr(vp + 16384), h1 = vtr(vp + 16384 + 512);
                const bf16x8 v0 = (bf16x8){l0[0], l0[1], l0[2], l0[3], h0[0], h0[1], h0[2], h0[3]};
                const bf16x8 v1 = (bf16x8){l1[0], l1[1], l1[2], l1[3], h1[0], h1[1], h1[2], h1[3]};
                a0 = __builtin_amdgcn_mfma_f32_32x32x16_bf16(pa, v0, a0, 0, 0, 0);
                a1 = __builtin_amdgcn_mfma_f32_32x32x16_bf16(pa, v1, a1, 0, 0, 0);
            }
        }
    }
    o0 = a0; o1 = a1; mxo = mx; lo_ = l;
}

__device__ __forceinline__ void load_kv_tile(const bf16* Kt, const bf16* Vt, int h, int j, LAS unsigned char* Kl, LAS unsigned char* Vl, int tid) {
    const GAS unsigned char* ks = (const GAS unsigned char*)Kt + (size_t)(h * 64 + j) * 32768; const GAS unsigned char* vs = (const GAS unsigned char*)Vt + (size_t)(h * 64 + j) * 32768;
#pragma unroll
    for (int i = 0; i < 4; ++i) { const unsigned off = (unsigned)(tid + 512 * i) * 16u; *(LAS v4u*)(Kl + off) = *(const GAS v4u*)(ks + off); *(LAS v4u*)(Vl + off) = *(const GAS v4u*)(vs + off); }
}
__device__ __forceinline__ int select_bit(unsigned long long m, int k) {
    int pos = 0; unsigned x = (unsigned)m; int c = __popc(x);
    if (k >= c) { k -= c; pos = 32; x = (unsigned)(m >> 32); }
    c = __popc(x & 0xffffu); if (k >= c) { k -= c; pos += 16; x >>= 16; }
    c = __popc(x & 0xffu); if (k >= c) { k -= c; pos += 8; x >>= 8; }
    c = __popc(x & 0xfu); if (k >= c) { k -= c; pos += 4; x >>= 4; }
    c = __popc(x & 0x3u); if (k >= c) { k -= c; pos += 2; x >>= 2; }
    c = (int)(x & 1u); if (k >= c) pos += 1;
    return pos;
}
__device__ __forceinline__ int block_incl_scan(int v, LAS int* scr, int lane, int wave) {
#pragma unroll
    for (int o = 1; o < 64; o <<= 1) { const int t = __shfl_up(v, o); if (lane >= o) v += t; }
    __syncthreads();
    if (lane == 63) scr[wave] = v;
    __syncthreads();
    int add = 0;
#pragma unroll
    for (int w = 0; w < 8; ++w) { const int t = scr[w]; if (w < wave) add += t; }
    return v + add;
}
__device__ __forceinline__ bool gbetter(float va, int ja, float vb, int jb) { return va > vb || (va == vb && ja < jb); }
__device__ __forceinline__ void top3_insert(float s, int j, float& v0, float& v1, float& v2, int& j0, int& j1, int& j2) {
    const bool b0 = gbetter(s, j, v0, j0), b1 = gbetter(s, j, v1, j1), b2 = gbetter(s, j, v2, j2);
    const float n2 = b1 ? v1 : (b2 ? s : v2), n1 = b0 ? v0 : (b1 ? s : v1), n0 = b0 ? s : v0;
    const int m2 = b1 ? j1 : (b2 ? j : j2), m1 = b0 ? j0 : (b1 ? j : j1), m0 = b0 ? j : j0;
    v0 = n0; v1 = n1; v2 = n2; j0 = m0; j1 = m1; j2 = m2;
}
__device__ __forceinline__ unsigned swapu(unsigned x, int hi) { auto rr = __builtin_amdgcn_permlane32_swap(x, x, false, false); return hi ? rr[0] : rr[1]; }

__device__ __forceinline__ void p2_gating(Frame& F, bool count) {
    const int wave = F.wave;
    const bf16* qa = WSP(bf16, WS_B); const float* ksum = (const float*)(F.ctl + CW_KSUM); unsigned* sel = WSP(unsigned, MS_SEL); unsigned long long* mask3 = WSP(unsigned long long, MS_MASK); unsigned* tot = (unsigned*)(F.ctl + CW_TOT);
    LAS unsigned char* kmb = F.lds + RING_OFF; LAS unsigned long long* wm = (LAS unsigned long long*)(F.lds + RING_OFF + 65536) + wave * 192;
    for (int qg = F.vcu; qg < M / 64; qg += F.G) {
        int tid = F.tid; asm volatile("" : "+v"(tid));
        const int lane = tid & 63, r32 = lane & 31, hi = lane >> 5;
        const int b = qg >> 2, h = wave;
        __syncthreads();
#pragma unroll 2
        for (int i = 0; i < 8; ++i) { const int p = tid + 512 * i, hh = p >> 9, j = (p >> 3) & 63, c = p & 7;
            const f32x4 a = *(const GAS f32x4*)(ksum + ((size_t)(hh * 64 + j)) * 64 + c * 8), bb = *(const GAS f32x4*)(ksum + ((size_t)(hh * 64 + j)) * 64 + c * 8 + 4);
            const float sc = 1.0f / 256.0f;
            *(LAS v4u*)(kmb + hh * 8192 + c * 1024 + j * 16) = (v4u){pk2(a.x * sc, a.y * sc), pk2(a.z * sc, a.w * sc), pk2(bb.x * sc, bb.y * sc), pk2(bb.z * sc, bb.w * sc)}; }
        for (int i = lane; i < 192; i += 64) wm[i] = 0ull;
        __syncthreads();
        const int n = b < 3 ? b : 3;
#pragma unroll 1
        for (int tt = 0; tt < 2; ++tt) {
            const int q = qg * 64 + tt * 32 + r32;
            bf16x8 qr[4];
#pragma unroll
            for (int d0 = 0; d0 < 4; ++d0) qr[d0] = *(const GAS bf16x8*)(qa + (size_t)q * 512 + h * 64 + d0 * 16 + hi * 8);
            f32x16 c0, c1;
#pragma unroll
            for (int r = 0; r < 16; ++r) { c0[r] = 0.f; c1[r] = 0.f; }
            const LAS unsigned char* kb0 = kmb + h * 8192 + hi * 1024 + r32 * 16;
#pragma unroll
            for (int d0 = 0; d0 < 4; ++d0) { const bf16x8 k0 = *(const LAS bf16x8*)(kb0 + d0 * 2048), k1 = *(const LAS bf16x8*)(kb0 + d0 * 2048 + 512);
                c0 = __builtin_amdgcn_mfma_f32_32x32x16_bf16(k0, qr[d0], c0, 0, 0, 0); c1 = __builtin_amdgcn_mfma_f32_32x32x16_bf16(k1, qr[d0], c1, 0, 0, 0); }
            float v0 = -INFINITY, v1 = -INFINITY, v2 = -INFINITY; int j0 = 64, j1 = 64, j2 = 64;
#pragma unroll
            for (int r = 0; r < 16; ++r) { const int j = crow(r, hi); if (j < b) top3_insert(c0[r], j, v0, v1, v2, j0, j1, j2); }
#pragma unroll
            for (int r = 0; r < 16; ++r) { const int j = 32 + crow(r, hi); if (j < b) top3_insert(c1[r], j, v0, v1, v2, j0, j1, j2); }
            { const float pv0 = __uint_as_float(swapu(__float_as_uint(v0), hi)), pv1 = __uint_as_float(swapu(__float_as_uint(v1), hi)), pv2 = __uint_as_float(swapu(__float_as_uint(v2), hi));
              const int pj0 = (int)swapu((unsigned)j0, hi), pj1 = (int)swapu((unsigned)j1, hi), pj2 = (int)swapu((unsigned)j2, hi);
              top3_insert(pv0, pj0, v0, v1, v2, j0, j1, j2); top3_insert(pv1, pj1, v0, v1, v2, j0, j1, j2); top3_insert(pv2, pj2, v0, v1, v2, j0, j1, j2); }
            if (hi == 0) {
                sel[(size_t)h * M + q] = (unsigned)(j0 & 63) | ((unsigned)(j1 & 63) << 8) | ((unsigned)(j2 & 63) << 16) | ((unsigned)n << 24);
                const unsigned long long bit = 1ull << (tt * 32 + r32);
                if (n > 0) __hip_atomic_fetch_or(wm + j0, bit, __ATOMIC_RELAXED, __HIP_MEMORY_SCOPE_WORKGROUP);
                if (n > 1) __hip_atomic_fetch_or(wm + 64 + j1, bit, __ATOMIC_RELAXED, __HIP_MEMORY_SCOPE_WORKGROUP);
                if (n > 2) __hip_atomic_fetch_or(wm + 128 + j2, bit, __ATOMIC_RELAXED, __HIP_MEMORY_SCOPE_WORKGROUP);
            }
        }
        asm volatile("s_waitcnt lgkmcnt(0)" ::: "memory");
        if (lane < b) { const unsigned long long m0 = wm[lane], m1 = wm[64 + lane], m2 = wm[128 + lane], all = m0 | m1 | m2; const size_t mi = ((size_t)h * 256 + qg) * 64 + lane;
            mask3[mi] = all; mask3[MASK_STRIDE + mi] = m0; mask3[2 * MASK_STRIDE + mi] = m1;
            const int pc = __popcll(all); if (pc && count) atomicAdd(tot + h * 64 + lane, (unsigned)pc); }
    }
    __syncthreads();
}

__device__ __forceinline__ int pos2j(int u) { return (u & 1) ? 63 - (u >> 1) : (u >> 1); }
__device__ __forceinline__ void p3_attn_selected(Frame& F) {
    const int wave = F.wave;
    const bf16* Qa = WSP(bf16, WS_B); const bf16* Kt = Qa + (size_t)M * 512; const bf16* Vt = Kt + (size_t)M * 512;
    const unsigned long long* mask3 = WSP(unsigned long long, MS_MASK); const unsigned* tot = (const unsigned*)(F.ctl + CW_TOT);
    bf16* Op = (bf16*)F.out; float* Lp = (float*)((unsigned char*)F.out + 48 * MiB);
    LAS unsigned char* Kl = F.lds + RING_OFF; LAS unsigned char* Vl = F.lds + RING_OFF + 32768;
    LAS int* pre = (LAS int*)(F.lds + RING_OFF + 65536); LAS int* gpx = pre + 520; LAS unsigned long long* lm = (LAS unsigned long long*)(gpx + 264); LAS int* scr = (LAS int*)(lm + 768);
    LAS unsigned char* wbase = F.lds + RING_OFF + 81920 + wave * 4608; LAS bf16* stg = (LAS bf16*)wbase; LAS int* rowq = (LAS int*)(wbase + 4096); LAS int* rowslot = rowq + 32; LAS float* rinv = (LAS float*)(rowslot + 32);
    { const int p = F.tid, n = (int)tot[(p & ~63) + pos2j(p & 63)]; const int inc = block_incl_scan((n + 31) >> 5, scr, F.lane, wave); pre[p + 1] = inc; if (p == 0) pre[0] = 0; }
    __syncthreads();
    const int TOTAL = pre[512];
    const int t_lo = (int)(((long)TOTAL * F.vcu) / F.G), t_hi = (int)(((long)TOTAL * (F.vcu + 1)) / F.G);
    for (int t = t_lo; t < t_hi;) {
        int tid = F.tid; asm volatile("" : "+v"(tid));
        const int lane = tid & 63, r32 = lane & 31, hi = lane >> 5;
        int a = 0, b = 512;
        while (b - a > 1) { const int mid = (a + b) >> 1; if (pre[mid] <= t) a = mid; else b = mid; }
        const int h = a >> 6, j = pos2j(a & 63), item = h * 64 + j, seg_end = pre[a + 1] < t_hi ? pre[a + 1] : t_hi, tl0 = t - pre[a], nseg = seg_end - t, n_item = (int)tot[item];
        __syncthreads();
        load_kv_tile(Kt, Vt, h, j, Kl, Vl, tid);
        int pc = 0;
        if (tid < 256) { unsigned long long mk = 0ull, m0 = 0ull, m1 = 0ull; if (tid >= 4 * (j + 1)) { const size_t mi = ((size_t)h * 256 + tid) * 64 + j; mk = mask3[mi]; m0 = mask3[MASK_STRIDE + mi]; m1 = mask3[2 * MASK_STRIDE + mi]; }
            lm[tid] = mk; lm[256 + tid] = m0; lm[512 + tid] = m1; pc = __popcll(mk); }
        const int inc = block_incl_scan(pc, scr, lane, wave);
        if (tid < 256) gpx[tid + 1] = inc; if (tid == 0) gpx[0] = 0;
        __syncthreads();
        const float ch = exp2f(-(float)(h + 1)) * LOG2E;
        bf16x8 qn[4]; int qnext = 0, slotnext = 0; bool validnext = false;
#define P3_PREFETCH(kk) do { const int row_ = 32 * (tl0 + (kk)) + r32; validnext = row_ < n_item; const int rowc_ = validnext ? row_ : 32 * (tl0 + (kk)); \
            int a2 = 0, b2 = 256; while (b2 - a2 > 1) { const int mid = (a2 + b2) >> 1; if (gpx[mid] <= rowc_) a2 = mid; else b2 = mid; } \
            const int pos_ = select_bit(lm[a2], rowc_ - gpx[a2]); qnext = a2 * 64 + pos_; \
            slotnext = ((lm[256 + a2] >> pos_) & 1ull) ? 0 : (((lm[512 + a2] >> pos_) & 1ull) ? 1 : 2); \
            _Pragma("unroll") for (int d0 = 0; d0 < 4; ++d0) qn[d0] = *(const GAS bf16x8*)(Qa + (size_t)qnext * 512 + h * 64 + d0 * 16 + hi * 8); } while (0)
        if (wave < nseg) P3_PREFETCH(wave);
#pragma unroll 1
        for (int k = wave; k < nseg; k += 8) {
            bf16x8 qr[4];
#pragma unroll
            for (int d0 = 0; d0 < 4; ++d0) qr[d0] = qn[d0];
            const int q = qnext, slot = slotnext; const bool valid = validnext;
            if (hi == 0) { rowq[r32] = valid ? q : -1; rowslot[r32] = slot; }
            if (k + 8 < nseg) P3_PREFETCH(k + 8);
            f32x16 o0, o1; float mx, l;
            attn_tile(Kl, Vl, qr, 8, false, q - j * 256, ch, lane, o0, o1, mx, l);
            if (hi == 0) { rinv[r32] = 1.0f / l; if (valid) Lp[((size_t)q * 8 + h) * 3 + slot] = mx + __log2f(l); }
            asm volatile("s_waitcnt lgkmcnt(0)" ::: "memory");
#pragma unroll
            for (int r = 0; r < 16; ++r) { const int rr = crow(r, hi); const float rl = rinv[rr]; stg[rr * 64 + r32] = (bf16)f2bf(o0[r] * rl); stg[rr * 64 + 32 + r32] = (bf16)f2bf(o1[r] * rl); }
            asm volatile("s_waitcnt lgkmcnt(0)" ::: "memory");
#pragma unroll
            for (int i = 0; i < 4; ++i) { const int idx = i * 64 + lane, rr = idx >> 3, pc8 = idx & 7; const int qq = rowq[rr];
                if (qq >= 0) *(GAS v4u*)(Op + (((size_t)qq * 8 + h) * 3 + rowslot[rr]) * 64 + pc8 * 8) = *(const LAS v4u*)(stg + rr * 64 + pc8 * 8); }
            asm volatile("s_waitcnt lgkmcnt(0)" ::: "memory");
        }
#undef P3_PREFETCH
        t = seg_end;
    }
    __syncthreads();
}

__device__ __forceinline__ void p4_attn_own(Frame& F, bf16* Ydst, int qmask) {
    const int wave = F.wave;
    bf16* Qa = WSP(bf16, WS_B); const bf16* Kt = Qa + (size_t)M * 512; const bf16* Vt = Kt + (size_t)M * 512;
    const bf16* Op = (const bf16*)F.out; const float* Lp = (const float*)((const unsigned char*)F.out + 48 * MiB);
    LAS unsigned char* Kl = F.lds + RING_OFF; LAS unsigned char* Vl = F.lds + RING_OFF + 32768;
    LAS unsigned char* wbase = F.lds + RING_OFF + 65536 + wave * 4608; LAS bf16* stg = (LAS bf16*)wbase; LAS float* tab = (LAS float*)(wbase + 4096);
    for (int it = F.vcu; it < AH * NBLK; it += F.G) {
        int tid = F.tid; asm volatile("" : "+v"(tid));
        const int lane = tid & 63, r32 = lane & 31, hi = lane >> 5;
        const int h = it >> 6, b = it & 63, qt = wave;
        __syncthreads();
        load_kv_tile(Kt, Vt, h, b, Kl, Vl, tid);
        __syncthreads();
        const int q0 = b * 256 + qt * 32, q = q0 + r32;
        bf16x8 qr[4];
#pragma unroll
        for (int d0 = 0; d0 < 4; ++d0) qr[d0] = *(const GAS bf16x8*)(Qa + (size_t)q * 512 + h * 64 + d0 * 16 + hi * 8);
        const float ch = exp2f(-(float)(h + 1)) * LOG2E;
        f32x16 o0, o1; float mx, l;
        attn_tile(Kl, Vl, qr, qt + 1, true, qt * 32 + r32, ch, lane, o0, o1, mx, l);
        const int n = b < 3 ? b : 3;
        if (hi == 0) { const float lse = mx + __log2f(l); float ls[3]; float big = lse;
#pragma unroll
            for (int s = 0; s < 3; ++s) { ls[s] = (s < n) ? Lp[((size_t)q * 8 + h) * 3 + s] : -INFINITY; big = fmaxf(big, ls[s]); }
            const float wo = __builtin_amdgcn_exp2f(lse - big); float w[3]; float den = wo;
#pragma unroll
            for (int s = 0; s < 3; ++s) { w[s] = __builtin_amdgcn_exp2f(ls[s] - big); den += w[s]; }
            const float rd = 1.0f / den; tab[r32] = wo * rd / l; tab[32 + r32] = w[0] * rd; tab[64 + r32] = w[1] * rd; tab[96 + r32] = w[2] * rd; }
        asm volatile("s_waitcnt lgkmcnt(0)" ::: "memory");
#pragma unroll
        for (int r = 0; r < 16; ++r) { const float w = tab[crow(r, hi)]; o0[r] *= w; o1[r] *= w; }
#pragma unroll 1
        for (int s = 0; s < n; ++s) {
#pragma unroll
            for (int i = 0; i < 4; ++i) { const int idx = i * 64 + lane, rr = idx >> 3, pc8 = idx & 7;
                *(LAS v4u*)(stg + rr * 64 + pc8 * 8) = *(const GAS v4u*)(Op + (((size_t)(q0 + rr) * 8 + h) * 3 + s) * 64 + pc8 * 8); }
            asm volatile("s_waitcnt vmcnt(0) lgkmcnt(0)" ::: "memory");
#pragma unroll
            for (int r = 0; r < 16; ++r) { const int rr = crow(r, hi); const float w = tab[32 + 32 * s + rr]; o0[r] += w * bf2f(stg[rr * 64 + r32]); o1[r] += w * bf2f(stg[rr * 64 + 32 + r32]); }
            asm volatile("s_waitcnt lgkmcnt(0)" ::: "memory");
        }
#pragma unroll
        for (int r = 0; r < 16; ++r) { const int rr = crow(r, hi); stg[rr * 64 + r32] = (bf16)f2bf(o0[r]); stg[rr * 64 + 32 + r32] = (bf16)f2bf(o1[r]); }
        asm volatile("s_waitcnt lgkmcnt(0)" ::: "memory");
#pragma unroll
        for (int i = 0; i < 4; ++i) { const int idx = i * 64 + lane, rr = idx >> 3, pc8 = idx & 7;
            *(GAS v4u*)(Ydst + (size_t)((q0 + rr) & qmask) * 512 + h * 64 + pc8 * 8) = *(const LAS v4u*)(stg + rr * 64 + pc8 * 8); }
        asm volatile("s_waitcnt lgkmcnt(0)" ::: "memory");
    }
    __syncthreads();
}
__device__ __forceinline__ void mscan_wave(const float* chs, int h, int c, int lane, float& mprev, float& mnew) {
    const float b0 = chs[0 * 512 + h * 128 + 2 * lane], b1 = chs[0 * 512 + h * 128 + 2 * lane + 1], g0 = chs[1 * 512 + h * 128 + 2 * lane], g1 = chs[1 * 512 + h * 128 + 2 * lane + 1];
    float A = b0 + b1, G = fmaxf(b1 + g0, g1);
#pragma unroll
    for (int o = 1; o < 64; o <<= 1) { const float Ap = __shfl_up(A, o), Gp = __shfl_up(G, o); if (lane >= o) { G = fmaxf(A + Gp, G); A = A + Ap; } }
    const float m_odd = fmaxf(A, G);
    float m_before = __shfl_up(m_odd, 1); if (lane == 0) m_before = 0.f;
    const float m_even = fmaxf(b0 + m_before, g0);
    const int src = c >> 1;
    const float me = __shfl(m_even, src), mo = __shfl(m_odd, src), mb = __shfl(m_before, src);
    if (c & 1) { mprev = me; mnew = mo; } else { mprev = mb; mnew = me; }
}
__device__ __forceinline__ int panel_off(int r, int ci  ) { return (ci >> 2) * 8192 + r * 64 + (ci & 3) * 16; }
__device__ __forceinline__ int chunk_off(int r, int ci) { return ci * 2048 + r * 16; }
__device__ __forceinline__ bf16x8 tr8(const LAS unsigned char* p, int second) { const s16x4 a = vtr(p), b = vtr(p + second); return (bf16x8){a[0], a[1], a[2], a[3], b[0], b[1], b[2], b[3]}; }

__device__ __forceinline__ void p2_cloc(Frame& F) {
    const int tid = F.tid, lane = F.lane, wave = F.wave, r32 = lane & 31, hi = lane >> 5;
    const bf16* km = WSP(bf16, WS_C) + (size_t)M * 512; const bf16* vm = WSP(bf16, WS_C) + (size_t)2 * M * 512;
    const float* logi = WSP(float, MS_LOGI); const float* bcum = WSP(float, MS_BCUM); float* chs = WSP(float, MS_CHS);
    float* Cl = WSP(float, WS_A); float* nst = WSP(float, MS_NST);
    LAS unsigned char* KW = F.lds + RING_OFF; LAS unsigned char* VV = F.lds + RING_OFF + 32768; LAS float* sh = (LAS float*)(F.lds + RING_OFF + 65536);
    const float* cwk = IN_CONV + 512;
    for (int it = F.vcu; it < MH * NCH; it += F.G) { const int h = it >> 7, c = it & 127, t0 = c * CL;
        __syncthreads();
        if (wave == 0) { float mp, mn; mscan_wave(chs, h, c, lane, mp, mn);
            if (lane == 0) { sh[0] = mp; sh[1] = mn; const float bl = chs[0 * 512 + it]; chs[2 * 512 + it] = mp; chs[3 * 512 + it] = mn; chs[4 * 512 + it] = __expf(bl + mp - mn); } }
        __syncthreads();
        if (tid < 128) { const float bl = chs[0 * 512 + it]; sh[8 + tid] = __expf(bl - bcum[(size_t)h * M + t0 + tid] + logi[(size_t)(t0 + tid) * 4 + h] - sh[1]); }
        __syncthreads();
#pragma unroll
        for (int i = 0; i < 4; ++i) { const int idx = tid + 512 * i, r = idx >> 4, ci = idx & 15; const float w = sh[8 + r];
            float kk[8]; conv8(km, t0 + r, h * 128 + ci * 8, cwk + h * 128 + ci * 8, 0.08838834764831845f, kk);
            v4u o;
            { const float k0 = bf2f((bf16)f2bf(kk[0])), k1 = bf2f((bf16)f2bf(kk[1])), k2 = bf2f((bf16)f2bf(kk[2])), k3 = bf2f((bf16)f2bf(kk[3])), k4 = bf2f((bf16)f2bf(kk[4])), k5 = bf2f((bf16)f2bf(kk[5])), k6 = bf2f((bf16)f2bf(kk[6])), k7 = bf2f((bf16)f2bf(kk[7]));
              o.x = pk2(k0 * w, k1 * w); o.y = pk2(k2 * w, k3 * w); o.z = pk2(k4 * w, k5 * w); o.w = pk2(k6 * w, k7 * w); }
            *(LAS v4u*)(KW + panel_off(r, ci)) = o;
            *(LAS v4u*)(VV + panel_off(r, ci)) = *(const GAS v4u*)(vm + (size_t)(t0 + r) * 512 + h * 128 + ci * 8); }
        __syncthreads();
        {
            const int db = wave >> 1, eb0 = 2 * (wave & 1);
            const int toff = (4 * hi + ((lane & 15) >> 2)) * 64 + ((lane >> 4) & 1) * 32 + (lane & 3) * 8;
            f32x16 a0, a1;
#pragma unroll
            for (int r = 0; r < 16; ++r) { a0[r] = 0.f; a1[r] = 0.f; }
#pragma unroll
            for (int ks = 0; ks < 8; ++ks) {
                const bf16x8 A = tr8(KW + db * 8192 + ks * 1024 + toff, 512);
                const bf16x8 B0 = tr8(VV + eb0 * 8192 + ks * 1024 + toff, 512), B1 = tr8(VV + (eb0 + 1) * 8192 + ks * 1024 + toff, 512);
                a0 = __builtin_amdgcn_mfma_f32_32x32x16_bf16(A, B0, a0, 0, 0, 0);
                a1 = __builtin_amdgcn_mfma_f32_32x32x16_bf16(A, B1, a1, 0, 0, 0);
            }
            float* dst = Cl + ((size_t)it * 128 + 32 * db) * 128 + 32 * eb0 + r32;
#pragma unroll
            for (int r = 0; r < 16; ++r) { const int d = crow(r, hi); dst[(size_t)d * 128] = a0[r]; dst[(size_t)d * 128 + 32] = a1[r]; }
        }
        {
            const int d = tid >> 2, part = tid & 3; float ns = 0.f;
            const LAS bf16* col = (const LAS bf16*)(KW + (d >> 5) * 8192 + (d & 31) * 2);
#pragma unroll 8
            for (int s = 0; s < 32; ++s) ns += bf2f(col[(part * 32 + s) * 32]);
            ns += __shfl_xor(ns, 1); ns += __shfl_xor(ns, 2);
            if (part == 0) nst[(size_t)it * 128 + d] = ns;
        }
    }
    __syncthreads();
}

__device__ __forceinline__ void p4_mlstm_out(Frame& F, bf16* Ydst, int tmask) {
    const int wave = F.wave;
    const bf16* qm = WSP(bf16, WS_C); const bf16* km = qm + (size_t)M * 512; const bf16* vm = WSP(bf16, WS_C) + (size_t)2 * M * 512; bf16* om = WSP(bf16, WS_C) + (size_t)3 * M * 512;
    const float* logi = WSP(float, MS_LOGI); const float* bcum = WSP(float, MS_BCUM); const float* chs = WSP(float, MS_CHS);
    const float* Cst = WSP(float, WS_A); const float* nst = WSP(float, MS_NST);
    LAS unsigned char* Qc = F.lds + RING_OFF; LAS unsigned char* Kc = F.lds + RING_OFF + 32768; LAS unsigned char* Vp = F.lds + RING_OFF + 65536; LAS unsigned char* Cp = F.lds + RING_OFF + 98304;
    LAS float* sh = (LAS float*)(F.lds + RING_OFF + 131072);
    LAS float* bvec = sh, *ivb = sh + 128, *pm = sh + 256, *nprev = sh + 384, *stat = sh + 512;
    const float* cwq = IN_CONV; const float* cwk = IN_CONV + 512; const float* lng = IN_MNG;
    for (int it = F.vcu; it < MH * NCH; it += F.G) { const int h = it >> 7, c = it & 127, t0 = c * CL;
        int tid = F.tid; asm volatile("" : "+v"(tid));
        const int lane = tid & 63, r32 = lane & 31, hi = lane >> 5; LAS float* wt = sh + 1024 + wave * 64;
        __syncthreads();
#pragma unroll 1
        for (int i = 0; i < 4; ++i) { const int idx = tid + 512 * i, r = idx >> 4, ci = idx & 15; const size_t go = (size_t)(t0 + r) * 512 + h * 128 + ci * 8;
            float cq[8], ck[8]; conv8(qm, t0 + r, h * 128 + ci * 8, cwq + h * 128 + ci * 8, 1.0f, cq); conv8(km, t0 + r, h * 128 + ci * 8, cwk + h * 128 + ci * 8, 0.08838834764831845f, ck);
            *(LAS v4u*)(Qc + chunk_off(r, ci)) = (v4u){pk2(cq[0], cq[1]), pk2(cq[2], cq[3]), pk2(cq[4], cq[5]), pk2(cq[6], cq[7])};
            *(LAS v4u*)(Kc + chunk_off(r, ci)) = (v4u){pk2(ck[0], ck[1]), pk2(ck[2], ck[3]), pk2(ck[4], ck[5]), pk2(ck[6], ck[7])};
            *(LAS v4u*)(Vp + panel_off(r, ci)) = *(const GAS v4u*)(vm + go);
            v4u o = (v4u){0u, 0u, 0u, 0u};
            if (c > 0) { const float* cp = Cst + ((size_t)(it - 1) * 128 + r) * 128 + ci * 8; const f32x4 a = *(const GAS f32x4*)cp, b = *(const GAS f32x4*)(cp + 4); o.x = pk2(a.x, a.y); o.y = pk2(a.z, a.w); o.z = pk2(b.x, b.y); o.w = pk2(b.z, b.w); }
            *(LAS v4u*)(Cp + panel_off(r, ci)) = o; }
        if (tid < 128) { const float bt = bcum[(size_t)h * M + t0 + tid]; bvec[tid] = bt; ivb[tid] = logi[(size_t)(t0 + tid) * 4 + h] - bt; nprev[tid] = (c > 0) ? nst[(size_t)(it - 1) * 128 + tid] : 0.f; }
        __syncthreads();
        if (wave == 0) { float v0 = ivb[lane], v1 = ivb[64 + lane];
#pragma unroll
            for (int o = 1; o < 64; o <<= 1) { const float a = __shfl_up(v0, o), b = __shfl_up(v1, o); if (lane >= o) { v0 = fmaxf(v0, a); v1 = fmaxf(v1, b); } }
            v1 = fmaxf(v1, __shfl(v0, 63)); pm[lane] = v0; pm[64 + lane] = v1; }
        __syncthreads();
        const float mprev = chs[2 * 512 + it];
        const int tb = wave & 3, eh = wave >> 2, t = 32 * tb + r32;
        bf16x8 qr[8];
#pragma unroll
        for (int k0 = 0; k0 < 8; ++k0) qr[k0] = *(const LAS bf16x8*)(Qc + (2 * k0 + hi) * 2048 + t * 16);
        const float bt = bvec[t], mt = bt + fmaxf(mprev, pm[t]), winter = __expf(bt + mprev - mt), cst = bt - mt;
        float rs = 0.f; u32x4a pw[4][2];
#pragma unroll
        for (int sb = 0; sb < 4; ++sb) {
            if (sb <= tb) {
                f32x16 cc;
#pragma unroll
                for (int r = 0; r < 16; ++r) cc[r] = 0.f;
#pragma unroll
                for (int k0 = 0; k0 < 8; ++k0) { const bf16x8 ka = *(const LAS bf16x8*)(Kc + (2 * k0 + hi) * 2048 + (32 * sb + r32) * 16); cc = __builtin_amdgcn_mfma_f32_32x32x16_bf16(ka, qr[k0], cc, 0, 0, 0); }
                float e[16];
#pragma unroll
                for (int r = 0; r < 16; ++r) { const int s = 32 * sb + crow(r, hi); const float w = (s <= t) ? __expf(ivb[s] + cst) : 0.f; e[r] = cc[r] * w; rs += e[r]; }
                pw[sb][0] = (u32x4a){cvtpk(e[0], e[1]), cvtpk(e[2], e[3]), cvtpk(e[4], e[5]), cvtpk(e[6], e[7])};
                pw[sb][1] = (u32x4a){cvtpk(e[8], e[9]), cvtpk(e[10], e[11]), cvtpk(e[12], e[13]), cvtpk(e[14], e[15])};
            } else { pw[sb][0] = (u32x4a){0u, 0u, 0u, 0u}; pw[sb][1] = (u32x4a){0u, 0u, 0u, 0u}; }
        }
        rs = swapsum(rs);
        float qn = 0.f;
#pragma unroll
        for (int k0 = 0; k0 < 8; ++k0) { const u32x4a qq = __builtin_bit_cast(u32x4a, qr[k0]); const LAS float* np = nprev + 16 * k0 + 8 * hi;
            qn += (blo(qq.x) * np[0] + bhi(qq.x) * np[1]) + (blo(qq.y) * np[2] + bhi(qq.y) * np[3]) + (blo(qq.z) * np[4] + bhi(qq.z) * np[5]) + (blo(qq.w) * np[6] + bhi(qq.w) * np[7]); }
        qn = swapsum(qn);
        const float den = winter * qn + rs, scl = 1.0f / fmaxf(fabsf(den), __expf(-mt));
        if (hi == 0) { wt[r32] = winter; wt[32 + r32] = scl; }
        f32x16 acc[2];
#pragma unroll
        for (int r = 0; r < 16; ++r) { acc[0][r] = 0.f; acc[1][r] = 0.f; }
        const int coff = (8 * hi + ((lane & 15) >> 2)) * 64 + ((lane >> 4) & 1) * 32 + (lane & 3) * 8;
#pragma unroll
        for (int k0 = 0; k0 < 8; ++k0) {
#pragma unroll
            for (int eb = 0; eb < 2; ++eb) { const bf16x8 B = tr8(Cp + (2 * eh + eb) * 8192 + k0 * 1024 + coff, 256); acc[eb] = __builtin_amdgcn_mfma_f32_32x32x16_bf16(qr[k0], B, acc[eb], 0, 0, 0); } }
        asm volatile("s_waitcnt lgkmcnt(0)" ::: "memory");
#pragma unroll
        for (int r = 0; r < 16; ++r) { const float wi = wt[crow(r, hi)]; acc[0][r] *= wi; acc[1][r] *= wi; }
        const int voff = (4 * hi + ((lane & 15) >> 2)) * 64 + ((lane >> 4) & 1) * 32 + (lane & 3) * 8;
#pragma unroll
        for (int sb = 0; sb < 4; ++sb) {
            if (sb <= tb) {
#pragma unroll
                for (int k2 = 0; k2 < 2; ++k2) { const bf16x8 pa = __builtin_bit_cast(bf16x8, pw[sb][k2]);
#pragma unroll
                    for (int eb = 0; eb < 2; ++eb) { const bf16x8 B = tr8(Vp + (2 * eh + eb) * 8192 + (2 * sb + k2) * 1024 + voff, 512); acc[eb] = __builtin_amdgcn_mfma_f32_32x32x16_bf16(pa, B, acc[eb], 0, 0, 0); } }
            }
        }
        const size_t gbase = (size_t)(t0 + 32 * tb) * 512 + h * 128 + 64 * eh + r32;
        float s1[16], s2[16];
#pragma unroll
        for (int r = 0; r < 16; ++r) { const int tr_ = crow(r, hi); const float sc = wt[32 + tr_]; const bf16* op = om + gbase + (size_t)tr_ * 512;
            const float x0 = acc[0][r] * sc * sigm(bf2f(op[0])), x1 = acc[1][r] * sc * sigm(bf2f(op[32])); acc[0][r] = x0; acc[1][r] = x1; s1[r] = x0 + x1; s2[r] = x0 * x0 + x1 * x1; }
#pragma unroll
        for (int o = 1; o < 32; o <<= 1) {
#pragma unroll
            for (int r = 0; r < 16; ++r) { s1[r] += __shfl_xor(s1[r], o); s2[r] += __shfl_xor(s2[r], o); } }
        if (r32 == 0) {
#pragma unroll
            for (int r = 0; r < 16; ++r) { const int tt = 32 * tb + crow(r, hi); stat[(tt * 2 + eh) * 2] = s1[r]; stat[(tt * 2 + eh) * 2 + 1] = s2[r]; } }
        __syncthreads();
        const float g0 = lng[h * 128 + 64 * eh + r32], g1 = lng[h * 128 + 64 * eh + 32 + r32];
#pragma unroll
        for (int r = 0; r < 16; ++r) { const int tr_ = crow(r, hi), tt = 32 * tb + tr_;
            const float sum = stat[tt * 4] + stat[tt * 4 + 2], sq = stat[tt * 4 + 1] + stat[tt * 4 + 3];
            const float mu = sum * (1.0f / 128.0f), var = fmaxf(sq * (1.0f / 128.0f) - mu * mu, 0.f), rstd = 1.0f / sqrtf(var + EPS);
            bf16* yp = Ydst + (size_t)((t0 + 32 * tb + tr_) & tmask) * 512 + h * 128 + 64 * eh + r32;
            yp[0] = (bf16)f2bf((acc[0][r] - mu) * rstd * g0); yp[32] = (bf16)f2bf((acc[1][r] - mu) * rstd * g1); }
    }
    __syncthreads();
}

__device__ __forceinline__ void p10_final_norm(Frame& F, float* io) {
    const int gw = F.vcu * NWAVES + F.wave, NGW = F.G * NWAVES, lane = F.lane;
    f32x4 gv[4];
#pragma unroll
    for (int j = 0; j < 4; ++j) gv[j] = ((const GAS f32x4*)IN_FING)[lane + 64 * j];
    for (int m = gw; m < M; m += NGW) {
        GAS f32x4* xr = (GAS f32x4*)(io + (size_t)m * D) + lane;
        f32x4 v[4]; float s = 0.f;
#pragma unroll
        for (int j = 0; j < 4; ++j) { v[j] = xr[64 * j]; s += (v[j].x * v[j].x + v[j].y * v[j].y) + (v[j].z * v[j].z + v[j].w * v[j].w); }
        const float rstd = 1.0f / sqrtf(wave_sum(s) * (1.f / D) + EPS);
#pragma unroll
        for (int j = 0; j < 4; ++j) xr[64 * j] = v[j] * rstd * gv[j];
    }
}

struct Args { const float* in[15]; float* out; unsigned char* ws; int ph_lo, ph_hi, li, pad; };
__global__ void __launch_bounds__(NWAVES * 64, 2) mk_fwd(Args args) {
    extern __shared__ __attribute__((aligned(16))) unsigned char lds[];
    Frame F;
    F.lds = (LAS unsigned char*)lds;
    F.MISC = (volatile LAS unsigned*)(F.lds + MISC_OFF);
    F.tid = threadIdx.x; F.lane = F.tid & 63; F.wave = __builtin_amdgcn_readfirstlane(F.tid >> 6);
    F.G = gridDim.x; { const int bx = blockIdx.x; F.vcu = (F.G % 8 == 0) ? (bx % 8) * (F.G / 8) + bx / 8 : bx; }
    F.ws = args.ws; F.ctl = (gu32*)(args.ws + WS_CTL); F.out = args.out;
    for (int u = F.tid; u < (LDS_BYTES - LDSCTL_OFF) / 4; u += NWAVES * 64) ((LAS unsigned*)(F.lds + LDSCTL_OFF))[u] = 0u;
    __syncthreads();
    if (F.tid < 15) ((LAS cfptr*)(F.lds + LDSCTL_OFF))[F.tid] = args.in[F.tid];
    __syncthreads();
#define REFRESH() do { int l_; asm volatile("v_mbcnt_lo_u32_b32 %0, -1, 0\n\tv_mbcnt_hi_u32_b32 %0, -1, %0" : "=v"(l_)); F.lane = l_; F.tid = F.wave * 64 + l_; } while (0)
    XcdBarrier bar; bar.bar = (unsigned*)(F.ctl + CW_BAR); bar.x = 0; bar.st = nullptr;
    if (N_LAUNCHES == 1) bar = xcd_barrier_post((unsigned*)(F.ctl + CW_BAR), F.MISC + 8, F.tid);
#define GRID_BAR() do { if (N_LAUNCHES == 1) { REFRESH(); xcd_barrier(bar, F.tid); } } while (0)
    const int lo = args.ph_lo, hi = args.ph_hi;
#define IN(k) (lo <= (k) && (k) < hi)
#define SEAM(k) do { if (IN(k) && IN((k) + 1)) GRID_BAR(); } while (0)
    bf16* segs = WSP(bf16, WS_B);
    static_assert(WS_C == WS_B + (size_t)3 * M * 512 * 2, "segments contiguous");
    bf16* ga = WSP(bf16, WS_D); bf16* gm = ga + (size_t)M * 1024;
    bf16* ya = WSP(bf16, WS_B); bf16* ym = WSP(bf16, WS_C) + (size_t)3 * M * 512;
    bf16* P1 = WSP(bf16, WS_C); bf16* merged = WSP(bf16, WS_A);
    bf16* x1b = WSP(bf16, WS_B + 16 * MiB); bf16* hid = WSP(bf16, WS_HID);

#ifndef PROBE_DUP
#define PROBE_DUP -1
#endif
#define DUP(k) (PROBE_DUP == (k))
    bf16* dummy = (bf16*)((unsigned char*)F.out + 50 * MiB);
    if (IN(0)) { p0_prologue(F); if (DUP(0)) { __syncthreads(); p0_prologue(F); } } SEAM(0);
    REFRESH(); if (IN(1)) { gate_prep(F);
        pg8::Gemm g{WSP(bf16, WS_A), WSP(bf16, WS_WIN), M, NIN, D}; pg8::StaticOrder S; S.init(M, NIN, F.G, (int)blockIdx.x);
        pg8::EpiIn E{segs, ga, C2, M, (float*)(F.ctl + CW_KSUM)};
        pg8::gemm_phase<pg8::EpiIn, pg8::StaticOrder, PG8_ALIGN, PG8_SP2>(F.lds + RING_OFF, g, S, E, F.tid);
        if (DUP(1)) pg8::gemm_phase<pg8::EpiIn, pg8::StaticOrder, PG8_ALIGN, PG8_SP2>(F.lds + RING_OFF, g, S, E, F.tid); } SEAM(1);
    REFRESH(); if (IN(2)) { p2_gating(F, true); if (DUP(20)) p2_gating(F, false); REFRESH(); p2_cloc(F); if (DUP(21)) p2_cloc(F); } SEAM(2);
    REFRESH(); if (IN(3)) { p3_scan(F, WSP(float, WS_A)); REFRESH(); p3_attn_selected(F); if (DUP(31)) p3_attn_selected(F); } SEAM(3);
    REFRESH(); if (IN(4)) { if (DUP(40)) p4_attn_own(F, dummy, 8191); p4_attn_own(F, WSP(bf16, WS_B), M - 1); REFRESH(); if (DUP(41)) p4_mlstm_out(F, dummy, 8191); p4_mlstm_out(F, ym, M - 1); } SEAM(4);
    REFRESH(); if (IN(5)) { pg8::Gemm g{ya, WSP(bf16, WS_WA), M, D, AW}; pg8::StaticOrder S; S.init(M, D, F.G, (int)blockIdx.x);
        pg8::EpiGate<0> E{ga, nullptr, P1};
        pg8::gemm_phase<pg8::EpiGate<0>, pg8::StaticOrder, PG8_ALIGN, PG8_SP2>(F.lds + RING_OFF, g, S, E, F.tid);
        if (DUP(5)) pg8::gemm_phase<pg8::EpiGate<0>, pg8::StaticOrder, PG8_ALIGN, PG8_SP2>(F.lds + RING_OFF, g, S, E, F.tid); } SEAM(5);
    if (DUP(50)) { for (int kk = 0; kk < 10; ++kk) GRID_BAR(); }
    REFRESH(); if (IN(6)) { pg8::Gemm g{ym, WSP(bf16, WS_WM), M, D, MW}; pg8::StaticOrder S; S.init(M, D, F.G, (int)blockIdx.x);
        pg8::EpiGate<1> E{gm, P1, merged};
        pg8::gemm_phase<pg8::EpiGate<1>, pg8::StaticOrder, PG8_ALIGN, PG8_SP2>(F.lds + RING_OFF, g, S, E, F.tid); } SEAM(6);
    REFRESH(); if (IN(7)) { pg8::Gemm g{merged, WSP(bf16, WS_WO), M, D, D}; pg8::StaticOrder S; S.init(M, D, F.G, (int)blockIdx.x);
        pg8::EpiRes<true> E{IN_X, F.out, x1b, WSP(float, MS_SSQ1)};
        pg8::gemm_phase<pg8::EpiRes<true>, pg8::StaticOrder, PG8_ALIGN, PG8_SP2>(F.lds + RING_OFF, g, S, E, F.tid);
        if (DUP(7)) pg8::gemm_phase<pg8::EpiRes<true>, pg8::StaticOrder, PG8_ALIGN, PG8_SP2>(F.lds + RING_OFF, g, S, E, F.tid); } SEAM(7);
    REFRESH(); if (IN(8)) { pg8::Gemm g{x1b, WSP(bf16, WS_WGU), M, NIN, D}; pg8::StaticOrder S; S.init(M, NIN, F.G, (int)blockIdx.x);
        pg8::EpiSwiGLU E{WSP(float, MS_SSQ1), hid, FF, EPS};
        pg8::gemm_phase<pg8::EpiSwiGLU, pg8::StaticOrder, PG8_ALIGN, PG8_SP2>(F.lds + RING_OFF, g, S, E, F.tid);
        if (DUP(8)) pg8::gemm_phase<pg8::EpiSwiGLU, pg8::StaticOrder, PG8_ALIGN, PG8_SP2>(F.lds + RING_OFF, g, S, E, F.tid); } SEAM(8);
    REFRESH(); if (IN(9)) { if (DUP(30)) { p3_scan(F, WSP(float, WS_A + 36 * MiB)); REFRESH(); }
        pg8::Gemm g{hid, WSP(bf16, WS_WD), M, D, FF}; pg8::StaticOrder S; S.init(M, D, F.G, (int)blockIdx.x);
        if (DUP(9)) { pg8::EpiRes<false> E0{F.out, (float*)WSP(bf16, WS_A), nullptr, WSP(float, MS_SSQ2)}; pg8::gemm_phase<pg8::EpiRes<false>, pg8::StaticOrder, PG8_ALIGN, PG8_SP2>(F.lds + RING_OFF, g, S, E0, F.tid); }
        pg8::EpiRes<false> E{F.out, F.out, nullptr, WSP(float, MS_SSQ2)};
        pg8::gemm_phase<pg8::EpiRes<false>, pg8::StaticOrder, PG8_ALIGN, PG8_SP2>(F.lds + RING_OFF, g, S, E, F.tid); } SEAM(9);
    REFRESH(); if (IN(10)) { if (DUP(100)) p10_final_norm(F, WSP(float, WS_A)); p10_final_norm(F, F.out); }
#undef IN
#undef SEAM
}

extern "C" void kernel_launch(void* const* d_in, const int* in_sizes, int n_in, void* d_out, int out_size, void* d_ws, size_t ws_size, hipStream_t stream) {
    static int grid = 0;
    if (grid == 0) {
        if (n_in != 15 || in_sizes[0] != M * D || out_size != M * D || ws_size < WS_END) { fprintf(stderr, "kernel_launch: unexpected shapes: n_in %d in0 %d out %d ws %zu\n", n_in, n_in > 0 ? in_sizes[0] : -1, out_size, ws_size); grid = -1; return; }
        int dev = 0, cus = 0, per_cu = 0;
        if (hipGetDevice(&dev) != hipSuccess || hipDeviceGetAttribute(&cus, hipDeviceAttributeMultiprocessorCount, dev) != hipSuccess) { grid = -1; return; }
        if (hipFuncSetAttribute((const void*)mk_fwd, hipFuncAttributeMaxDynamicSharedMemorySize, LDS_BYTES) != hipSuccess) { fprintf(stderr, "kernel_launch: hipFuncSetAttribute failed\n"); grid = -1; return; }
        if (hipOccupancyMaxActiveBlocksPerMultiprocessor(&per_cu, (const void*)mk_fwd, NWAVES * 64, LDS_BYTES) != hipSuccess || per_cu < 1) { fprintf(stderr, "kernel_launch: occupancy query says %d blocks per CU\n", per_cu); per_cu = 1; }
        (void)hipGetLastError();
        grid = cus;
    }
    if (grid < 0) return;
    if (hipMemsetAsync((char*)d_ws + WS_CTL, 0, CTL_ZERO_BYTES, stream) != hipSuccess) { fprintf(stderr, "kernel_launch: memset failed\n"); return; }
    Args a{};
    for (int i = 0; i < 15; ++i) a.in[i] = (const float*)d_in[i];
    a.out = (float*)d_out; a.ws = (unsigned char*)d_ws;
    for (int li = 0; li < N_LAUNCHES; ++li) {
        a.ph_lo = (N_LAUNCHES == 1) ? 0 : li; a.ph_hi = (N_LAUNCHES == 1) ? N_PHASES : li + 1; a.li = li;
        hipLaunchKernelGGL(mk_fwd, dim3(grid), dim3(NWAVES * 64), LDS_BYTES, stream, a);
        const hipError_t le = hipPeekAtLastError();
        if (le != hipSuccess) { fprintf(stderr, "kernel_launch: launch %d failed: %s\n", li, hipGetErrorName(le)); break; }
    }
}
```
